# Optimizing an MI355X kernel written in HIP

```python
import numpy as np
import jax, jax.numpy as jnp
from jax import lax

D_MODEL = 1024
BATCH = 8
SEQ = 4096
DEPTH = 4

D_MIX = D_MODEL
N_MIXERS = 4
GROUP_W = D_MIX // N_MIXERS

MLA_HEADS = 4
MLA_V = GROUP_W // MLA_HEADS
MLA_NOPE = MLA_V
MLA_ROPE = MLA_NOPE // 2
MLA_Q_RANK = D_MODEL // 4
MLA_KV_RANK = D_MODEL // 8
ROPE_THETA = 10000.0
MAX_START = 4096

CONV_CH = GROUP_W
CONV_K = 3

GMLP_GROUPS = 4
GMLP_CHUNK = 128

NSA_HEADS = 4
NSA_DH = GROUP_W // NSA_HEADS
CMP_LEN = 32
CMP_STRIDE = 16
CMP_HIDDEN = 4 * NSA_DH
SEL_LEN = 64
N_SELECT = 16
WINDOW = 512
Q_BLOCK = 128
FORCE_SCORE = 1e4

D_FF = 7 * D_MODEL // 2
N_EXPERTS = 8
TOP_K = 2

EPS = 1e-6
NEG = -1e30

IN_SIZES = (MLA_Q_RANK, MLA_KV_RANK, MLA_ROPE,
            CONV_CH, CONV_CH, CONV_CH,
            GROUP_W, GROUP_W,
            NSA_HEADS * NSA_DH,
            NSA_DH, NSA_DH, NSA_DH, NSA_DH, NSA_DH, NSA_DH,
            NSA_HEADS * 3)
D_IN = sum(IN_SIZES)

kernel_name = 'hybrid_mla_conv_gmlp_nsa_moe'


def rms_norm(x, g):
    xf = x.astype(jnp.float32)
    y = xf * lax.rsqrt(jnp.mean(xf * xf, axis=-1, keepdims=True) + EPS)
    return (y * g.astype(jnp.float32)).astype(x.dtype)


def layer_norm(x, g):
    xf = x.astype(jnp.float32)
    mu = jnp.mean(xf, axis=-1, keepdims=True)
    var = jnp.mean(jnp.square(xf - mu), axis=-1, keepdims=True)
    return ((xf - mu) * lax.rsqrt(var + EPS) * g.astype(jnp.float32)).astype(x.dtype)


def masked_softmax(s, mask):
    return jax.nn.softmax(jnp.where(mask, s.astype(jnp.float32), NEG), axis=-1)


def rope(x, positions):
    half = x.shape[-1] // 2
    inv = ROPE_THETA ** (-jnp.arange(half, dtype=jnp.float32) / half)
    ang = positions.astype(jnp.float32)[..., None] * inv
    cos = jnp.cos(ang)[:, :, None, :]
    sin = jnp.sin(ang)[:, :, None, :]
    xf = x.astype(jnp.float32)
    x1, x2 = xf[..., :half], xf[..., half:]
    return jnp.concatenate([x1 * cos - x2 * sin, x1 * sin + x2 * cos], axis=-1).astype(x.dtype)


def causal_attention_blocked(q, k, v, scale):
    B, S, H, dk = q.shape
    nq = S // Q_BLOCK
    qb = q.reshape(B, nq, Q_BLOCK, H, dk).transpose(1, 0, 2, 3, 4)
    k_idx = jnp.arange(S)

    def block(args):
        qi, i = args
        s = jnp.einsum('bqhd,bkhd->bhqk', qi, k).astype(jnp.float32) * scale
        q_idx = i * Q_BLOCK + jnp.arange(Q_BLOCK)
        p = masked_softmax(s, k_idx[None, :] <= q_idx[:, None])
        return jnp.einsum('bhqk,bkhd->bqhd', p.astype(v.dtype), v)

    out = lax.map(block, (qb, jnp.arange(nq)))
    return out.transpose(1, 0, 2, 3, 4).reshape(B, S, H, v.shape[-1])


def mla_mixer(cq, ckv, kr, positions, q_norm, w_uq, kv_norm, w_ukv):
    B, S, _ = cq.shape
    q = (rms_norm(cq, q_norm) @ w_uq).reshape(B, S, MLA_HEADS, MLA_NOPE + MLA_ROPE)
    q = jnp.concatenate([q[..., :MLA_NOPE], rope(q[..., MLA_NOPE:], positions)], axis=-1)
    kv = (rms_norm(ckv, kv_norm) @ w_ukv).reshape(B, S, MLA_HEADS, MLA_NOPE + MLA_V)
    k_rope = jnp.broadcast_to(rope(kr[:, :, None, :], positions), (B, S, MLA_HEADS, MLA_ROPE))
    k = jnp.concatenate([kv[..., :MLA_NOPE], k_rope], axis=-1)
    v = kv[..., MLA_NOPE:]
    o = causal_attention_blocked(q, k, v, (MLA_NOPE + MLA_ROPE) ** -0.5)
    return o.reshape(B, S, MLA_HEADS * MLA_V)


def short_conv_mixer(b_gate, c_gate, h, conv_w):
    u = c_gate * h
    y = lax.conv_general_dilated(u, conv_w[:, None, :].astype(u.dtype), window_strides=(1,),
                                 padding=[(CONV_K - 1, 0)],
                                 dimension_numbers=('NWC', 'WIO', 'NWC'),
                                 feature_group_count=u.shape[-1])
    return b_gate * y


def gmlp_mixer(u, v, ln_g, w_s, b_s):
    B, S, W = u.shape
    u = jax.nn.gelu(u)
    v = layer_norm(jax.nn.gelu(v), ln_g)
    n = S // GMLP_CHUNK
    dg = W // GMLP_GROUPS
    vc = v.reshape(B, n, GMLP_CHUNK, GMLP_GROUPS, dg)
    causal = jnp.tril(jnp.ones((GMLP_CHUNK, GMLP_CHUNK), dtype=bool))
    ws = jnp.where(causal[None], w_s, 0)
    sv = jnp.einsum('gij,bnjgd->bnigd', ws, vc) + b_s.T[None, None, :, :, None]
    return u * sv.reshape(B, S, W)


def compress_blocks(z, pe, w1, w2):
    B, S, d = z.shape
    r = CMP_LEN // CMP_STRIDE
    n = S // CMP_STRIDE
    ch = z.reshape(B, n, CMP_STRIDE, d)
    blocks = jnp.concatenate([ch[:, j:n - r + 1 + j] for j in range(r)], axis=2)
    nc = blocks.shape[1]
    blocks = (blocks + pe).reshape(B, nc, CMP_LEN * d)
    return jax.nn.gelu(blocks @ w1) @ w2


def cmp_to_sel_matrix(S):
    nc = S // CMP_STRIDE - CMP_LEN // CMP_STRIDE + 1
    ns = S // SEL_LEN
    cs = np.arange(nc)[:, None] * CMP_STRIDE
    ss = np.arange(ns)[None, :] * SEL_LEN
    ov = np.clip(np.minimum(cs + CMP_LEN, ss + SEL_LEN) - np.maximum(cs, ss), 0, None)
    return jnp.asarray(ov.astype(np.float32) / np.float32(CMP_LEN))


def nsa_mixer(q, kc_raw, vc_raw, ks, vs, kw, vw, g_logits,
              pe_k, w1_k, w2_k, pe_v, w1_v, w2_v):
    B, S, _ = q.shape
    H, dh = NSA_HEADS, NSA_DH
    scale = dh ** -0.5
    q = q.reshape(B, S, H, dh)
    t_idx = jnp.arange(S)
    nq = S // Q_BLOCK

    kc = compress_blocks(kc_raw, pe_k, w1_k, w2_k)
    vc = compress_blocks(vc_raw, pe_v, w1_v, w2_v)
    nc = kc.shape[1]
    blk_end = jnp.arange(nc) * CMP_STRIDE + CMP_LEN - 1
    cmask = blk_end[None, :] <= t_idx[:, None]
    s_c = jnp.einsum('bshd,bcd->bshc', q, kc).astype(jnp.float32) * scale
    p_c = masked_softmax(s_c, cmask[None, :, None, :]) * jnp.any(cmask, axis=-1)[None, :, None, None]
    o_cmp = jnp.einsum('bshc,bcd->bshd', p_c.astype(vc.dtype), vc)

    ns = S // SEL_LEN
    p_sel = jnp.einsum('bshc,cn->bsn', p_c, cmp_to_sel_matrix(S))
    blk = jnp.arange(ns)[None, :]
    cur = (t_idx // SEL_LEN)[:, None]
    valid = blk <= cur
    forced = (blk == 0) | (blk == cur) | (blk == cur - 1)
    p_sel = jnp.where(forced[None], FORCE_SCORE, jnp.where(valid[None], p_sel, -1.0))
    n_sel = min(N_SELECT, ns)
    _, sel_idx = lax.top_k(p_sel, n_sel)

    ks_blk = ks.reshape(B, ns, SEL_LEN, dh)
    vs_blk = vs.reshape(B, ns, SEL_LEN, dh)
    qb = q.reshape(B, nq, Q_BLOCK, H, dh).transpose(1, 0, 2, 3, 4)
    ib = sel_idx.reshape(B, nq, Q_BLOCK, n_sel).transpose(1, 0, 2, 3)
    b_ar = jnp.arange(B)[:, None, None]

    def sel_block(args):
        qi, idx, i = args
        kg = ks_blk[b_ar, idx]
        vg = vs_blk[b_ar, idx]
        key_pos = idx[..., None] * SEL_LEN + jnp.arange(SEL_LEN)
        q_pos = i * Q_BLOCK + jnp.arange(Q_BLOCK)
        mask = (key_pos <= q_pos[None, :, None, None]).reshape(B, Q_BLOCK, 1, n_sel * SEL_LEN)
        s = jnp.einsum('bqhd,bqnld->bqhnl', qi, kg).astype(jnp.float32) * scale
        p = masked_softmax(s.reshape(B, Q_BLOCK, H, n_sel * SEL_LEN), mask)
        p = p.reshape(B, Q_BLOCK, H, n_sel, SEL_LEN)
        return jnp.einsum('bqhnl,bqnld->bqhd', p.astype(vg.dtype), vg)

    o_sel = lax.map(sel_block, (qb, ib, jnp.arange(nq)))
    o_sel = o_sel.transpose(1, 0, 2, 3, 4).reshape(B, S, H, dh)

    n_band = WINDOW // Q_BLOCK + 1

    def band(z):
        zc = z.reshape(B, nq, Q_BLOCK, dh)
        zp = jnp.pad(zc, ((0, 0), (n_band - 1, 0), (0, 0), (0, 0)))
        return jnp.concatenate([zp[:, j:j + nq] for j in range(n_band)], axis=2)

    kb, vb = band(kw), band(vw)
    qc = q.reshape(B, nq, Q_BLOCK, H, dh)
    q_pos = jnp.arange(nq)[:, None] * Q_BLOCK + jnp.arange(Q_BLOCK)
    k_pos = (jnp.arange(nq)[:, None] - (n_band - 1)) * Q_BLOCK + jnp.arange(n_band * Q_BLOCK)
    diff = q_pos[:, :, None] - k_pos[:, None, :]
    wmask = (diff >= 0) & (diff < WINDOW) & (k_pos[:, None, :] >= 0)
    s_w = jnp.einsum('bnqhd,bnkd->bnhqk', qc, kb).astype(jnp.float32) * scale
    p_w = masked_softmax(s_w, wmask[None, :, None])
    o_win = jnp.einsum('bnhqk,bnkd->bnqhd', p_w.astype(vb.dtype), vb).reshape(B, S, H, dh)

    g = jax.nn.sigmoid(g_logits.astype(jnp.float32)).reshape(B, S, H, 3).astype(q.dtype)
    o = g[..., 0:1] * o_cmp + g[..., 1:2] * o_sel + g[..., 2:3] * o_win
    return o.reshape(B, S, H * dh)


def swiglu(x, wg, wu, wd):
    return (jax.nn.silu(x @ wg) * (x @ wu)) @ wd


def moe_ffn(x, w_router, wg, wu, wd):
    B, S, D = x.shape
    xt = x.reshape(B * S, D)
    logits = (xt @ w_router).astype(jnp.float32)
    top_v, top_i = lax.top_k(logits, TOP_K)
    w = jax.nn.softmax(top_v, axis=-1)
    gates = jnp.sum(jax.nn.one_hot(top_i, N_EXPERTS, dtype=jnp.float32) * w[..., None], axis=1)
    y = jnp.zeros_like(xt)
    for e in range(N_EXPERTS):
        y = y + gates[:, e:e + 1].astype(xt.dtype) * swiglu(xt, wg[e], wu[e], wd[e])
    return y.reshape(B, S, D)


def setup_inputs(seed: int = 0) -> dict:
    key = jax.random.key(seed)
    keys = jax.random.split(key, 32)

    def nrm(i, shape, scale):
        return jax.random.normal(keys[i], shape, jnp.float32) * scale

    def gain(i, shape):
        return 1.0 + nrm(i, shape, 0.02)

    nd, nm = (DEPTH + 1) // 2, DEPTH // 2
    L = DEPTH
    start = jax.random.randint(keys[1], (BATCH, 1), 0, MAX_START, dtype=jnp.int32)
    positions = start + jnp.arange(SEQ, dtype=jnp.int32)[None, :]
    return {
        'x': nrm(0, (BATCH, SEQ, D_MODEL), 1.0),
        'positions': positions,
        'attn_norm': gain(2, (L, D_MODEL)),
        'w_in': nrm(3, (L, D_MODEL, D_IN), D_MODEL ** -0.5),
        'mla_q_norm': gain(4, (L, MLA_Q_RANK)),
        'mla_w_uq': nrm(5, (L, MLA_Q_RANK, MLA_HEADS * (MLA_NOPE + MLA_ROPE)), MLA_Q_RANK ** -0.5),
        'mla_kv_norm': gain(6, (L, MLA_KV_RANK)),
        'mla_w_ukv': nrm(7, (L, MLA_KV_RANK, MLA_HEADS * (MLA_NOPE + MLA_V)), MLA_KV_RANK ** -0.5),
        'conv_w': nrm(8, (L, CONV_K, CONV_CH), CONV_K ** -0.5),
        'gmlp_ln': gain(9, (L, GROUP_W)),
        'gmlp_w_s': nrm(10, (L, GMLP_GROUPS, GMLP_CHUNK, GMLP_CHUNK), GMLP_CHUNK ** -0.5),
        'gmlp_b_s': gain(11, (L, GMLP_GROUPS, GMLP_CHUNK)),
        'nsa_pe_k': nrm(12, (L, CMP_LEN, NSA_DH), 0.1),
        'nsa_w1_k': nrm(13, (L, CMP_LEN * NSA_DH, CMP_HIDDEN), (CMP_LEN * NSA_DH) ** -0.5),
        'nsa_w2_k': nrm(14, (L, CMP_HIDDEN, NSA_DH), CMP_HIDDEN ** -0.5),
        'nsa_pe_v': nrm(15, (L, CMP_LEN, NSA_DH), 0.1),
        'nsa_w1_v': nrm(16, (L, CMP_LEN * NSA_DH, CMP_HIDDEN), (CMP_LEN * NSA_DH) ** -0.5),
        'nsa_w2_v': nrm(17, (L, CMP_HIDDEN, NSA_DH), CMP_HIDDEN ** -0.5),
        'group_norm': gain(18, (L, N_MIXERS, GROUP_W)),
        'w_o': nrm(19, (L, D_MIX, D_MODEL), D_MIX ** -0.5),
        'ffn_norm': gain(20, (L, D_MODEL)),
        'dense_w_gate': nrm(21, (nd, D_MODEL, D_FF), D_MODEL ** -0.5),
        'dense_w_up': nrm(22, (nd, D_MODEL, D_FF), D_MODEL ** -0.5),
        'dense_w_down': nrm(23, (nd, D_FF, D_MODEL), D_FF ** -0.5),
        'moe_router': nrm(24, (nm, D_MODEL, N_EXPERTS), D_MODEL ** -0.5),
        'moe_w_gate': nrm(25, (nm, N_EXPERTS, D_MODEL, D_FF), D_MODEL ** -0.5),
        'moe_w_up': nrm(26, (nm, N_EXPERTS, D_MODEL, D_FF), D_MODEL ** -0.5),
        'moe_w_down': nrm(27, (nm, N_EXPERTS, D_FF, D_MODEL), D_FF ** -0.5),
        'final_norm': gain(28, (D_MODEL,)),
    }


def reference(x, positions, attn_norm, w_in, mla_q_norm, mla_w_uq, mla_kv_norm, mla_w_ukv,
              conv_w, gmlp_ln, gmlp_w_s, gmlp_b_s,
              nsa_pe_k, nsa_w1_k, nsa_w2_k, nsa_pe_v, nsa_w1_v, nsa_w2_v,
              group_norm, w_o, ffn_norm,
              dense_w_gate, dense_w_up, dense_w_down,
              moe_router, moe_w_gate, moe_w_up, moe_w_down, final_norm):
    B, S, D = x.shape
    splits = np.cumsum(IN_SIZES)[:-1].tolist()
    h = x
    for l in range(DEPTH):
        xn = rms_norm(h, attn_norm[l])
        (cq, ckv, kr, cb, cc, chv, gu, gv,
         nq_, nkc, nvc, nks, nvs, nkw, nvw, ng) = jnp.split(xn @ w_in[l], splits, axis=-1)
        y_mla = mla_mixer(cq, ckv, kr, positions, mla_q_norm[l], mla_w_uq[l],
                          mla_kv_norm[l], mla_w_ukv[l])
        y_conv = short_conv_mixer(cb, cc, chv, conv_w[l])
        y_gmlp = gmlp_mixer(gu, gv, gmlp_ln[l], gmlp_w_s[l], gmlp_b_s[l])
        y_nsa = nsa_mixer(nq_, nkc, nvc, nks, nvs, nkw, nvw, ng,
                          nsa_pe_k[l], nsa_w1_k[l], nsa_w2_k[l],
                          nsa_pe_v[l], nsa_w1_v[l], nsa_w2_v[l])
        y = jnp.stack([y_mla, y_conv, y_gmlp, y_nsa], axis=2)
        y = rms_norm(y, group_norm[l]).reshape(B, S, D_MIX)
        h = h + y @ w_o[l]
        hn = rms_norm(h, ffn_norm[l])
        if l % 2 == 0:
            h = h + swiglu(hn, dense_w_gate[l // 2], dense_w_up[l // 2], dense_w_down[l // 2])
        else:
            h = h + moe_ffn(hn, moe_router[l // 2], moe_w_gate[l // 2], moe_w_up[l // 2],
                            moe_w_down[l // 2])
    return rms_norm(h, final_norm)
```

```cpp
#include <hip/hip_runtime.h>
#include <cstdio>
#include <cstdint>

#define LAS __attribute__((address_space(3)))
#define GAS __attribute__((address_space(1)))
typedef unsigned short bf16;
typedef short bf16x8 __attribute__((ext_vector_type(8)));
typedef float f32x4 __attribute__((ext_vector_type(4)));
typedef float f32x16 __attribute__((ext_vector_type(16)));
typedef unsigned u32x4 __attribute__((ext_vector_type(4)));
typedef unsigned u32x2 __attribute__((ext_vector_type(2)));
typedef float f32x2_t __attribute__((ext_vector_type(2)));
typedef __bf16 bf16x2_t __attribute__((ext_vector_type(2)));

constexpr int NB = 8, SEQ = 4096, T = NB * SEQ, DM = 1024, DEPTH = 4;
constexpr int DIN = 2348, PP = 2560;
constexpr int FF = 3584, NE = 8;
constexpr float EPS = 1e-6f;
constexpr float LOG2E = 1.4426950408889634f;
constexpr int C_CQ = 0, C_CKV = 256, C_NKC = 384, C_NVC = 448, C_CB = 512, C_CC = 768, C_CHV = 1024, C_GU = 1280, C_GV = 1536,
              C_NQ = 1792, C_NKS = 2048, C_NVS = 2112, C_NKW = 2176, C_NVW = 2240, C_KR = 2304, C_NG = 2336;

constexpr size_t MiB = 1u << 20;
constexpr size_t WS_CTL = 0, CTL_ZERO_BYTES = 1 * MiB;
constexpr size_t WS_CS = 1 * MiB;
constexpr size_t WS_LIST = 5 * MiB;
constexpr size_t WS_WL = 7 * MiB;
constexpr size_t WS_SSQ = 9 * MiB;
constexpr size_t WS_SSKV = WS_SSQ + MiB / 2;
constexpr size_t WS_KC = 10 * MiB;
constexpr size_t WS_VCT = WS_KC + 256 * 1024;
constexpr size_t WS_WQKV = 11 * MiB;
constexpr size_t WS_WGM = WS_WQKV + 768 * 1024;
constexpr size_t WS_W2T = WS_WGM + 128 * 1024;
constexpr size_t WS_BPE = WS_W2T + 64 * 1024;
constexpr size_t WS_W1T = 12 * MiB;
constexpr size_t WS_WIN = 14 * MiB;
constexpr size_t WS_WO = 19 * MiB;
constexpr size_t WS_WGU = 21 * MiB;
constexpr size_t WS_WD = 133 * MiB;
constexpr size_t WS_XN = 189 * MiB;
constexpr size_t WS_P = 253 * MiB;
constexpr size_t WS_QN = 414 * MiB;
constexpr size_t WS_QR = 430 * MiB;
constexpr size_t WS_KN = 438 * MiB;
constexpr size_t WS_KR = 454 * MiB;
constexpr size_t WS_VTM = 456 * MiB;
constexpr size_t WS_VTS = 472 * MiB;
constexpr size_t WS_VTW = 476 * MiB;
constexpr size_t WS_Y = 480 * MiB;
constexpr size_t WS_D1 = 544 * MiB;
constexpr size_t WS_ACT = 608 * MiB;
constexpr size_t WS_H = 720 * MiB;
constexpr size_t WS_ACTR = 784 * MiB;
constexpr size_t WS_END = 800 * MiB;
static_assert(WS_P + (size_t)(T + 64) * PP * 2 <= WS_QN, "P");
constexpr int CW_BAR = 4096;
constexpr int CW_CNT = 16384;

constexpr int NWAVES = 8;
constexpr int ARENA_BYTES = 143360;
constexpr int MISC_OFF = ARENA_BYTES;
constexpr int LDS_BYTES = 147456;

__device__ __forceinline__ unsigned pk2(float lo, float hi) { f32x2_t v = {lo, hi}; bf16x2_t b = __builtin_convertvector(v, bf16x2_t); return __builtin_bit_cast(unsigned, b); }
__device__ __forceinline__ float bf2f(unsigned short x) { return __uint_as_float(((unsigned)x) << 16); }
__device__ __forceinline__ float bflo(unsigned w) { return __uint_as_float(w << 16); }
__device__ __forceinline__ float bfhi(unsigned w) { return __uint_as_float(w & 0xffff0000u); }
__device__ __forceinline__ float wave_sum(float v) {
#pragma unroll
    for (int o = 1; o < 64; o <<= 1) v += __shfl_xor(v, o);
    return v;
}
__device__ __forceinline__ float gelu_tanh(float x) {
    const float u = 0.7978845608028654f * (x + 0.044715f * x * x * x);
    const float e = __builtin_amdgcn_exp2f(u * (2.0f * LOG2E));
    const float th = 1.0f - 2.0f * __builtin_amdgcn_rcpf(e + 1.0f);
    return 0.5f * x * (1.0f + th);
}
__device__ __forceinline__ float silu_f(float x) { return x * __builtin_amdgcn_rcpf(1.0f + __builtin_amdgcn_exp2f(-x * LOG2E)); }
__device__ __forceinline__ float sigmoid_f(float x) { return __builtin_amdgcn_rcpf(1.0f + __builtin_amdgcn_exp2f(-x * LOG2E)); }
#define LDS_WAIT() asm volatile("s_waitcnt lgkmcnt(0)" ::: "memory")
#define VM_WAIT() asm volatile("s_waitcnt vmcnt(0)" ::: "memory")

namespace pg8 {
constexpr int BM = 256, BK = 64, HALF = 128, HTB = HALF * BK * 2, STAGE_BYTES = 8 * HTB, NXCD = 8, WGM = 8;
__host__ __device__ __forceinline__ int lds_byte(int r, int c) { const int st = (r >> 4) * 2 + (c >> 5), rr = r & 15, cc = c & 31, ob = rr * 64 + cc * 2; return st * 1024 + (ob ^ (((ob >> 9) & 1) << 5)); }
__host__ __device__ __forceinline__ void stage_rc(int b, int& R, int& C) { const int st = b / 1024, sb = b % 1024, swz = sb ^ (((sb >> 9) & 1) << 5); R = (st >> 1) * 16 + swz / 64; C = (st & 1) * 32 + (swz % 64) / 2; }
__host__ __device__ __forceinline__ int perm32(int rho) { const int n = rho >> 4, i = rho & 15; return 8 * (i >> 2) + 4 * n + (i & 3); }

struct Unit { int pm, pn, e, aux, ne; };

struct RectOrder {
    int nM, nN, nwg, G, c;
    __device__ __forceinline__ void init(int nM_, int nN_, int G_, int c_) { nM = nM_; nN = nN_; nwg = nM * nN; G = G_; c = c_; }
    __device__ __forceinline__ bool get(int i, int& pm, int& pn) const { return getL((long)i * G + c, pm, pn); }
    __device__ __forceinline__ bool getL(long L, int& pm, int& pn) const {
        if (L >= nwg) return false;
        int wgid = (int)L; { const int q = nwg / NXCD, r = nwg % NXCD, xcd = wgid % NXCD, off = wgid / NXCD; wgid = (xcd < r ? xcd * (q + 1) : r * (q + 1) + (xcd - r) * q) + off; }
        const int nig = WGM * nN, gid = wgid / nig, fm = gid * WGM, gsz = (nM - fm) < WGM ? (nM - fm) : WGM;
        pm = fm + ((wgid % nig) % gsz); pn = (wgid % nig) / gsz; return true;
    }
};

template <class Epi, class Sched>
__device__ __forceinline__ void gemm_phase(LAS unsigned char* lds, const char* Abase, const int K, const int ldb  , const Sched& S, const Epi& E) {
    int tid = threadIdx.x; asm volatile("" : "+v"(tid));
    const int wid = __builtin_amdgcn_readfirstlane(tid >> 6), lane = tid & 63, wr = wid >> 2, wc = wid & 3, fr = lane & 15, fq = lane >> 4;
    int nt = K / BK; asm volatile("" : "+s"(nt));
    int R0, C0, R1, C1; stage_rc(tid * 16, R0, C0); stage_rc(tid * 16 + 8192, R1, C1);
    unsigned voffB[2];
    { const int Rb0 = Epi::PERM ? ((R0 & ~31) + perm32(R0 & 31)) : R0, Rb1 = Epi::PERM ? ((R1 & ~31) + perm32(R1 & 31)) : R1;
      voffB[0] = (unsigned)(Rb0 * ldb + C0) * 2u; voffB[1] = (unsigned)(Rb1 * ldb + C1) * 2u; }
    const size_t kstep = (size_t)(BK * 2);
    const size_t hstepB = (size_t)HALF * ldb * 2;
    const unsigned ldsw = (unsigned)wid * 1024u;
    const int aoff = lds_byte(wr * 64 + fr, fq * 8), boff = lds_byte(wc * 32 + fr, fq * 8);
#define PG8_SA(b, h) (((b) * 2 + (h)) * HTB)
#define PG8_SB(b, h) ((4 + (b) * 2 + (h)) * HTB)
#define PG8_GL(ubase, voff, dstoff) do { unsigned _o = (voff); asm volatile("" : "+v"(_o)); __builtin_amdgcn_global_load_lds((const unsigned*)((const char*)(ubase) + _o), (LAS unsigned*)(lds + (dstoff)), 16, 0, 0); } while (0)
#define PG8_STAGE_B(bufoff, gbase) do { PG8_GL(gbase, voffB[0], (bufoff) + ldsw); PG8_GL(gbase, voffB[1], (bufoff) + ldsw + 8192); } while (0)
#define PG8_STAGE_A0(bufoff, ub, kb) do { PG8_GL(Abase + ((ub) + (kb)), va00, (bufoff) + ldsw); PG8_GL(Abase + ((ub) + (kb)), va01, (bufoff) + ldsw + 8192); } while (0)
#define PG8_STAGE_A1(bufoff, ub, kb) do { PG8_GL(Abase + ((ub) + (kb) + hstepA), va10, (bufoff) + ldsw); PG8_GL(Abase + ((ub) + (kb) + hstepA), va11, (bufoff) + ldsw + 8192); } while (0)
#define PG8_LDA(dst, b, h) do { _Pragma("unroll") for (int m = 0; m < 4; ++m) _Pragma("unroll") for (int k = 0; k < 2; ++k) dst[m][k] = *(const LAS bf16x8*)(lds + PG8_SA(b, h) + aoff + m * 2048 + k * 1024); } while (0)
#define PG8_LDB(dst, b, h) do { _Pragma("unroll") for (int n = 0; n < 2; ++n) _Pragma("unroll") for (int k = 0; k < 2; ++k) dst[n][k] = *(const LAS bf16x8*)(lds + PG8_SB(b, h) + boff + n * 2048 + k * 1024); } while (0)
#define PG8_MMA(ai, bj, At, Bt) do { __builtin_amdgcn_s_setprio(1); _Pragma("unroll") for (int m = 0; m < 4; ++m) _Pragma("unroll") for (int n = 0; n < 2; ++n) _Pragma("unroll") for (int k = 0; k < 2; ++k) \
        acc[ai][bj][m][n] = __builtin_amdgcn_mfma_f32_16x16x32_bf16(Bt[n][k], At[m][k], acc[ai][bj][m][n], 0, 0, 0); __builtin_amdgcn_s_setprio(0); } while (0)
#define PG8_WAIT_V(n) asm volatile("s_waitcnt vmcnt(" #n ")" ::: "memory")
#define PG8_WAIT_L(n) asm volatile("s_waitcnt lgkmcnt(" #n ")" ::: "memory")
#define PG8_BAR __builtin_amdgcn_s_barrier()
#define PG8_SCHED __builtin_amdgcn_sched_barrier(0)
    Unit cur, nxt; int ui = 0;
    if (!S.next(0, cur)) return;
    f32x4 acc[2][2][4][2];
    float zf = 0.f; asm volatile("" : "+v"(zf));
#pragma unroll
    for (int a = 0; a < 2; ++a)
#pragma unroll
        for (int b = 0; b < 2; ++b)
#pragma unroll
            for (int m = 0; m < 4; ++m)
#pragma unroll
                for (int n = 0; n < 2; ++n) acc[a][b][m][n] = (f32x4){zf, zf, zf, zf};
    bf16x8 At[4][2], B0[2][2], B1[2][2];
    unsigned va00, va01, va10, va11; size_t cAb, hstepA;
    if constexpr (Sched::GATHER) { va00 = S.arow(cur, R0) + C0 * 2; va01 = S.arow(cur, R1) + C1 * 2; va10 = S.arow(cur, HALF + R0) + C0 * 2; va11 = S.arow(cur, HALF + R1) + C1 * 2; cAb = 0; hstepA = 0; }
    else { const unsigned l2 = S.lda2(); va00 = (unsigned)R0 * l2 + C0 * 2; va01 = (unsigned)R1 * l2 + C1 * 2; va10 = va00; va11 = va01; cAb = S.abase(cur); hstepA = (size_t)HALF * l2; }
    const char* cB = S.bbase(cur);
    PG8_STAGE_B(PG8_SB(0, 0), cB); PG8_STAGE_B(PG8_SB(0, 1), cB + hstepB); PG8_STAGE_A0(PG8_SA(0, 0), cAb, 0); PG8_STAGE_A1(PG8_SA(0, 1), cAb, 0);
    if (wr == 1) PG8_BAR;
    PG8_WAIT_V(2); PG8_BAR;
    PG8_STAGE_B(PG8_SB(1, 0), cB + kstep); PG8_STAGE_A0(PG8_SA(1, 0), cAb, kstep); PG8_STAGE_B(PG8_SB(1, 1), cB + hstepB + kstep);
    PG8_WAIT_V(6); PG8_BAR;
    for (;;) {
        const bool has_next = S.next(ui + 1, nxt);
        const char* nB = cB; size_t nAb = cAb;
        if (has_next) { nB = S.bbase(nxt); if constexpr (!Sched::GATHER) nAb = S.abase(nxt); }
        for (int t = 0; t < nt; t += 2) {
            const bool last = (t == nt - 2);
            const size_t k1 = (size_t)(t + 1) * kstep;
            const size_t k2 = last ? 0 : (size_t)(t + 2) * kstep, k3 = k2 + kstep;
            const size_t ab2 = last ? nAb : cAb;
            const char* b2 = last ? nB : cB + k2; const char* b3 = b2 + kstep;
            PG8_LDB(B0, 0, 0); PG8_LDB(B1, 0, 1); PG8_SCHED; PG8_LDA(At, 0, 0); PG8_STAGE_A1(PG8_SA(1, 1), cAb, k1);
            if constexpr (Sched::GATHER) { if (last && has_next) {
                va00 = S.arow(nxt, R0) + C0 * 2; va01 = S.arow(nxt, R1) + C1 * 2; va10 = S.arow(nxt, HALF + R0) + C0 * 2; va11 = S.arow(nxt, HALF + R1) + C1 * 2; } }
            PG8_WAIT_V(8); PG8_WAIT_L(0); PG8_BAR; PG8_MMA(0, 0, At, B0); PG8_MMA(0, 1, At, B1); PG8_BAR; PG8_SCHED;
            PG8_LDA(At, 0, 1); PG8_STAGE_B(PG8_SB(0, 0), b2); PG8_STAGE_B(PG8_SB(0, 1), b2 + hstepB); PG8_STAGE_A0(PG8_SA(0, 0), ab2, k2);
            PG8_WAIT_V(8); PG8_WAIT_L(0); PG8_BAR; PG8_MMA(1, 0, At, B0); PG8_MMA(1, 1, At, B1); PG8_BAR; PG8_SCHED;
            PG8_LDB(B0, 1, 0); PG8_LDB(B1, 1, 1); PG8_SCHED; PG8_LDA(At, 1, 0); PG8_STAGE_A1(PG8_SA(0, 1), ab2, k2);
            PG8_WAIT_V(8); PG8_WAIT_L(0); PG8_BAR; PG8_MMA(0, 0, At, B0); PG8_MMA(0, 1, At, B1); PG8_BAR; PG8_SCHED;
            PG8_LDA(At, 1, 1); PG8_STAGE_B(PG8_SB(1, 0), b3); PG8_STAGE_B(PG8_SB(1, 1), b3 + hstepB); PG8_STAGE_A0(PG8_SA(1, 0), ab2, k3);
            PG8_WAIT_V(8); PG8_WAIT_L(0); PG8_BAR; PG8_MMA(1, 0, At, B0); PG8_MMA(1, 1, At, B1); PG8_BAR; PG8_SCHED;
        }
        if (wr == 0) PG8_BAR;
        E(acc, cur, wr, wc, fr, fq);
        if (!has_next) break;
        zf = 0.f; asm volatile("" : "+v"(zf));
#pragma unroll
        for (int a = 0; a < 2; ++a)
#pragma unroll
            for (int b = 0; b < 2; ++b)
#pragma unroll
                for (int m = 0; m < 4; ++m)
#pragma unroll
                    for (int n = 0; n < 2; ++n) acc[a][b][m][n] = (f32x4){zf, zf, zf, zf};
        cur = nxt; cB = nB; cAb = nAb; ++ui;
        if (wr == 1) PG8_BAR;
    }
    PG8_WAIT_V(0);
    PG8_BAR;
#undef PG8_SA
#undef PG8_SB
#undef PG8_GL
#undef PG8_STAGE_A0
#undef PG8_STAGE_A1
#undef PG8_STAGE_B
#undef PG8_LDA
#undef PG8_LDB
#undef PG8_MMA
#undef PG8_WAIT_V
#undef PG8_WAIT_L
#undef PG8_BAR
#undef PG8_SCHED
}
}

#define XB_TMO      128
#define XB_XCNT(j)  (256  + 64 * (j))
#define XB_XSUB(j)  (1280 + 64 * (j))
#define XB_XGEN(j)  (2304 + 64 * (j))
#define XB_TOP      3328
#define XB_TOPGEN   3392
#define XCD_BAR_WORDS 3456
#define XB_SPIN_CAP (1u << 18)
__device__ __forceinline__ unsigned xb_ld(unsigned* p)              { return __hip_atomic_load(p, __ATOMIC_RELAXED, __HIP_MEMORY_SCOPE_AGENT); }
__device__ __forceinline__ unsigned xb_add(unsigned* p, unsigned v) { return __hip_atomic_fetch_add(p, v, __ATOMIC_RELAXED, __HIP_MEMORY_SCOPE_AGENT); }
__device__ __forceinline__ unsigned xb_xcc_id() { return (unsigned)__builtin_amdgcn_s_getreg((3 << 11) | 20) & 0xFu; }
#define XB_SPIN(cond, bar) do { unsigned _sp = 0; while (cond) { __builtin_amdgcn_s_sleep(1); \
    if ((++_sp & 255u) == 0u) { if (xb_ld(&(bar)[XB_TMO])) break; if (_sp > XB_SPIN_CAP) { atomicAdd(&(bar)[XB_TMO], 1u); break; } } } } while (0)
struct XcdBarrier { unsigned* bar; unsigned x; volatile LAS unsigned* st; };
__device__ __forceinline__ XcdBarrier xcd_barrier_post(unsigned* bar, volatile LAS unsigned* st) {
    XcdBarrier b; b.bar = bar; b.x = xb_xcc_id(); b.st = st;
    if (threadIdx.x == 0) (void)xb_add(&bar[XB_XCNT(b.x)], 1u);
    return b;
}
__device__ __forceinline__ void xcd_barrier_complete(unsigned* bar, unsigned x, unsigned& nloc, unsigned& nx) {
    const unsigned G = gridDim.x * gridDim.y * gridDim.z;
    unsigned sum, cnt, mine, sp = 0u;
    for (;;) {
        sum = 0u; cnt = 0u; mine = 0u;
#pragma unroll
        for (unsigned j = 0; j < 16; ++j) { const unsigned c = xb_ld(&bar[XB_XCNT(j)]); sum += c; cnt += (c > 0u) ? 1u : 0u; mine = (j == x) ? c : mine; }
        if (sum == G) break;
        __builtin_amdgcn_s_sleep(1);
        if ((++sp & 255u) == 0u) { if (xb_ld(&bar[XB_TMO])) break; if (sp > XB_SPIN_CAP) { atomicAdd(&bar[XB_TMO], 1u); break; } }
    }
    nloc = mine > 0u ? mine : 1u; nx = cnt > 0u ? cnt : 1u;
}
__device__ __forceinline__ void xcd_barrier(const XcdBarrier& b, unsigned* bar) {
    asm volatile("s_waitcnt vmcnt(0)" ::: "memory");
    __syncthreads();
    if (threadIdx.x == 0) {
        __builtin_amdgcn_s_waitcnt(0);
        unsigned nloc = b.st[0], nx = b.st[1];
        if (nloc == 0u) { xcd_barrier_complete(bar, b.x, nloc, nx); b.st[0] = nloc; b.st[1] = nx; }
        const unsigned old = xb_add(&bar[XB_XSUB(b.x)], 1u);
        const unsigned gen = old / nloc;
        if (old + 1u == (gen + 1u) * nloc) {
            __builtin_amdgcn_fence(__ATOMIC_RELEASE, "agent");
            asm volatile("s_waitcnt vmcnt(0)" ::: "memory");
            const unsigned og = xb_add(&bar[XB_TOP], 1u);
            const unsigned tg = og / nx;
            if (og + 1u == (tg + 1u) * nx) xb_add(&bar[XB_TOPGEN], 1u);
            else XB_SPIN(xb_ld(&bar[XB_TOPGEN]) == tg, bar);
            __builtin_amdgcn_fence(__ATOMIC_ACQUIRE, "agent");
            xb_add(&bar[XB_XGEN(b.x)], 1u);
            asm volatile("s_waitcnt vmcnt(0)" ::: "memory");
        } else {
            XB_SPIN(xb_ld(&bar[XB_XGEN(b.x)]) == gen, bar);
            __builtin_amdgcn_fence(__ATOMIC_ACQUIRE, "agent");
            asm volatile("s_waitcnt vmcnt(0)" ::: "memory");
        }
    }
    __syncthreads();
}

struct Args { const float* in[29]; float* out; unsigned char* ws; int ph_lo, ph_hi; };
static_assert(sizeof(Args) == 29 * 8 + 8 + 8 + 8, "Args has no padding");
enum { I_X = 0, I_POS, I_ATTN_NORM, I_W_IN, I_Q_NORM, I_W_UQ, I_KV_NORM, I_W_UKV, I_CONV_W, I_GMLP_LN, I_GMLP_WS, I_GMLP_BS,
       I_PE_K, I_W1_K, I_W2_K, I_PE_V, I_W1_V, I_W2_V, I_GROUP_NORM, I_W_O, I_FFN_NORM, I_DW_GATE, I_DW_UP, I_DW_DOWN,
       I_ROUTER, I_MW_GATE, I_MW_UP, I_MW_DOWN, I_FINAL_NORM };

typedef GAS const float* __attribute__((address_space(4))) const volatile* kargtab_t;
__device__ __forceinline__ const float* argp(int i) { kargtab_t p = (kargtab_t)__builtin_amdgcn_kernarg_segment_ptr(); GAS const float* g = p[i]; return (const float*)g; }

struct Ctx {
    LAS unsigned char* lds;
    GAS unsigned char* ws;
    int tid, lane, wave, G, bid;
};
__device__ __forceinline__ Ctx fresh(const Ctx& c0) { Ctx c = c0; asm volatile("" : "+v"(c.tid)); asm volatile("" : "+s"(c.ws)); asm volatile("" : "+s"(c.lds)); c.lane = c.tid & 63; return c; }

enum { K_WIN = 0, K_UQ, K_UKV, K_ID, K_GATE, K_UP };
__device__ __forceinline__ int map_col(int kind, int j, float& scale) {
    scale = 1.0f;
    switch (kind) {
    case K_WIN:
        if (j < 384) return j;
        if (j < 416) { const int i = j - 384; return C_KR + (i < 16 ? 2 * i : 2 * (i - 16) + 1); }
        if (j < 672) return C_CB + (j - 416);
        if (j < 928) return C_CC + (j - 672);
        if (j < 1184) return C_CHV + (j - 928);
        if (j < 1440) return C_GU + (j - 1184);
        if (j < 1696) return C_GV + (j - 1440);
        if (j < 1952) { scale = 0.125f * LOG2E; return C_NQ + (j - 1696); }
        if (j < 2016) return C_NKC + (j - 1952);
        if (j < 2080) return C_NVC + (j - 2016);
        if (j < 2144) return C_NKS + (j - 2080);
        if (j < 2208) return C_NVS + (j - 2144);
        if (j < 2272) return C_NKW + (j - 2208);
        if (j < 2336) return C_NVW + (j - 2272);
        return C_NG + (j - 2336);
    case K_UQ: {
        const int h = j / 96, x = j % 96; scale = 0.10206207261596575f * LOG2E;
        if (x < 64) return h * 64 + x;
        const int i = x - 64; return 256 + h * 32 + (i < 16 ? 2 * i : 2 * (i - 16) + 1); }
    case K_UKV: {
        const int h = j >> 7, x = j & 127;
        return x < 64 ? 512 + h * 64 + x : 768 + h * 64 + (x - 64); }
    case K_GATE: return (j >> 7) * 256 + (j & 127);
    case K_UP:   return (j >> 7) * 256 + 128 + (j & 127);
    default: return j;
    }
}
__device__ __forceinline__ void conv_item(const float* src, int src_ld, int nsrc, const float* gain, bf16* dst, int dst_ld, int kdst0, int kind, int nblk, int item, LAS float* scr, int lane) {
    const int kb = item / nblk, nb = item % nblk, k0 = 64 * kb, j0 = 64 * nb;
    const int jr = j0 + 4 * (lane & 15), kr = lane >> 4;
    const int jc = jr < nsrc ? jr : nsrc - 4;
    f32x4 v[16];
#pragma unroll
    for (int i = 0; i < 16; ++i) v[i] = __builtin_nontemporal_load((const f32x4*)(src + (size_t)(k0 + 4 * i + kr) * src_ld + jc));
    float gv[16];
    if (gain) {
#pragma unroll
        for (int i = 0; i < 16; ++i) gv[i] = gain[k0 + 4 * i + kr];
    } else {
#pragma unroll
        for (int i = 0; i < 16; ++i) gv[i] = 1.0f;
    }
#pragma unroll
    for (int i = 0; i < 16; ++i) { const int kk = 4 * i + kr; const float g = gv[i]; LAS float* p = scr + kk * 65 + 4 * (lane & 15);
        p[0] = v[i][0] * g; p[1] = v[i][1] * g; p[2] = v[i][2] * g; p[3] = v[i][3] * g; }
    LDS_WAIT(); asm volatile("" ::: "memory");
    const int c = lane & 7;
#pragma unroll
    for (int jj = 0; jj < 8; ++jj) { const int n = (lane >> 3) + 8 * jj; const int j = j0 + n;
        if (j < nsrc) { float sc; const int drow = map_col(kind, j, sc); const LAS float* s = scr + (8 * c) * 65 + n;
            u32x4 o; o.x = pk2(s[0 * 65] * sc, s[1 * 65] * sc); o.y = pk2(s[2 * 65] * sc, s[3 * 65] * sc); o.z = pk2(s[4 * 65] * sc, s[5 * 65] * sc); o.w = pk2(s[6 * 65] * sc, s[7 * 65] * sc);
            *(u32x4*)(dst + (size_t)drow * dst_ld + kdst0 + k0 + 8 * c) = o; } }
    LDS_WAIT(); asm volatile("" ::: "memory");
}

__device__ __forceinline__ void zero_rect(bf16* dst, int ld, int r0, int r1, int c0, int c1, int gtid, int nthr) {
    const int nch = (c1 - c0) >> 3, total = (r1 - r0) * nch;
    for (int idx = gtid; idx < total; idx += nthr) { const int r = idx / nch, c = idx % nch; unsigned z = 0u; asm volatile("" : "+v"(z)); *(u32x4*)(dst + (size_t)(r0 + r) * ld + c0 + 8 * c) = (u32x4){z, z, z, z}; }
}

__device__ __forceinline__ void convert_weights(const Args& a, const Ctx& c0, int l) {
    const Ctx c = fresh(c0);
    LAS float* scr = (LAS float*)(c.lds + c.wave * 16640);
    const int gw = c.bid * NWAVES + c.wave, NGW = c.G * NWAVES, gtid = c.bid * (NWAVES * 64) + c.tid, NT = c.G * NWAVES * 64;
    GAS unsigned char* ws = c.ws;
    const int nexp = (l & 1) ? NE : 1;
    constexpr int I_WIN = 37 * 16, I_UQ = 6 * 4, I_UKV = 8 * 2, I_WOI = 16 * 16, I_W1 = 4 * 32, I_W2 = 1 * 4, I_GU = 56 * 16, I_DN = 16 * 56;
    const int n_fixed = I_WIN + I_UQ + I_UKV + I_WOI + 2 * I_W1 + 2 * I_W2;
    const int n_total = n_fixed + nexp * (2 * I_GU + I_DN);
    const float* wg_src = (l & 1) ? argp(I_MW_GATE) + (size_t)(l >> 1) * NE * DM * FF : argp(I_DW_GATE) + (size_t)(l >> 1) * DM * FF;
    const float* wu_src = (l & 1) ? argp(I_MW_UP) + (size_t)(l >> 1) * NE * DM * FF : argp(I_DW_UP) + (size_t)(l >> 1) * DM * FF;
    const float* wd_src = (l & 1) ? argp(I_MW_DOWN) + (size_t)(l >> 1) * NE * DM * FF : argp(I_DW_DOWN) + (size_t)(l >> 1) * DM * FF;
    for (int it = gw; it < n_total; it += NGW) {
        int r = it;
        if (r < I_WIN) { conv_item(argp(I_W_IN) + (size_t)l * DM * DIN, DIN, DIN, argp(I_ATTN_NORM) + l * DM, (bf16*)(ws + WS_WIN), DM, 0, K_WIN, 37, r, scr, c.lane); continue; } r -= I_WIN;
        if (r < I_UQ) { conv_item(argp(I_W_UQ) + (size_t)l * 256 * 384, 384, 384, argp(I_Q_NORM) + l * 256, (bf16*)(ws + WS_WQKV), 384, 0, K_UQ, 6, r, scr, c.lane); continue; } r -= I_UQ;
        if (r < I_UKV) { conv_item(argp(I_W_UKV) + (size_t)l * 128 * 512, 512, 512, argp(I_KV_NORM) + l * 128, (bf16*)(ws + WS_WQKV), 384, 256, K_UKV, 8, r, scr, c.lane); continue; } r -= I_UKV;
        if (r < I_WOI) { conv_item(argp(I_W_O) + (size_t)l * DM * DM, DM, DM, argp(I_GROUP_NORM) + l * DM, (bf16*)(ws + WS_WO), DM, 0, K_ID, 16, r, scr, c.lane); continue; } r -= I_WOI;
        if (r < I_W1) { conv_item(argp(I_W1_K) + (size_t)l * 2048 * 256, 256, 256, nullptr, (bf16*)(ws + WS_W1T), 2048, 0, K_ID, 4, r, scr, c.lane); continue; } r -= I_W1;
        if (r < I_W1) { conv_item(argp(I_W1_V) + (size_t)l * 2048 * 256, 256, 256, nullptr, (bf16*)(ws + WS_W1T) + 256 * 2048, 2048, 0, K_ID, 4, r, scr, c.lane); continue; } r -= I_W1;
        if (r < I_W2) { conv_item(argp(I_W2_K) + (size_t)l * 256 * 64, 64, 64, nullptr, (bf16*)(ws + WS_W2T), 256, 0, K_ID, 1, r, scr, c.lane); continue; } r -= I_W2;
        if (r < I_W2) { conv_item(argp(I_W2_V) + (size_t)l * 256 * 64, 64, 64, nullptr, (bf16*)(ws + WS_W2T) + 64 * 256, 256, 0, K_ID, 1, r, scr, c.lane); continue; } r -= I_W2;
        const int e = r / (2 * I_GU + I_DN); r -= e * (2 * I_GU + I_DN);
        if (r < I_GU) { conv_item(wg_src + (size_t)e * DM * FF, FF, FF, argp(I_FFN_NORM) + l * DM, (bf16*)(ws + WS_WGU) + (size_t)e * 2 * FF * DM, DM, 0, K_GATE, 56, r, scr, c.lane); continue; } r -= I_GU;
        if (r < I_GU) { conv_item(wu_src + (size_t)e * DM * FF, FF, FF, argp(I_FFN_NORM) + l * DM, (bf16*)(ws + WS_WGU) + (size_t)e * 2 * FF * DM, DM, 0, K_UP, 56, r, scr, c.lane); continue; } r -= I_GU;
        conv_item(wd_src + (size_t)e * FF * DM, DM, DM, nullptr, (bf16*)(ws + WS_WD) + (size_t)e * DM * FF, FF, 0, K_ID, 16, r, scr, c.lane);
    }
    zero_rect((bf16*)(ws + WS_WIN), DM, DIN, PP, 0, DM, gtid, NT);
    zero_rect((bf16*)(ws + WS_WQKV), 384, 0, 384, 256, 384, gtid, NT);
    zero_rect((bf16*)(ws + WS_WQKV), 384, 384, 512, 0, 384, gtid, NT);
    zero_rect((bf16*)(ws + WS_WQKV), 384, 512, 1024, 0, 256, gtid, NT);
    { const float* wsrc = argp(I_GMLP_WS) + (size_t)l * 4 * 128 * 128; unsigned* d = (unsigned*)(ws + WS_WGM);
      for (int idx = gtid; idx < 4 * 128 * 64; idx += NT) { const int j = (idx & 63) * 2, i = (idx >> 6) & 127;
          const float v0 = (j <= i) ? wsrc[2 * idx] : 0.f, v1 = (j + 1 <= i) ? wsrc[2 * idx + 1] : 0.f; d[idx] = pk2(v0, v1); } }
    for (int o = gw; o < 512; o += NGW) { const int kv = o >> 8, cc = o & 255; const float* pe = argp(kv ? I_PE_V : I_PE_K) + (size_t)l * 2048; const float* w1 = argp(kv ? I_W1_V : I_W1_K) + (size_t)l * 2048 * 256;
        float sacc = 0.f;
#pragma unroll 8
        for (int i = 0; i < 32; ++i) { const int k = i * 64 + c.lane; sacc += pe[k] * w1[(size_t)k * 256 + cc]; }
        sacc = wave_sum(sacc); if (c.lane == 0) ((float*)(ws + WS_BPE))[o] = sacc; }
    if (l == 0) { const int* pos = (const int*)argp(I_POS); f32x2_t* cs = (f32x2_t*)(ws + WS_CS);
        for (int idx = gtid; idx < T * 16; idx += NT) { const int tk = idx >> 4, i = idx & 15;
            const float inv = __builtin_amdgcn_exp2f(-(float)i * (13.287712379549449f / 16.0f));
            const float ang = (float)pos[tk] * inv; float rev = ang * 0.15915494309189535f; rev -= floorf(rev);
            cs[idx] = (f32x2_t){__builtin_amdgcn_cosf(rev), __builtin_amdgcn_sinf(rev)}; } }
}

template <int MODE>
__device__ __forceinline__ void norm_pass(const Args& a, const Ctx& c0, const float* hsrc, const bf16* add0, const bf16* add1, bool write_h, int l) {
    const Ctx c = fresh(c0);
    const int gw = c.bid * NWAVES + c.wave, NGW = c.G * NWAVES, lane = c.lane;
    float* hout = a.out; bf16* XN = (bf16*)(c.ws + WS_XN); bf16* Hb = (bf16*)(c.ws + WS_H);
    constexpr int R = 4;
    for (int row0 = gw; row0 < T; row0 += R * NGW) {
        f32x4 v[R][4]; u32x2 a0[R][4], a1[R][4];
#pragma unroll
        for (int r = 0; r < R; ++r) { const int row = row0 + r * NGW; const size_t ro = (size_t)(row < T ? row : 0) * DM;
#pragma unroll
            for (int j = 0; j < 4; ++j) { a0[r][j] = (u32x2){0u, 0u}; a1[r][j] = (u32x2){0u, 0u}; } }
        if (hsrc) {
#pragma unroll
            for (int r = 0; r < R; ++r) { const int row = row0 + r * NGW; const size_t ro = (size_t)(row < T ? row : 0) * DM;
#pragma unroll
                for (int j = 0; j < 4; ++j) v[r][j] = *(const f32x4*)(hsrc + ro + 4 * lane + 256 * j); }
        } else {
#pragma unroll
            for (int r = 0; r < R; ++r) { const int row = row0 + r * NGW; const size_t ro = (size_t)(row < T ? row : 0) * DM;
#pragma unroll
                for (int j = 0; j < 4; ++j) { const u32x2 hw = *(const u32x2*)(Hb + ro + 4 * lane + 256 * j); v[r][j] = (f32x4){bflo(hw.x), bfhi(hw.x), bflo(hw.y), bfhi(hw.y)}; } }
        }
        if (add0) {
#pragma unroll
            for (int r = 0; r < R; ++r) { const int row = row0 + r * NGW; const size_t ro = (size_t)(row < T ? row : 0) * DM;
#pragma unroll
                for (int j = 0; j < 4; ++j) a0[r][j] = *(const u32x2*)(add0 + ro + 4 * lane + 256 * j); } }
        if (add1) {
#pragma unroll
            for (int r = 0; r < R; ++r) { const int row = row0 + r * NGW; const size_t ro = (size_t)(row < T ? row : 0) * DM;
#pragma unroll
                for (int j = 0; j < 4; ++j) a1[r][j] = *(const u32x2*)(add1 + ro + 4 * lane + 256 * j); } }
#pragma unroll
        for (int r = 0; r < R; ++r) { const int row = row0 + r * NGW; if (row >= T) break; const size_t ro = (size_t)row * DM;
            float ss = 0.f;
#pragma unroll
            for (int j = 0; j < 4; ++j) { f32x4& x = v[r][j];
                x[0] += bflo(a0[r][j].x) + bflo(a1[r][j].x); x[1] += bfhi(a0[r][j].x) + bfhi(a1[r][j].x); x[2] += bflo(a0[r][j].y) + bflo(a1[r][j].y); x[3] += bfhi(a0[r][j].y) + bfhi(a1[r][j].y);
                ss += (x[0] * x[0] + x[1] * x[1]) + (x[2] * x[2] + x[3] * x[3]); }
            const float rstd = 1.0f / sqrtf(wave_sum(ss) * (1.0f / DM) + EPS);
            if (MODE == 2) {
                const float* g = argp(I_FINAL_NORM);
#pragma unroll
                for (int j = 0; j < 4; ++j) { const f32x4 gv = *(const f32x4*)(g + 4 * lane + 256 * j); *(f32x4*)(hout + ro + 4 * lane + 256 * j) = v[r][j] * rstd * gv; }
            } else {
                if (write_h) {
#pragma unroll
                    for (int j = 0; j < 4; ++j) { u32x2 hw; hw.x = pk2(v[r][j][0], v[r][j][1]); hw.y = pk2(v[r][j][2], v[r][j][3]); *(u32x2*)(Hb + ro + 4 * lane + 256 * j) = hw; }
                }
#pragma unroll
                for (int j = 0; j < 4; ++j) { u32x2 w; w.x = pk2(v[r][j][0] * rstd, v[r][j][1] * rstd); w.y = pk2(v[r][j][2] * rstd, v[r][j][3] * rstd); *(u32x2*)(XN + ro + 4 * lane + 256 * j) = w; }
                if (MODE == 1 && (l & 1)) {
                    const float* g = argp(I_FFN_NORM) + l * DM; const float* wr = argp(I_ROUTER) + (size_t)(l >> 1) * DM * NE;
                    float lg[8];
#pragma unroll
                    for (int e = 0; e < 8; ++e) lg[e] = 0.f;
#pragma unroll
                    for (int j = 0; j < 4; ++j) { const f32x4 gv = *(const f32x4*)(g + 4 * lane + 256 * j);
#pragma unroll
                        for (int i = 0; i < 4; ++i) { const float hn = v[r][j][i] * rstd * gv[i]; const int k = 4 * lane + 256 * j + i;
                            const f32x4 w0 = *(const f32x4*)(wr + (size_t)k * 8), w1 = *(const f32x4*)(wr + (size_t)k * 8 + 4);
                            lg[0] += hn * w0.x; lg[1] += hn * w0.y; lg[2] += hn * w0.z; lg[3] += hn * w0.w; lg[4] += hn * w1.x; lg[5] += hn * w1.y; lg[6] += hn * w1.z; lg[7] += hn * w1.w; } }
#pragma unroll
                    for (int e = 0; e < 8; ++e) lg[e] = wave_sum(lg[e]);
                    int i0 = 0; float l0 = lg[0];
#pragma unroll
                    for (int e = 1; e < 8; ++e) if (lg[e] > l0) { l0 = lg[e]; i0 = e; }
                    int i1 = -1; float l1 = -3.0e38f;
#pragma unroll
                    for (int e = 0; e < 8; ++e) if (e != i0 && lg[e] > l1) { l1 = lg[e]; i1 = e; }
                    const float w0 = 1.0f / (1.0f + __expf(l1 - l0)), w1 = 1.0f - w0;
                    if (lane == 0) {
                        unsigned* cnt = (unsigned*)(c.ws + WS_CTL) + CW_CNT + (l >> 1) * 8 * 64;
                        unsigned* list = (unsigned*)(c.ws + WS_LIST) + (size_t)(l >> 1) * NE * T; float* wl = (float*)(c.ws + WS_WL) + (size_t)(l >> 1) * NE * T;
                        const unsigned p0 = __hip_atomic_fetch_add(cnt + 64 * i0, 1u, __ATOMIC_RELAXED, __HIP_MEMORY_SCOPE_AGENT);
                        list[(size_t)i0 * T + p0] = (unsigned)row * 2u; wl[(size_t)i0 * T + p0] = w0;
                        const unsigned p1 = __hip_atomic_fetch_add(cnt + 64 * i1, 1u, __ATOMIC_RELAXED, __HIP_MEMORY_SCOPE_AGENT);
                        list[(size_t)i1 * T + p1] = (unsigned)row * 2u + 1u; wl[(size_t)i1 * T + p1] = w1;
                    }
                }
            }
        }
    }
}

typedef pg8::Unit Unit;
struct SchedPlain {
    pg8::RectOrder R; unsigned lda2_; const char* B; size_t btile;
    __device__ __forceinline__ bool next(int i, Unit& u) const { u.e = 0; u.aux = 0; u.ne = 0; return R.get(i, u.pm, u.pn); }
    static constexpr bool GATHER = false;
    __device__ __forceinline__ size_t abase(const Unit& u) const { return (size_t)u.pm * 256 * lda2_; }
    __device__ __forceinline__ unsigned lda2() const { return lda2_; }
    __device__ __forceinline__ const char* bbase(const Unit& u) const { return B + (size_t)u.pn * btile; }
};
struct MoeMap {
    int pre1, pre2, pre3, pre4, pre5, pre6, pre7, pre8;
    int c0, c1, c2, c3, c4, c5, c6, c7;
    const unsigned* list; const float* wl;
    __device__ __forceinline__ void locate(int pm, int& e, int& lt, int& ne) const {
        e = 0; lt = pm; ne = c0;
        if (pm >= pre1) { e = 1; lt = pm - pre1; ne = c1; } if (pm >= pre2) { e = 2; lt = pm - pre2; ne = c2; } if (pm >= pre3) { e = 3; lt = pm - pre3; ne = c3; }
        if (pm >= pre4) { e = 4; lt = pm - pre4; ne = c4; } if (pm >= pre5) { e = 5; lt = pm - pre5; ne = c5; } if (pm >= pre6) { e = 6; lt = pm - pre6; ne = c6; }
        if (pm >= pre7) { e = 7; lt = pm - pre7; ne = c7; }
    }
};
__device__ __forceinline__ MoeMap make_moemap(const Ctx& c, int l) {
    MoeMap m;
    if (l & 1) {
        unsigned* cnt = (unsigned*)(c.ws + WS_CTL) + CW_CNT + (l >> 1) * 8 * 64;
        int n[8];
#pragma unroll
        for (int e = 0; e < 8; ++e) n[e] = __builtin_amdgcn_readfirstlane((int)__hip_atomic_load(cnt + 64 * e, __ATOMIC_RELAXED, __HIP_MEMORY_SCOPE_AGENT));
        m.c0 = n[0]; m.c1 = n[1]; m.c2 = n[2]; m.c3 = n[3]; m.c4 = n[4]; m.c5 = n[5]; m.c6 = n[6]; m.c7 = n[7];
        m.pre1 = (n[0] + 255) >> 8; m.pre2 = m.pre1 + ((n[1] + 255) >> 8); m.pre3 = m.pre2 + ((n[2] + 255) >> 8); m.pre4 = m.pre3 + ((n[3] + 255) >> 8);
        m.pre5 = m.pre4 + ((n[4] + 255) >> 8); m.pre6 = m.pre5 + ((n[5] + 255) >> 8); m.pre7 = m.pre6 + ((n[6] + 255) >> 8); m.pre8 = m.pre7 + ((n[7] + 255) >> 8);
        m.list = (const unsigned*)(c.ws + WS_LIST) + (size_t)(l >> 1) * NE * T; m.wl = (const float*)(c.ws + WS_WL) + (size_t)(l >> 1) * NE * T;
    } else {
        m.c0 = T; m.c1 = m.c2 = m.c3 = m.c4 = m.c5 = m.c6 = m.c7 = 0;
        m.pre1 = m.pre2 = m.pre3 = m.pre4 = m.pre5 = m.pre6 = m.pre7 = m.pre8 = T / 256;
        m.list = nullptr; m.wl = nullptr;
    }
    return m;
}
struct SchedGateUp {
    static constexpr bool GATHER = true;
    pg8::RectOrder R; MoeMap M; int t0; const char* B;
    int nd;
    __device__ __forceinline__ bool next(int i, Unit& u) const {
        long L;
        if (nd == 0) L = (long)i * R.G + R.c;
        else if (R.c < nd) { if (i >= 4) return false; L = (long)(i + 3) * R.G + R.c; }
        else { if (i < 7) L = (long)i * R.G + R.c; else if (i == 7) { const int o = R.c - nd; if (o >= 3 * nd) return false; L = (long)(o / nd) * R.G + (o % nd); } else return false; }
        int pm, pn; if (!R.getL(L, pm, pn)) return false; u.pm = t0 + pm; u.pn = pn; M.locate(u.pm, u.e, u.aux, u.ne); return true; }
    __device__ __forceinline__ unsigned arow(const Unit& u, int r) const {
        const int ne = u.ne; int idx = u.aux * 256 + r; idx = idx < ne ? idx : ne - 1;
        const unsigned tok = M.list ? (M.list[(size_t)u.e * T + idx] >> 1) : (unsigned)idx;
        return tok * (unsigned)(DM * 2); }
    __device__ __forceinline__ const char* bbase(const Unit& u) const { return B + ((size_t)u.e * 2 * FF + (size_t)u.pn * 256) * DM * 2; }
};
struct SchedDown {
    pg8::RectOrder R; MoeMap M; int t0; const char* B;
    __device__ __forceinline__ bool next(int i, Unit& u) const { int pm, pn; if (!R.get(i, pm, pn)) return false; u.pm = t0 + pm; u.pn = pn; M.locate(u.pm, u.e, u.aux, u.ne); return true; }
    static constexpr bool GATHER = false;
    __device__ __forceinline__ size_t abase(const Unit& u) const { return (size_t)(u.pm - t0) * 256 * (FF * 2); }
    __device__ __forceinline__ unsigned lda2() const { return (unsigned)(FF * 2); }
    __device__ __forceinline__ const char* bbase(const Unit& u) const { return B + ((size_t)u.e * DM + (size_t)u.pn * 256) * FF * 2; }
};

#define EPI_ARGS const f32x4 (&acc)[2][2][4][2], const Unit& u, int wr, int wc, int fr, int fq
struct EpiInProj {
    static constexpr bool PERM = true;
    bf16* P; float* ssq; float* sskv;
    __device__ __forceinline__ void operator()(EPI_ARGS) const {
#pragma unroll
        for (int ai = 0; ai < 2; ++ai)
#pragma unroll
            for (int m = 0; m < 4; ++m) {
                const int row = u.pm * 256 + ai * 128 + wr * 64 + m * 16 + fr;
                float s0 = 0.f, s1 = 0.f;
#pragma unroll
                for (int bj = 0; bj < 2; ++bj) { const f32x4 v0 = acc[ai][bj][m][0], v1 = acc[ai][bj][m][1];
                    u32x4 w; w.x = pk2(v0[0], v0[1]); w.y = pk2(v0[2], v0[3]); w.z = pk2(v1[0], v1[1]); w.w = pk2(v1[2], v1[3]);
                    *(u32x4*)(P + (size_t)row * PP + u.pn * 256 + bj * 128 + wc * 32 + 8 * fq) = w;
                    const float s = (v0[0] * v0[0] + v0[1] * v0[1]) + (v0[2] * v0[2] + v0[3] * v0[3]) + (v1[0] * v1[0] + v1[1] * v1[1]) + (v1[2] * v1[2] + v1[3] * v1[3]);
                    if (bj == 0) s0 = s; else s1 = s; }
                if (u.pn == 0) { float s = s0 + s1; s += __shfl_xor(s, 16); s += __shfl_xor(s, 32); if (fq == 0) ssq[row * 4 + wc] = s; }
                else if (u.pn == 1) { float s = s0; s += __shfl_xor(s, 16); s += __shfl_xor(s, 32); if (fq == 0) sskv[row * 4 + wc] = s; }
            }
    }
};
struct EpiQkv {
    static constexpr bool PERM = true;
    const float* ssq; const float* sskv; const f32x2_t* cs; bf16 *Qn, *Qr, *Kn, *Vt;
    __device__ __forceinline__ float rstd_of(const float* ss, int row, float invn) const { const f32x4 p = *(const f32x4*)(ss + row * 4); return 1.0f / sqrtf(((p.x + p.y) + (p.z + p.w)) * invn + EPS); }
    __device__ __forceinline__ void operator()(EPI_ARGS) const {
        if (u.pn == 0 || u.pn == 2) {
            bf16* O = u.pn == 0 ? Qn : Kn; const float* ss = u.pn == 0 ? ssq : sskv; const float invn = u.pn == 0 ? (1.0f / 256.0f) : (1.0f / 128.0f);
#pragma unroll
            for (int ai = 0; ai < 2; ++ai)
#pragma unroll
                for (int m = 0; m < 4; ++m) { const int row = u.pm * 256 + ai * 128 + wr * 64 + m * 16 + fr; const float rs = rstd_of(ss, row, invn);
#pragma unroll
                    for (int bj = 0; bj < 2; ++bj) { const f32x4 v0 = acc[ai][bj][m][0] * rs, v1 = acc[ai][bj][m][1] * rs;
                        u32x4 w; w.x = pk2(v0[0], v0[1]); w.y = pk2(v0[2], v0[3]); w.z = pk2(v1[0], v1[1]); w.w = pk2(v1[2], v1[3]);
                        *(u32x4*)(O + (size_t)row * 256 + bj * 128 + wc * 32 + 8 * fq) = w; }
                    asm volatile("" ::: "memory"); }
        } else if (u.pn == 1) {
            const int col = wc * 32 + 8 * fq, i0 = (col & 31) >> 1;
#pragma unroll
            for (int ai = 0; ai < 2; ++ai)
#pragma unroll
                for (int m = 0; m < 4; ++m) { const int row = u.pm * 256 + ai * 128 + wr * 64 + m * 16 + fr; const float rq = rstd_of(ssq, row, 1.0f / 256.0f);
                    const f32x4 ca = *(const f32x4*)(cs + (size_t)row * 16 + i0), cb = *(const f32x4*)(cs + (size_t)row * 16 + i0 + 2);
                    const f32x4 v0 = acc[ai][0][m][0] * rq, v1 = acc[ai][0][m][1] * rq;
                    u32x4 w; w.x = pk2(v0[0] * ca[0] - v0[1] * ca[1], v0[0] * ca[1] + v0[1] * ca[0]); w.y = pk2(v0[2] * ca[2] - v0[3] * ca[3], v0[2] * ca[3] + v0[3] * ca[2]);
                    w.z = pk2(v1[0] * cb[0] - v1[1] * cb[1], v1[0] * cb[1] + v1[1] * cb[0]); w.w = pk2(v1[2] * cb[2] - v1[3] * cb[3], v1[2] * cb[3] + v1[3] * cb[2]);
                    *(u32x4*)(Qr + (size_t)row * 128 + col) = w; asm volatile("" ::: "memory"); }
        } else {
#pragma unroll
            for (int ai = 0; ai < 2; ++ai)
#pragma unroll
                for (int m = 0; m < 4; ++m) { const int row = u.pm * 256 + ai * 128 + wr * 64 + m * 16 + fr; const float rk = rstd_of(sskv, row, 1.0f / 128.0f);
                    const int b = row >> 12, sp = row & 4095;
#pragma unroll
                    for (int bj = 0; bj < 2; ++bj) { const int col = bj * 128 + wc * 32 + 8 * fq; const f32x4 v0 = acc[ai][bj][m][0] * rk, v1 = acc[ai][bj][m][1] * rk;
                        unsigned vo = (unsigned)(((b * 4 + (col >> 6)) * 64 + (col & 63)) * SEQ + sp) * 2u; asm volatile("" : "+v"(vo));
                        char* vb = (char*)Vt + vo;
#pragma unroll
                        for (int i = 0; i < 4; ++i) { *(bf16*)(vb + (size_t)i * SEQ * 2) = (bf16)(pk2(v0[i], 0.f) & 0xffffu); *(bf16*)(vb + (size_t)(4 + i) * SEQ * 2) = (bf16)(pk2(v1[i], 0.f) & 0xffffu); } }
                    asm volatile("" ::: "memory"); }
        }
    }
};
struct EpiBf16Plain {
    static constexpr bool PERM = true;
    bf16* O; int ldc;
    __device__ __forceinline__ void operator()(EPI_ARGS) const {
#pragma unroll
        for (int ai = 0; ai < 2; ++ai)
#pragma unroll
            for (int m = 0; m < 4; ++m) { const int row = u.pm * 256 + ai * 128 + wr * 64 + m * 16 + fr;
#pragma unroll
                for (int bj = 0; bj < 2; ++bj) { const f32x4 v0 = acc[ai][bj][m][0], v1 = acc[ai][bj][m][1];
                    u32x4 w; w.x = pk2(v0[0], v0[1]); w.y = pk2(v0[2], v0[3]); w.z = pk2(v1[0], v1[1]); w.w = pk2(v1[2], v1[3]);
                    *(u32x4*)(O + (size_t)row * ldc + u.pn * 256 + bj * 128 + wc * 32 + 8 * fq) = w; } }
    }
};
struct EpiSwiglu {
    static constexpr bool PERM = true;
    bf16* ACT; int t0;
    __device__ __forceinline__ void operator()(EPI_ARGS) const {
#pragma unroll
        for (int ai = 0; ai < 2; ++ai)
#pragma unroll
            for (int m = 0; m < 4; ++m) { const int row = (u.pm - t0) * 256 + ai * 128 + wr * 64 + m * 16 + fr;
                const f32x4 g0 = acc[ai][0][m][0], g1 = acc[ai][0][m][1], u0 = acc[ai][1][m][0], u1 = acc[ai][1][m][1];
                u32x4 w; w.x = pk2(silu_f(g0[0]) * u0[0], silu_f(g0[1]) * u0[1]); w.y = pk2(silu_f(g0[2]) * u0[2], silu_f(g0[3]) * u0[3]);
                w.z = pk2(silu_f(g1[0]) * u1[0], silu_f(g1[1]) * u1[1]); w.w = pk2(silu_f(g1[2]) * u1[2], silu_f(g1[3]) * u1[3]);
                *(u32x4*)(ACT + (size_t)row * FF + u.pn * 128 + wc * 32 + 8 * fq) = w; }
    }
};
struct EpiDown {
    static constexpr bool PERM = true;
    bf16* O2; MoeMap M;
    __device__ __forceinline__ void operator()(EPI_ARGS) const {
        const int ne = u.ne;
#pragma unroll
        for (int ai = 0; ai < 2; ++ai)
#pragma unroll
            for (int m = 0; m < 4; ++m) { const int idx = u.aux * 256 + ai * 128 + wr * 64 + m * 16 + fr;
                if (idx < ne) {
                    unsigned ts = (unsigned)idx * 2u; float w8 = 1.0f;
                    if (M.list) { ts = M.list[(size_t)u.e * T + idx]; w8 = M.wl[(size_t)u.e * T + idx]; }
                    bf16* orow = O2 + ((size_t)(ts & 1u) * T + (ts >> 1)) * DM + u.pn * 256 + wc * 32 + 8 * fq;
#pragma unroll
                    for (int bj = 0; bj < 2; ++bj) { const f32x4 v0 = acc[ai][bj][m][0] * w8, v1 = acc[ai][bj][m][1] * w8;
                        u32x4 w; w.x = pk2(v0[0], v0[1]); w.y = pk2(v0[2], v0[3]); w.z = pk2(v1[0], v1[1]); w.w = pk2(v1[2], v1[3]);
                        *(u32x4*)(orow + bj * 128) = w; } } }
    }
};

__device__ __forceinline__ void prep_thin(const Args& a, const Ctx& c0, int l) {
    const Ctx c = fresh(c0);
    const int gw = c.bid * NWAVES + c.wave, NGW = c.G * NWAVES, gtid = c.bid * (NWAVES * 64) + c.tid, NT = c.G * NWAVES * 64, lane = c.lane;
    const bf16* P = (const bf16*)(c.ws + WS_P);
    { const f32x2_t* cs = (const f32x2_t*)(c.ws + WS_CS); unsigned* Kr = (unsigned*)(c.ws + WS_KR);
      for (int idx = gtid; idx < T * 16; idx += NT) { const int tk = idx >> 4, i = idx & 15;
          const unsigned w = *(const unsigned*)(P + (size_t)tk * PP + C_KR + 2 * i); const float x1 = bflo(w), x2 = bfhi(w); const f32x2_t t = cs[idx];
          Kr[idx] = pk2(x1 * t.x - x2 * t.y, x1 * t.y + x2 * t.x); } }
    { LAS bf16* tl = (LAS bf16*)(c.lds + c.wave * 8448);
      for (int it = gw; it < 2 * NB * 64; it += NGW) { const int which = it >> 9, b = (it >> 6) & 7, st = it & 63;
          const bf16* src = P + (size_t)(b * SEQ + st * 64) * PP + (which ? C_NVW : C_NVS);
          bf16* dst = (bf16*)(c.ws + (which ? WS_VTW : WS_VTS)) + (size_t)b * 64 * SEQ + st * 64;
#pragma unroll
          for (int i = 0; i < 8; ++i) { const int tk = i * 8 + (lane >> 3), dc = lane & 7; const u32x4 w = *(const u32x4*)(src + (size_t)tk * PP + 8 * dc);
              LAS unsigned* t4 = (LAS unsigned*)(tl + tk * 66 + 8 * dc); t4[0] = w.x; t4[1] = w.y; t4[2] = w.z; t4[3] = w.w; }
          LDS_WAIT(); asm volatile("" ::: "memory");
#pragma unroll
          for (int tc = 0; tc < 8; ++tc) { unsigned short e[8];
#pragma unroll
              for (int k = 0; k < 8; ++k) e[k] = tl[(8 * tc + k) * 66 + lane];
              u32x4 o; o.x = e[0] | ((unsigned)e[1] << 16); o.y = e[2] | ((unsigned)e[3] << 16); o.z = e[4] | ((unsigned)e[5] << 16); o.w = e[6] | ((unsigned)e[7] << 16);
              *(u32x4*)(dst + (size_t)lane * SEQ + 8 * tc) = o; }
          LDS_WAIT(); asm volatile("" ::: "memory"); } }
    { const float* cw = argp(I_CONV_W) + (size_t)l * 3 * 256; bf16* Y = (bf16*)(c.ws + WS_Y);
      const f32x4 w0 = *(const f32x4*)(cw + 4 * lane), w1 = *(const f32x4*)(cw + 256 + 4 * lane), w2 = *(const f32x4*)(cw + 512 + 4 * lane);
      constexpr int R = 4;
      for (int row0 = gw; row0 < T; row0 += R * NGW) {
          u32x2 cc[R][3], hv[R][3], cb[R];
#pragma unroll
          for (int r = 0; r < R; ++r) { const int row = (row0 + r * NGW) < T ? (row0 + r * NGW) : 0; const int s = row & (SEQ - 1);
#pragma unroll
              for (int k = 0; k < 3; ++k) { const int sp = s - 2 + k; const size_t ro = (size_t)(sp >= 0 ? row - 2 + k : row) * PP;
                  cc[r][k] = *(const u32x2*)(P + ro + C_CC + 4 * lane); hv[r][k] = *(const u32x2*)(P + ro + C_CHV + 4 * lane); }
              cb[r] = *(const u32x2*)(P + (size_t)row * PP + C_CB + 4 * lane); }
#pragma unroll
          for (int r = 0; r < R; ++r) { const int row = row0 + r * NGW; if (row >= T) break; const int s = row & (SEQ - 1);
              f32x4 accv = {0.f, 0.f, 0.f, 0.f};
#pragma unroll
              for (int k = 0; k < 3; ++k) { const f32x4 wk = k == 0 ? w0 : (k == 1 ? w1 : w2); const float on = (s - 2 + k >= 0) ? 1.0f : 0.0f;
                  accv[0] += on * wk[0] * bflo(cc[r][k].x) * bflo(hv[r][k].x); accv[1] += on * wk[1] * bfhi(cc[r][k].x) * bfhi(hv[r][k].x);
                  accv[2] += on * wk[2] * bflo(cc[r][k].y) * bflo(hv[r][k].y); accv[3] += on * wk[3] * bfhi(cc[r][k].y) * bfhi(hv[r][k].y); }
              accv[0] *= bflo(cb[r].x); accv[1] *= bfhi(cb[r].x); accv[2] *= bflo(cb[r].y); accv[3] *= bfhi(cb[r].y);
              const float ss = wave_sum((accv[0] * accv[0] + accv[1] * accv[1]) + (accv[2] * accv[2] + accv[3] * accv[3]));
              const float rstd = 1.0f / sqrtf(ss * (1.0f / 256.0f) + EPS);
              u32x2 o; o.x = pk2(accv[0] * rstd, accv[1] * rstd); o.y = pk2(accv[2] * rstd, accv[3] * rstd);
              *(u32x2*)(Y + (size_t)row * DM + 256 + 4 * lane) = o; } } }
}
__device__ __forceinline__ void mla_groupnorm(const Ctx& c0) {
    const Ctx c = fresh(c0);
    const int gw = c.bid * NWAVES + c.wave, NGW = c.G * NWAVES, lane = c.lane; bf16* Y = (bf16*)(c.ws + WS_Y);
    for (int row = gw; row < T; row += NGW) { u32x2* p = (u32x2*)(Y + (size_t)row * DM + 4 * lane); const u32x2 w = *p;
        const float x0 = bflo(w.x), x1 = bfhi(w.x), x2 = bflo(w.y), x3 = bfhi(w.y);
        const float ss = wave_sum((x0 * x0 + x1 * x1) + (x2 * x2 + x3 * x3)); const float rstd = 1.0f / sqrtf(ss * (1.0f / 256.0f) + EPS);
        u32x2 o; o.x = pk2(x0 * rstd, x1 * rstd); o.y = pk2(x2 * rstd, x3 * rstd); *p = o; }
}

#define MFMA32(a, b, c) __builtin_amdgcn_mfma_f32_32x32x16_bf16((a), (b), (c), 0, 0, 0)
__device__ __forceinline__ int crow(int r, int hi) { return (r & 3) + 8 * (r >> 2) + 4 * hi; }

__device__ __forceinline__ void gmlp_unit(const Args& a, const Ctx& c0, int l, int unit) {
    const Ctx c = fresh(c0);
    const int lane = c.lane, w = c.wave, r32 = lane & 31, hi = lane >> 5; const int tok0 = unit * 128;
    const bf16* P = (const bf16*)(c.ws + WS_P); bf16* Y = (bf16*)(c.ws + WS_Y);
    LAS bf16* vnT = (LAS bf16*)c.lds;
    LAS bf16* ug = (LAS bf16*)(c.lds + 69632);
    LAS float* stg = (LAS float*)c.lds;
    const f32x4 lg = *(const f32x4*)(argp(I_GMLP_LN) + l * 256 + 4 * lane);
    __syncthreads();
    {   u32x2 wv[16], wu[16];
#pragma unroll
        for (int jj = 0; jj < 16; ++jj) { const size_t ro = (size_t)(tok0 + w * 16 + jj) * PP; wv[jj] = *(const u32x2*)(P + ro + C_GV + 4 * lane); wu[jj] = *(const u32x2*)(P + ro + C_GU + 4 * lane); }
#pragma unroll
        for (int jj = 0; jj < 16; ++jj) { const int j = w * 16 + jj;
            float x[4] = {gelu_tanh(bflo(wv[jj].x)), gelu_tanh(bfhi(wv[jj].x)), gelu_tanh(bflo(wv[jj].y)), gelu_tanh(bfhi(wv[jj].y))};
            const float mean = wave_sum((x[0] + x[1]) + (x[2] + x[3])) * (1.0f / 256.0f);
#pragma unroll
            for (int i = 0; i < 4; ++i) x[i] -= mean;
            const float var = wave_sum((x[0] * x[0] + x[1] * x[1]) + (x[2] * x[2] + x[3] * x[3])) * (1.0f / 256.0f); const float rstd = 1.0f / sqrtf(var + EPS);
#pragma unroll
            for (int i = 0; i < 4; ++i) vnT[(4 * lane + i) * 136 + j] = (bf16)(pk2(x[i] * rstd * lg[i], 0.f) & 0xffffu);
            u32x2 gu; gu.x = pk2(gelu_tanh(bflo(wu[jj].x)), gelu_tanh(bfhi(wu[jj].x))); gu.y = pk2(gelu_tanh(bflo(wu[jj].y)), gelu_tanh(bfhi(wu[jj].y)));
            *(LAS u32x2*)(ug + j * 256 + 4 * lane) = gu; } }
    __syncthreads();
    const int g = w >> 1; const bf16* WG = (const bf16*)(c.ws + WS_WGM) + (size_t)g * 128 * 128;
    f32x16 acc[4];
#pragma unroll
    for (int it = 0; it < 4; ++it)
#pragma unroll
        for (int r = 0; r < 16; ++r) acc[it][r] = 0.f;
#pragma unroll
    for (int ks = 0; ks < 8; ++ks) { const bf16x8 bfr = *(const LAS bf16x8*)(vnT + (32 * w + r32) * 136 + 16 * ks + 8 * hi);
#pragma unroll
        for (int it = 0; it < 4; ++it) { const bf16x8 afr = *(const bf16x8*)(WG + (size_t)(32 * it + r32) * 128 + 16 * ks + 8 * hi); acc[it] = MFMA32(afr, bfr, acc[it]); } }
    const float* bs = argp(I_GMLP_BS) + (size_t)l * 4 * 128 + g * 128; const int col = 32 * w + r32;
#pragma unroll
    for (int it = 0; it < 4; ++it)
#pragma unroll
        for (int r = 0; r < 16; ++r) { const int i = 32 * it + crow(r, hi); acc[it][r] = bf2f(ug[i * 256 + col]) * (acc[it][r] + bs[i]); }
    __syncthreads();
#pragma unroll
    for (int it = 0; it < 4; ++it)
#pragma unroll
        for (int r = 0; r < 16; ++r) { const int i = 32 * it + crow(r, hi); stg[i * 260 + col] = acc[it][r]; }
    __syncthreads();
    for (int jj = 0; jj < 16; ++jj) { const int i = w * 16 + jj; const f32x4 v = *(const LAS f32x4*)(stg + i * 260 + 4 * lane);
        const float ss = wave_sum((v[0] * v[0] + v[1] * v[1]) + (v[2] * v[2] + v[3] * v[3])); const float rstd = 1.0f / sqrtf(ss * (1.0f / 256.0f) + EPS);
        u32x2 o; o.x = pk2(v[0] * rstd, v[1] * rstd); o.y = pk2(v[2] * rstd, v[3] * rstd); *(u32x2*)(Y + (size_t)(tok0 + i) * DM + 512 + 4 * lane) = o; }
    __syncthreads();
}

__device__ __forceinline__ void compress_unit(const Ctx& c0, int unit) {
    const Ctx c = fresh(c0);
    const int lane = c.lane, w = c.wave, r32 = lane & 31, hi = lane >> 5; const int b = unit >> 4, kv = (unit >> 3) & 1, grp = unit & 7;
    const bf16* P = (const bf16*)(c.ws + WS_P);
    const bf16* arow = P + (size_t)(b * SEQ + 16 * (32 * grp + r32)) * PP + (kv ? C_NVC : C_NKC) + 8 * hi;
    const bf16* brow = (const bf16*)(c.ws + WS_W1T) + ((size_t)kv * 256 + 32 * w + r32) * 2048 + 8 * hi;
    f32x16 acc;
#pragma unroll
    for (int r = 0; r < 16; ++r) acc[r] = 0.f;
#pragma unroll 16
    for (int ks = 0; ks < 128; ++ks) { const bf16x8 af = *(const bf16x8*)(arow + (size_t)(ks >> 2) * PP + 16 * (ks & 3)); const bf16x8 bf_ = *(const bf16x8*)(brow + 16 * ks); acc = MFMA32(af, bf_, acc); }
    LAS bf16* Hs = (LAS bf16*)c.lds;
    __syncthreads();
    { const float bp = ((const float*)(c.ws + WS_BPE))[kv * 256 + 32 * w + r32];
#pragma unroll
      for (int r = 0; r < 16; ++r) Hs[crow(r, hi) * 264 + 32 * w + r32] = (bf16)(pk2(gelu_tanh(acc[r] + bp), 0.f) & 0xffffu); }
    __syncthreads();
    if (w < 2) {
        const bf16* w2 = (const bf16*)(c.ws + WS_W2T) + ((size_t)kv * 64 + 32 * w + r32) * 256 + 8 * hi;
        f32x16 o;
#pragma unroll
        for (int r = 0; r < 16; ++r) o[r] = 0.f;
#pragma unroll
        for (int ks = 0; ks < 16; ++ks) { const bf16x8 af = *(const LAS bf16x8*)(Hs + r32 * 264 + 16 * ks + 8 * hi); const bf16x8 bf_ = *(const bf16x8*)(w2 + 16 * ks); o = MFMA32(af, bf_, o); }
        const int n = 32 * w + r32;
#pragma unroll
        for (int r = 0; r < 16; ++r) { const int ig = 32 * grp + crow(r, hi); const bf16 val = ig < 255 ? (bf16)(pk2(o[r], 0.f) & 0xffffu) : (bf16)0;
            if (kv == 0) ((bf16*)(c.ws + WS_KC))[((size_t)b * 256 + ig) * 64 + n] = val; else ((bf16*)(c.ws + WS_VCT))[((size_t)b * 64 + n) * 256 + ig] = val; }
    }
    __syncthreads();
}

constexpr int NSLOT = 4, SLOT_BYTES = 20480, SL_K = 0, SL_V = 8192, SL_KR = 16384;
constexpr int AT_RING = 0, AT_PSEL = NSLOT * SLOT_BYTES, AT_SELM = AT_PSEL + 64 * 65 * 4, AT_TACC = AT_SELM + 512, AT_END = AT_TACC + 8 * 4096;
static_assert(AT_END <= ARENA_BYTES, "attention LDS");
struct FState { f32x16 o0, o1; float m, l; };
__device__ __forceinline__ void fstate_init(FState& st) {
#pragma unroll
    for (int r = 0; r < 16; ++r) { st.o0[r] = 0.f; st.o1[r] = 0.f; }
    st.m = -1e30f; st.l = 0.f;
}
struct QLds { LAS const unsigned char* ql; __device__ __forceinline__ bf16x8 operator[](int ks) const { return *(const LAS bf16x8*)(ql + ks * 1024); } };
template <int DK, class QF> __device__ __forceinline__ void qk_tile(f32x16& p0, f32x16& p1, const QF& qf, LAS const unsigned char* Sb, int r32, int hi) {
    const f32x16 zero16 = {0.f, 0.f, 0.f, 0.f, 0.f, 0.f, 0.f, 0.f, 0.f, 0.f, 0.f, 0.f, 0.f, 0.f, 0.f, 0.f};
    const int xa = (r32 >> 1) & 7;
#pragma unroll
    for (int ks = 0; ks < 4; ++ks) {
        const int off = r32 * 128 + (((2 * ks + hi) ^ xa) << 4);
        const bf16x8 ka = *(const LAS bf16x8*)(Sb + SL_K + off);
        const bf16x8 kb = *(const LAS bf16x8*)(Sb + SL_K + 4096 + off);
        if (ks == 0) { p0 = MFMA32(ka, qf[0], zero16); p1 = MFMA32(kb, qf[0], zero16); }
        else { p0 = MFMA32(ka, qf[ks], p0); p1 = MFMA32(kb, qf[ks], p1); }
    }
    if (DK == 96) {
        const int xr = (r32 >> 2) & 3;
#pragma unroll
        for (int ks = 0; ks < 2; ++ks) {
            const int off = r32 * 64 + (((2 * ks + hi) ^ xr) << 4);
            const bf16x8 ka = *(const LAS bf16x8*)(Sb + SL_KR + off);
            const bf16x8 kb = *(const LAS bf16x8*)(Sb + SL_KR + 2048 + off);
            p0 = MFMA32(ka, qf[4 + ks], p0); p1 = MFMA32(kb, qf[4 + ks], p1); } }
}
template <class QF> __device__ __forceinline__ void qk_step(f32x16& p0, f32x16& p1, const QF& qf, LAS const unsigned char* Sb, int r32, int hi, int ks) {
    const f32x16 zero16 = {0.f, 0.f, 0.f, 0.f, 0.f, 0.f, 0.f, 0.f, 0.f, 0.f, 0.f, 0.f, 0.f, 0.f, 0.f, 0.f};
    bf16x8 ka, kb;
    if (ks < 4) { const int off = r32 * 128 + (((2 * ks + hi) ^ ((r32 >> 1) & 7)) << 4); ka = *(const LAS bf16x8*)(Sb + SL_K + off); kb = *(const LAS bf16x8*)(Sb + SL_K + 4096 + off); }
    else { const int off = r32 * 64 + (((2 * (ks - 4) + hi) ^ ((r32 >> 2) & 3)) << 4); ka = *(const LAS bf16x8*)(Sb + SL_KR + off); kb = *(const LAS bf16x8*)(Sb + SL_KR + 2048 + off); }
    const bf16x8 q = qf[ks];
    if (ks == 0) { p0 = MFMA32(ka, q, zero16); p1 = MFMA32(kb, q, zero16); } else { p0 = MFMA32(ka, q, p0); p1 = MFMA32(kb, q, p1); }
}
__device__ __forceinline__ void pv_step(f32x16& o0, f32x16& o1, const f32x16& p0, const f32x16& p1, LAS const unsigned char* Sb, int r32, int hi, int s) {
    const int xv = (r32 >> 1) & 7, b = 8 * (s & 1);
    u32x4 pw;
    if (s < 2) { pw.x = pk2(p0[b], p0[b + 1]); pw.y = pk2(p0[b + 2], p0[b + 3]); pw.z = pk2(p0[b + 4], p0[b + 5]); pw.w = pk2(p0[b + 6], p0[b + 7]); }
    else       { pw.x = pk2(p1[b], p1[b + 1]); pw.y = pk2(p1[b + 2], p1[b + 3]); pw.z = pk2(p1[b + 4], p1[b + 5]); pw.w = pk2(p1[b + 6], p1[b + 7]); }
    const bf16x8 pf = __builtin_bit_cast(bf16x8, pw);
#pragma unroll
    for (int db = 0; db < 2; ++db) {
        LAS const unsigned char* vrow = Sb + SL_V + (32 * db + r32) * 128 + 8 * hi;
        const u32x2 lo = *(const LAS u32x2*)(vrow + (((2 * s) ^ xv) << 4)), hh = *(const LAS u32x2*)(vrow + (((2 * s + 1) ^ xv) << 4));
        const u32x4 vv = {lo.x, lo.y, hh.x, hh.y}; const bf16x8 vf = __builtin_bit_cast(bf16x8, vv);
        if (db == 0) o0 = MFMA32(vf, pf, o0); else o1 = MFMA32(vf, pf, o1); }
}
__device__ __forceinline__ void pv_tile(f32x16& o0, f32x16& o1, const f32x16& p0, const f32x16& p1, LAS const unsigned char* Sb, int r32, int hi) {
    const int xv = (r32 >> 1) & 7;
#pragma unroll
    for (int s = 0; s < 4; ++s) {
        const int b = 8 * (s & 1);
        u32x4 pw;
        if (s < 2) { pw.x = pk2(p0[b], p0[b + 1]); pw.y = pk2(p0[b + 2], p0[b + 3]); pw.z = pk2(p0[b + 4], p0[b + 5]); pw.w = pk2(p0[b + 6], p0[b + 7]); }
        else       { pw.x = pk2(p1[b], p1[b + 1]); pw.y = pk2(p1[b + 2], p1[b + 3]); pw.z = pk2(p1[b + 4], p1[b + 5]); pw.w = pk2(p1[b + 6], p1[b + 7]); }
        const bf16x8 pf = __builtin_bit_cast(bf16x8, pw);
#pragma unroll
        for (int db = 0; db < 2; ++db) {
            LAS const unsigned char* vrow = Sb + SL_V + (32 * db + r32) * 128 + 8 * hi;
            const u32x2 lo = *(const LAS u32x2*)(vrow + (((2 * s) ^ xv) << 4)), hh = *(const LAS u32x2*)(vrow + (((2 * s + 1) ^ xv) << 4));
            const u32x4 vv = {lo.x, lo.y, hh.x, hh.y}; const bf16x8 vf = __builtin_bit_cast(bf16x8, vv);
            if (db == 0) o0 = MFMA32(vf, pf, o0); else o1 = MFMA32(vf, pf, o1); }
    }
}
template <bool MASKED> __device__ __forceinline__ void softmax_step(FState& st, f32x16& p0, f32x16& p1, bool lane_on = true) {
    float mx = fmaxf(p0[0], p1[0]);
#pragma unroll
    for (int r = 1; r < 16; ++r) mx = fmaxf(mx, fmaxf(p0[r], p1[r]));
    mx = fmaxf(mx, __shfl_xor(mx, 32));
    if (!MASKED) mx = lane_on ? mx : -1e30f;
    if (__any(mx > st.m)) {
        const float mnew = fmaxf(st.m, mx), alpha = __builtin_amdgcn_exp2f(st.m - mnew); st.m = mnew;
        st.l *= alpha;
#pragma unroll
        for (int r = 0; r < 16; ++r) { st.o0[r] *= alpha; st.o1[r] *= alpha; }
    }
    float rs = 0.f;
    if (MASKED) {
        const float m = st.m;
#pragma unroll
        for (int r = 0; r < 16; ++r) { p0[r] = p0[r] > -1e29f ? __builtin_amdgcn_exp2f(p0[r] - m) : 0.f; p1[r] = p1[r] > -1e29f ? __builtin_amdgcn_exp2f(p1[r] - m) : 0.f; rs += p0[r] + p1[r]; }
    } else {
        const float m = lane_on ? st.m : 1e30f;
#pragma unroll
        for (int r = 0; r < 16; ++r) { p0[r] = __builtin_amdgcn_exp2f(p0[r] - m); p1[r] = __builtin_amdgcn_exp2f(p1[r] - m); rs += p0[r] + p1[r]; }
    }
    st.l += rs;
}
__device__ __forceinline__ float max_xor32(float v) { const auto rr = __builtin_amdgcn_permlane32_swap(__float_as_uint(v), __float_as_uint(v), false, false); return fmaxf(__uint_as_float(rr[0]), __uint_as_float(rr[1])); }
#define SMX_I(P0, P1, AL, MEFF, ON) do { float mx_ = fmaxf(P0[0], P1[0]); \
    _Pragma("unroll") for (int r = 1; r < 16; ++r) mx_ = fmaxf(mx_, fmaxf(P0[r], P1[r])); \
    mx_ = max_xor32(mx_); if (LANEON_) mx_ = (ON) ? mx_ : -1e30f; \
    const float mn_ = fmaxf(st.m, mx_); AL = __builtin_amdgcn_exp2f(st.m - mn_); st.m = mn_; MEFF = LANEON_ ? ((ON) ? mn_ : 1e30f) : mn_; } while (0)
#define SMX_II(P, MEFF, RS) do { _Pragma("unroll") for (int r = 0; r < 16; ++r) { P[r] = __builtin_amdgcn_exp2f(P[r] - MEFF); RS += P[r]; } } while (0)
#define SMX_III(AL, RS) do { st.l = st.l * AL + RS; _Pragma("unroll") for (int r = 0; r < 16; ++r) { st.o0[r] *= AL; st.o1[r] *= AL; } } while (0)
#define SBAR0 __builtin_amdgcn_sched_barrier(0)
#define PAIR_NB(DK, LANEON, ONA, ONB) do { constexpr bool LANEON_ = LANEON; \
    f32x16 a0, a1, b0, b1; float alA, mA, rsA = 0.f, alB, mB, rsB = 0.f; \
    qk_tile<DK>(a0, a1, qf, SbA, r32, hi); SBAR0; \
    qk_step(b0, b1, qf, SbB, r32, hi, 0); qk_step(b0, b1, qf, SbB, r32, hi, 1); SMX_I(a0, a1, alA, mA, (ONA)); SBAR0; \
    qk_step(b0, b1, qf, SbB, r32, hi, 2); qk_step(b0, b1, qf, SbB, r32, hi, 3); SMX_II(a0, mA, rsA); SBAR0; \
    if (DK == 96) { qk_step(b0, b1, qf, SbB, r32, hi, 4); qk_step(b0, b1, qf, SbB, r32, hi, 5); } SMX_II(a1, mA, rsA); SMX_III(alA, rsA); SBAR0; \
    pv_step(st.o0, st.o1, a0, a1, SbA, r32, hi, 0); pv_step(st.o0, st.o1, a0, a1, SbA, r32, hi, 1); SMX_I(b0, b1, alB, mB, (ONB)); SMX_II(b0, mB, rsB); SBAR0; \
    pv_step(st.o0, st.o1, a0, a1, SbA, r32, hi, 2); pv_step(st.o0, st.o1, a0, a1, SbA, r32, hi, 3); SMX_II(b1, mB, rsB); SBAR0; \
    SMX_III(alB, rsB); pv_tile(st.o0, st.o1, b0, b1, SbB, r32, hi); } while (0)
template <int DK> struct DmaLoader {
    const char *k1, *k2, *v; unsigned ks1, ks2, vs;
    unsigned o1, o2, ov;
    unsigned ldsbase, w;
    __device__ __forceinline__ void init(const bf16* k1_, int kp1, const bf16* k2_, int kp2, const bf16* v_, int vp, int lane, int wave, LAS unsigned char* lds) {
        k1 = (const char*)k1_; k2 = (const char*)k2_; v = (const char*)v_; ks1 = 64u * kp1 * 2u; ks2 = 64u * kp2 * 2u; vs = 128u; w = (unsigned)wave;
        ldsbase = (unsigned)(uintptr_t)lds + AT_RING;
        { const int key = 8 * wave + (lane >> 3), cc = (lane & 7) ^ ((key >> 1) & 7); o1 = ((unsigned)key * kp1 + 8u * cc) * 2u; }
        { const int key = 16 * (wave & 3) + (lane >> 2), cc = (lane & 3) ^ ((key >> 2) & 3); o2 = ((unsigned)key * kp2 + 8u * cc) * 2u; }
        { const int d = 8 * wave + (lane >> 3), kc = (lane & 7) ^ ((d >> 1) & 7); ov = ((unsigned)d * vp + 8u * kc) * 2u; }
    }
    __device__ __forceinline__ void issue(int j, int slot) const {
        const unsigned sb = ldsbase + (unsigned)slot * SLOT_BYTES;
        __builtin_amdgcn_global_load_lds((const unsigned*)(k1 + (size_t)j * ks1 + o1), (LAS unsigned*)(uintptr_t)(sb + SL_K + w * 1024u), 16, 0, 0);
        __builtin_amdgcn_global_load_lds((const unsigned*)(v + (size_t)j * vs + ov), (LAS unsigned*)(uintptr_t)(sb + SL_V + w * 1024u), 16, 0, 0);
        if (DK == 96) __builtin_amdgcn_global_load_lds((const unsigned*)(k2 + (size_t)j * ks2 + o2), (LAS unsigned*)(uintptr_t)(sb + SL_KR + (w & 3u) * 1024u), 16, 0, 0);
    }
};
#define ATT_WAITV(n) asm volatile("s_waitcnt vmcnt(" #n ")" ::: "memory")
#define TILE_BEGIN(L, J0, J1, WAITSTMT) { \
    const int _j0 = (J0), _j1 = (J1); \
    __syncthreads(); \
    if (_j0 < _j1) { \
    _Pragma("unroll") for (int _p = 0; _p < 3; ++_p) (L).issue((_j0 + _p) < _j1 ? (_j0 + _p) : (_j1 - 1), _p); \
    for (int j = _j0; j < _j1; ++j) { \
        WAITSTMT; __builtin_amdgcn_s_barrier(); asm volatile("" ::: "memory"); \
        (L).issue((j + 3) < _j1 ? (j + 3) : (_j1 - 1), (j - _j0 + 3) & 3); \
        LAS const unsigned char* Sb = c.lds + AT_RING + ((j - _j0) & 3) * SLOT_BYTES;
#define TILE_END(L) \
    } } \
    ATT_WAITV(0); __builtin_amdgcn_s_barrier(); asm volatile("" ::: "memory"); }

#define TILE2_BEGIN(L, J0, J1) { \
    const int _j0 = (J0), _j1 = (J1), _npair = (_j1 - _j0 + 1) >> 1; \
    __syncthreads(); \
    if (_npair > 0) { \
    (L).issue(_j0, 0); (L).issue((_j0 + 1) < _j1 ? (_j0 + 1) : (_j1 - 1), 1); \
    for (int _i = 0; _i < _npair; ++_i) { \
        const int j = _j0 + 2 * _i; const bool hasB = (j + 1) < _j1; \
        ATT_WAITV(0); __builtin_amdgcn_s_barrier(); asm volatile("" ::: "memory"); \
        { const int _jn = j + 2, _s = ((_i + 1) & 1) * 2; (L).issue(_jn < _j1 ? _jn : (_j1 - 1), _s); (L).issue((_jn + 1) < _j1 ? (_jn + 1) : (_j1 - 1), _s + 1); } \
        LAS const unsigned char* SbA = c.lds + AT_RING + ((_i & 1) * 2) * SLOT_BYTES; LAS const unsigned char* SbB = SbA + SLOT_BYTES;
#define TILE2_END(L) \
    } } \
    ATT_WAITV(0); __builtin_amdgcn_s_barrier(); asm volatile("" ::: "memory"); }

__device__ __forceinline__ void mla_unit(const Ctx& c0, int b, int h, int qb) {
    const Ctx c = fresh(c0);
    const int lane = c.lane, w = c.wave, r32 = lane & 31, hi = lane >> 5;
    const int qpos = 256 * qb + 32 * w + r32; const int row = b * SEQ + qpos;
    const bf16* Qn = (const bf16*)(c.ws + WS_QN); const bf16* Qr = (const bf16*)(c.ws + WS_QR);
    LAS unsigned char* qimg = c.lds + NSLOT * SLOT_BYTES + w * 6144 + lane * 16;
    __syncthreads();
#pragma unroll
    for (int ks = 0; ks < 4; ++ks) *(LAS bf16x8*)(qimg + ks * 1024) = *(const bf16x8*)(Qn + (size_t)row * 256 + h * 64 + 16 * ks + 8 * hi);
#pragma unroll
    for (int ks = 0; ks < 2; ++ks) *(LAS bf16x8*)(qimg + (4 + ks) * 1024) = *(const bf16x8*)(Qr + (size_t)row * 128 + h * 32 + 16 * ks + 8 * hi);
    const QLds qf{qimg};
    DmaLoader<96> L; L.init((const bf16*)(c.ws + WS_KN) + (size_t)b * SEQ * 256 + h * 64, 256, (const bf16*)(c.ws + WS_KR) + (size_t)b * SEQ * 32, 32, (const bf16*)(c.ws + WS_VTM) + (size_t)(b * 4 + h) * 64 * SEQ, SEQ, lane, w, c.lds);
    FState st; fstate_init(st);
    const int wmax = 256 * qb + 32 * w + 31;
#define MLA_SM(P0, P1, JJ) do { if (64 * (JJ) + 63 > 256 * qb + 32 * w) { \
            _Pragma("unroll") for (int r = 0; r < 16; ++r) { const int k0 = 64 * (JJ) + crow(r, hi); if (k0 > qpos) P0[r] = -1e30f; if (k0 + 32 > qpos) P1[r] = -1e30f; } \
            softmax_step<true>(st, P0, P1); } else softmax_step<false>(st, P0, P1); } while (0)
    TILE2_BEGIN(L, 0, 4 * qb)
        PAIR_NB(96, false, true, true);
    TILE2_END(L)
    TILE2_BEGIN(L, 4 * qb, 4 * qb + 4)
        const bool needA = 64 * j <= wmax, needB = hasB && (64 * (j + 1) <= wmax);
        if (needB) {
            f32x16 a0, a1, b0, b1; qk_tile<96>(a0, a1, qf, SbA, r32, hi); __builtin_amdgcn_sched_barrier(0); qk_tile<96>(b0, b1, qf, SbB, r32, hi);
            MLA_SM(a0, a1, j); __builtin_amdgcn_sched_barrier(0); pv_tile(st.o0, st.o1, a0, a1, SbA, r32, hi); __builtin_amdgcn_sched_barrier(0);
            MLA_SM(b0, b1, j + 1); __builtin_amdgcn_sched_barrier(0); pv_tile(st.o0, st.o1, b0, b1, SbB, r32, hi);
        } else if (needA) {
            f32x16 a0, a1; qk_tile<96>(a0, a1, qf, SbA, r32, hi);
            MLA_SM(a0, a1, j); pv_tile(st.o0, st.o1, a0, a1, SbA, r32, hi);
        }
    TILE2_END(L)
#undef MLA_SM
    const float lt = st.l + __shfl_xor(st.l, 32); const float inv = 1.0f / lt;
    int qp2 = qpos; asm volatile("" : "+v"(qp2));
    bf16* Y = (bf16*)(c.ws + WS_Y) + (size_t)(b * SEQ + qp2) * DM + h * 64;
#pragma unroll
    for (int g = 0; g < 4; ++g) {
        u32x2 o; o.x = pk2(st.o0[4 * g] * inv, st.o0[4 * g + 1] * inv); o.y = pk2(st.o0[4 * g + 2] * inv, st.o0[4 * g + 3] * inv); *(u32x2*)(Y + 8 * g + 4 * hi) = o;
        u32x2 o2; o2.x = pk2(st.o1[4 * g] * inv, st.o1[4 * g + 1] * inv); o2.y = pk2(st.o1[4 * g + 2] * inv, st.o1[4 * g + 3] * inv); *(u32x2*)(Y + 32 + 8 * g + 4 * hi) = o2; }
}

__device__ __forceinline__ void nsa_unit(const Ctx& c0, int b, int qt) {
    const Ctx c = fresh(c0);
    const int lane = c.lane, w = c.wave, r32 = lane & 31, hi = lane >> 5;
    const int tl = 8 * w + (r32 & 7), head = r32 >> 3, tok = 64 * qt + tl; const int row = b * SEQ + tok;
    const bf16* P = (const bf16*)(c.ws + WS_P);
    bf16x8 qf[4];
#pragma unroll
    for (int ks = 0; ks < 4; ++ks) qf[ks] = *(const bf16x8*)(P + (size_t)row * PP + C_NQ + head * 64 + 16 * ks + 8 * hi);
#define NSA_GATE(br) sigmoid_f(bf2f(P[(size_t)(b * SEQ + tok) * PP + C_NG + head * 3 + (br)]))
    LAS float* psel = (LAS float*)(c.lds + AT_PSEL); LAS unsigned long long* selm = (LAS unsigned long long*)(c.lds + AT_SELM);
    __syncthreads();
    for (int i = c.tid; i < 64 * 65; i += NWAVES * 64) psel[i] = 0.f;
    LAS unsigned* tacc = (LAS unsigned*)(c.lds + AT_TACC) + w * 1024 + lane;
    DmaLoader<64> L; L.init((const bf16*)(c.ws + WS_KC) + (size_t)b * 256 * 64, 64, nullptr, 0, (const bf16*)(c.ws + WS_VCT) + (size_t)b * 64 * 256, 256, lane, w, c.lds);
    const int ntc = (4 * qt + 2) / 64 + 1;
    float cm = -1e30f, cl = 0.f;
    TILE_BEGIN(L, 0, ntc, ATT_WAITV(4))
        f32x16 p0, p1; qk_tile<64>(p0, p1, qf, Sb, r32, hi);
        float mx = -1e30f;
#pragma unroll
        for (int r = 0; r < 16; ++r) { const int c0 = 64 * j + crow(r, hi); if (16 * c0 + 31 > tok) p0[r] = -1e30f; if (16 * (c0 + 32) + 31 > tok) p1[r] = -1e30f; mx = fmaxf(mx, fmaxf(p0[r], p1[r])); }
        mx = fmaxf(mx, __shfl_xor(mx, 32));
        const float mnew = fmaxf(cm, mx); float rs = 0.f;
#pragma unroll
        for (int r = 0; r < 16; ++r) { rs += (p0[r] > -1e29f ? __builtin_amdgcn_exp2f(p0[r] - mnew) : 0.f) + (p1[r] > -1e29f ? __builtin_amdgcn_exp2f(p1[r] - mnew) : 0.f); }
        cl = cl * __builtin_amdgcn_exp2f(cm - mnew) + rs; cm = mnew;
    TILE_END(L)
    cl += __shfl_xor(cl, 32);
    const float cinv = cl > 0.f ? 1.0f / cl : 0.f;
    {
        f32x16 o0, o1;
#pragma unroll
        for (int r = 0; r < 16; ++r) { o0[r] = 0.f; o1[r] = 0.f; }
        TILE_BEGIN(L, 0, ntc, ATT_WAITV(4))
            f32x16 p0, p1; qk_tile<64>(p0, p1, qf, Sb, r32, hi);
#pragma unroll
            for (int r = 0; r < 16; ++r) { const int c0 = 64 * j + crow(r, hi);
                p0[r] = (16 * c0 + 31 <= tok) ? __builtin_amdgcn_exp2f(p0[r] - cm) * cinv : 0.f; p1[r] = (16 * (c0 + 32) + 31 <= tok) ? __builtin_amdgcn_exp2f(p1[r] - cm) * cinv : 0.f; }
#pragma unroll
            for (int half = 0; half < 2; ++half)
#pragma unroll
                for (int g = 0; g < 4; ++g) {
                    float av, bv;
                    if (half == 0) { av = p0[4 * g] + p0[4 * g + 1] + p0[4 * g + 2] + 0.5f * p0[4 * g + 3]; bv = 0.5f * p0[4 * g + 3]; }
                    else           { av = p1[4 * g] + p1[4 * g + 1] + p1[4 * g + 2] + 0.5f * p1[4 * g + 3]; bv = 0.5f * p1[4 * g + 3]; }
                    av += __shfl_xor(av, 8); av += __shfl_xor(av, 16); bv += __shfl_xor(bv, 8); bv += __shfl_xor(bv, 16);
                    if (head == 0) { const int n = 16 * j + 8 * half + 2 * g + hi; (void)__hip_atomic_fetch_add(psel + tl * 65 + n, av, __ATOMIC_RELAXED, __HIP_MEMORY_SCOPE_WORKGROUP); (void)__hip_atomic_fetch_add(psel + tl * 65 + n + 1, bv, __ATOMIC_RELAXED, __HIP_MEMORY_SCOPE_WORKGROUP); }
                }
            pv_tile(o0, o1, p0, p1, Sb, r32, hi);
        TILE_END(L)
        { const float g0 = NSA_GATE(0);
#pragma unroll
        for (int r = 0; r < 16; ++r) tacc[r * 64] = pk2(g0 * o0[r], g0 * o1[r]); }
    }
    __syncthreads();
    for (int tt = 0; tt < 8; ++tt) {
        const int tk = 8 * w + tt; float sc = psel[tk * 65 + lane];
        if (lane > qt) sc = -1.0f; else if (lane == 0 || lane == qt || lane == qt - 1) sc = 1e4f;
        int rank = 0;
        for (int n = 0; n < 64; ++n) { const float so = __builtin_bit_cast(float, __builtin_amdgcn_readlane(__builtin_bit_cast(int, sc), n)); rank += (so > sc || (so == sc && n < lane)) ? 1 : 0; }
        const unsigned long long mk = __ballot(rank < 16);
        if (lane == 0) selm[tk] = mk;
    }
    __syncthreads();
    const unsigned long long smask = selm[tl];
    {
        L.init(P + (size_t)b * SEQ * PP + C_NKS, PP, nullptr, 0, (const bf16*)(c.ws + WS_VTS) + (size_t)b * 64 * SEQ, SEQ, lane, w, c.lds);
        FState st; fstate_init(st);
#define SEL_SM(P0, P1, JJ) do { if ((JJ) == qt) { \
            _Pragma("unroll") for (int r = 0; r < 16; ++r) { const int k0 = 64 * (JJ) + crow(r, hi); if (k0 > tok) P0[r] = -1e30f; if (k0 + 32 > tok) P1[r] = -1e30f; } \
            softmax_step<true>(st, P0, P1);   \
        } else softmax_step<false>(st, P0, P1, (bool)((smask >> (JJ)) & 1ull)); } while (0)
        const int qe = qt & ~1;
        TILE2_BEGIN(L, 0, qe)
            PAIR_NB(64, true, (bool)((smask >> j) & 1ull), (bool)((smask >> (j + 1)) & 1ull));
        TILE2_END(L)
        TILE2_BEGIN(L, qe, qt + 1)
            if (hasB) {
                f32x16 a0, a1, b0, b1; qk_tile<64>(a0, a1, qf, SbA, r32, hi); __builtin_amdgcn_sched_barrier(0); qk_tile<64>(b0, b1, qf, SbB, r32, hi);
                SEL_SM(a0, a1, j); __builtin_amdgcn_sched_barrier(0); pv_tile(st.o0, st.o1, a0, a1, SbA, r32, hi); __builtin_amdgcn_sched_barrier(0);
                SEL_SM(b0, b1, j + 1); __builtin_amdgcn_sched_barrier(0); pv_tile(st.o0, st.o1, b0, b1, SbB, r32, hi);
            } else {
                f32x16 a0, a1; qk_tile<64>(a0, a1, qf, SbA, r32, hi);
                SEL_SM(a0, a1, j); pv_tile(st.o0, st.o1, a0, a1, SbA, r32, hi);
            }
        TILE2_END(L)
#undef SEL_SM
        const float lt = st.l + __shfl_xor(st.l, 32); const float f = lt > 0.f ? NSA_GATE(1) / lt : 0.f;
#pragma unroll
        for (int r = 0; r < 16; ++r) { const unsigned t = tacc[r * 64]; tacc[r * 64] = pk2(bflo(t) + f * st.o0[r], bfhi(t) + f * st.o1[r]); }
    }
    f32x16 t0, t1;
    {
        L.init(P + (size_t)b * SEQ * PP + C_NKW, PP, nullptr, 0, (const bf16*)(c.ws + WS_VTW) + (size_t)b * 64 * SEQ, SEQ, lane, w, c.lds);
        FState st; fstate_init(st);
        TILE_BEGIN(L, (qt >= 8 ? qt - 8 : 0), qt + 1, ATT_WAITV(4))
            f32x16 p0, p1; qk_tile<64>(p0, p1, qf, Sb, r32, hi);
            if (j == qt || j + 8 == qt) {
#pragma unroll
                for (int r = 0; r < 16; ++r) { const int k0 = 64 * j + crow(r, hi); if (k0 > tok || k0 + 512 <= tok) p0[r] = -1e30f; if (k0 + 32 > tok || k0 + 32 + 512 <= tok) p1[r] = -1e30f; }
                softmax_step<true>(st, p0, p1);
            } else softmax_step<false>(st, p0, p1);
            pv_tile(st.o0, st.o1, p0, p1, Sb, r32, hi);
        TILE_END(L)
        const float lt = st.l + __shfl_xor(st.l, 32); const float f = lt > 0.f ? NSA_GATE(2) / lt : 0.f;
#pragma unroll
        for (int r = 0; r < 16; ++r) { const unsigned t = tacc[r * 64]; t0[r] = bflo(t) + f * st.o0[r]; t1[r] = bfhi(t) + f * st.o1[r]; }
    }
    float ss = 0.f;
#pragma unroll
    for (int r = 0; r < 16; ++r) ss += t0[r] * t0[r] + t1[r] * t1[r];
    ss += __shfl_xor(ss, 32); ss += __shfl_xor(ss, 8); ss += __shfl_xor(ss, 16);
    const float rstd = 1.0f / sqrtf(ss * (1.0f / 256.0f) + EPS);
    int tk2 = tok; asm volatile("" : "+v"(tk2));
    bf16* Y = (bf16*)(c.ws + WS_Y) + (size_t)(b * SEQ + tk2) * DM + 768 + head * 64;
#pragma unroll
    for (int g = 0; g < 4; ++g) {
        u32x2 o; o.x = pk2(t0[4 * g] * rstd, t0[4 * g + 1] * rstd); o.y = pk2(t0[4 * g + 2] * rstd, t0[4 * g + 3] * rstd); *(u32x2*)(Y + 8 * g + 4 * hi) = o;
        u32x2 o2; o2.x = pk2(t1[4 * g] * rstd, t1[4 * g + 1] * rstd); o2.y = pk2(t1[4 * g + 2] * rstd, t1[4 * g + 3] * rstd); *(u32x2*)(Y + 32 + 8 * g + 4 * hi) = o2; }
}

#ifndef PHMASK
#define PHMASK 0xFFFF
#endif
#define PHON(k) ((PHMASK >> (k)) & 1)
#ifndef SUBMASK
#define SUBMASK 0xFF
#endif
#define SUBON(k) ((SUBMASK >> (k)) & 1)
#ifndef REPMASK
#define REPMASK 0
#endif
#define NREP(k) (((REPMASK >> (k)) & 1) ? 2 : 1)
constexpr int PH_PER_LAYER = 17, PH_FINAL = DEPTH * PH_PER_LAYER, NPH = PH_FINAL + 1;
__global__ void __launch_bounds__(NWAVES * 64, 2) fwd_kernel(Args a) {
    extern __shared__ __attribute__((aligned(16))) unsigned char lds_raw[];
    Ctx c; c.lds = (LAS unsigned char*)lds_raw; c.ws = (GAS unsigned char*)a.ws; c.tid = threadIdx.x; c.lane = c.tid & 63; c.wave = __builtin_amdgcn_readfirstlane(c.tid >> 6); c.G = gridDim.x; c.bid = blockIdx.x;
    volatile LAS unsigned* MISC = (volatile LAS unsigned*)(c.lds + MISC_OFF);
    if (c.tid < 64) MISC[c.tid] = 0u;
    __syncthreads();
    const int lo = a.ph_lo, hi = a.ph_hi;
    const bool multi = (hi - lo) > 1;
    XcdBarrier bar; bar.bar = (unsigned*)(c.ws + WS_CTL) + CW_BAR; bar.x = 0; bar.st = nullptr;
    if (multi) bar = xcd_barrier_post((unsigned*)(c.ws + WS_CTL) + CW_BAR, MISC + 8);
#define IN(k) (lo <= (k) && (k) < hi)
#define SEAM(k) do { if ((k) + 1 < hi) { xcd_barrier(bar, (unsigned*)(c.ws + WS_CTL) + CW_BAR); if (NREP(15) > 1) xcd_barrier(bar, (unsigned*)(c.ws + WS_CTL) + CW_BAR); } } while (0)
    for (int l = 0; l < DEPTH; ++l) {
        GAS unsigned char* ws = c.ws; asm volatile("" : "+s"(ws));
        const int pb = l * PH_PER_LAYER;
        const bool moe = (l & 1) != 0;
        if (PHON(0) && IN(pb + 0)) {
            for (int rep_ = 0; rep_ < NREP(0); ++rep_) convert_weights(a, c, l);
            const bf16* O2 = (const bf16*)(ws + WS_P);
            norm_pass<0>(a, c, l == 0 ? argp(I_X) : nullptr, l > 0 ? O2 : nullptr, (l > 0 && ((l - 1) & 1)) ? O2 + (size_t)T * DM : nullptr, l > 0, l);
            if (NREP(10) > 1) { xcd_barrier(bar, (unsigned*)(c.ws + WS_CTL) + CW_BAR); norm_pass<0>(a, c, l == 0 ? argp(I_X) : nullptr, nullptr, nullptr, false, l); }
            SEAM(pb + 0);
        }
        if (PHON(1) && IN(pb + 1)) for (int rep_ = 0; rep_ < NREP(1); ++rep_) {
            SchedPlain S; S.R.init(T / 256, PP / 256, c.G, c.bid); S.lda2_ = DM * 2; S.B = (const char*)(ws + WS_WIN); S.btile = (size_t)256 * DM * 2;
            EpiInProj E{(bf16*)(ws + WS_P), (float*)(ws + WS_SSQ), (float*)(ws + WS_SSKV)};
            pg8::gemm_phase<EpiInProj, SchedPlain>(c.lds, (const char*)(ws + WS_XN), DM, DM, S, E);
            if (rep_ + 1 < NREP(1)) xcd_barrier(bar, (unsigned*)(c.ws + WS_CTL) + CW_BAR); else SEAM(pb + 1);
        }
        if (PHON(2) && IN(pb + 2)) for (int rep_ = 0; rep_ < NREP(2); ++rep_) {
            if (SUBON(0)) for (int r2_ = 0; r2_ < NREP(11); ++r2_) { SchedPlain S; S.R.init(T / 256, 4, c.G, c.bid); S.lda2_ = PP * 2; S.B = (const char*)(ws + WS_WQKV); S.btile = (size_t)256 * 384 * 2;
              EpiQkv E{(const float*)(ws + WS_SSQ), (const float*)(ws + WS_SSKV), (const f32x2_t*)(ws + WS_CS), (bf16*)(ws + WS_QN), (bf16*)(ws + WS_QR), (bf16*)(ws + WS_KN), (bf16*)(ws + WS_VTM)};
              pg8::gemm_phase<EpiQkv, SchedPlain>(c.lds, (const char*)(ws + WS_P), 384, 384, S, E); }
            if (SUBON(1)) for (int r2_ = 0; r2_ < NREP(12); ++r2_) for (int u = c.bid; u < NB * 32; u += c.G) gmlp_unit(a, c, l, u);
            if (SUBON(2)) for (int r2_ = 0; r2_ < NREP(13); ++r2_) for (int u = c.bid; u < 128; u += c.G) compress_unit(c, u);
            __syncthreads();
            if (SUBON(3)) for (int r2_ = 0; r2_ < NREP(14); ++r2_) prep_thin(a, c, l);
            if (rep_ + 1 < NREP(2)) xcd_barrier(bar, (unsigned*)(c.ws + WS_CTL) + CW_BAR); else SEAM(pb + 2);
        }
        if (PHON(3) && IN(pb + 3)) for (int rep_ = 0; rep_ < NREP(3); ++rep_) {
            const int vcu = (c.G % 8 == 0) ? (c.bid % 8) * (c.G / 8) + c.bid / 8 : c.bid;
            if (SUBON(0)) for (int u = vcu; u < 256; u += c.G) for (int rep = 0; rep < 2; ++rep) { const int bh = u >> 3, s = u & 7; mla_unit(c, bh >> 2, bh & 3, rep ? 15 - s : s); }
            if (SUBON(1)) for (int u = vcu; u < 256; u += c.G) for (int rep = 0; rep < 2; ++rep) { const int b = u >> 5, s = u & 31; nsa_unit(c, b, rep ? 63 - s : s); }
            if (rep_ + 1 < NREP(3)) xcd_barrier(bar, (unsigned*)(c.ws + WS_CTL) + CW_BAR); else SEAM(pb + 3);
        }
        if (PHON(4) && IN(pb + 4)) { mla_groupnorm(c); SEAM(pb + 4); }
        if (PHON(5) && IN(pb + 5)) for (int rep_ = 0; rep_ < NREP(5); ++rep_) {
            SchedPlain S; S.R.init(T / 256, 4, c.G, c.bid); S.lda2_ = DM * 2; S.B = (const char*)(ws + WS_WO); S.btile = (size_t)256 * DM * 2;
            EpiBf16Plain E{(bf16*)(ws + WS_D1), DM};
            pg8::gemm_phase<EpiBf16Plain, SchedPlain>(c.lds, (const char*)(ws + WS_Y), DM, DM, S, E);
            if (rep_ + 1 < NREP(5)) xcd_barrier(bar, (unsigned*)(c.ws + WS_CTL) + CW_BAR); else SEAM(pb + 5);
        }
        if (PHON(6) && IN(pb + 6)) {
            norm_pass<1>(a, c, l == 0 ? argp(I_X) : nullptr, (const bf16*)(ws + WS_D1), nullptr, true, l);
            SEAM(pb + 6);
        }
        if (PHON(7) && IN(pb + 7)) {
            const MoeMap M = make_moemap(c, l);
            const int P8 = M.pre8, rem = P8 & 63, NF = P8 >> 6, nsteps = rem > 0 ? 2 * NF + 1 : 2 * NF;
            for (int sidx = 0; sidx < nsteps; ++sidx) {
                int dk = -2, gk = -2; bool mixed = false;
                if (rem > 0) { if (sidx == 0) gk = -1; else if (sidx == 1) { dk = -1; gk = 0; mixed = true; } else if ((sidx & 1) == 0) dk = sidx / 2 - 1; else gk = (sidx - 1) / 2; }
                else { if ((sidx & 1) == 0) gk = sidx / 2; else dk = sidx / 2; }
                if (dk != -2) {
                    const int t0 = dk < 0 ? 0 : rem + 64 * dk, nM = dk < 0 ? rem : 64;
                    SchedDown S; S.R.init(nM, 4, c.G, c.bid); S.M = M; S.t0 = t0; S.B = (const char*)(ws + WS_WD);
                    EpiDown E{(bf16*)(ws + WS_P), M};
                    pg8::gemm_phase<EpiDown, SchedDown>(c.lds, (const char*)(ws + (dk < 0 ? WS_ACTR : WS_ACT)), FF, FF, S, E);
                }
                if (gk != -2) {
                    const int t0 = gk < 0 ? 0 : rem + 64 * gk, nM = gk < 0 ? rem : 64;
                    SchedGateUp S; S.R.init(nM, 2 * FF / 256, c.G, c.bid); S.M = M; S.t0 = t0; S.B = (const char*)(ws + WS_WGU);
                    S.nd = (mixed && c.G == 256) ? rem * 4 : 0;
                    EpiSwiglu E{(bf16*)(ws + (gk < 0 ? WS_ACTR : WS_ACT)), t0};
                    pg8::gemm_phase<EpiSwiglu, SchedGateUp>(c.lds, (const char*)(ws + WS_XN), DM, DM, S, E);
                }
                xcd_barrier(bar, (unsigned*)(c.ws + WS_CTL) + CW_BAR);
            }
        }
    }
    if (PHON(9) && IN(PH_FINAL)) {
        GAS unsigned char* ws = c.ws;
        const bf16* O2 = (const bf16*)(ws + WS_P);
        norm_pass<2>(a, c, nullptr, O2, O2 + (size_t)T * DM, false, DEPTH - 1);
    }
#undef IN
#undef SEAM
}

#ifndef MK_MULTI_LAUNCH
#define MK_MULTI_LAUNCH 0
#endif
extern "C" void kernel_launch(void* const* d_in, const int* in_sizes, int n_in, void* d_out, int out_size, void* d_ws, size_t ws_size, hipStream_t stream) {
    static int grid = 0;
    if (grid == 0) {
        if (n_in != 29 || out_size != T * DM || ws_size < WS_END) { fprintf(stderr, "kernel_launch: unexpected shapes (n_in %d, out %d, ws %zu < %zu)\n", n_in, out_size, ws_size, (size_t)WS_END); grid = -1; return; }
        int dev = 0, cus = 0, per_cu = 0;
        if (hipGetDevice(&dev) != hipSuccess || hipDeviceGetAttribute(&cus, hipDeviceAttributeMultiprocessorCount, dev) != hipSuccess) { grid = -1; return; }
        if (hipFuncSetAttribute((const void*)fwd_kernel, hipFuncAttributeMaxDynamicSharedMemorySize, LDS_BYTES) != hipSuccess) { fprintf(stderr, "kernel_launch: hipFuncSetAttribute failed\n"); grid = -1; return; }
        if (hipOccupancyMaxActiveBlocksPerMultiprocessor(&per_cu, (const void*)fwd_kernel, NWAVES * 64, LDS_BYTES) != hipSuccess || per_cu < 1) { fprintf(stderr, "kernel_launch: occupancy query says %d\n", per_cu); }
        (void)hipGetLastError();
        grid = cus;
    }
    if (grid < 0) return;
    (void)hipMemsetAsync((char*)d_ws + WS_CTL, 0, CTL_ZERO_BYTES, stream);
    Args a{};
    for (int i = 0; i < 29; ++i) a.in[i] = (const float*)d_in[i];
    a.out = (float*)d_out; a.ws = (unsigned char*)d_ws;
#if MK_MULTI_LAUNCH
    for (int p = 0; p < NPH; ++p) {
        const int l = p / PH_PER_LAYER, q = p % PH_PER_LAYER;
        if (p < PH_FINAL && q >= 7) { const int ch = (q - 7) >> 1; if (ch >= ((l & 1) ? 5 : 2)) continue; }
        a.ph_lo = p; a.ph_hi = p + 1;
        hipLaunchKernelGGL(fwd_kernel, dim3(grid), dim3(NWAVES * 64), LDS_BYTES, stream, a);
    }
#else
    a.ph_lo = 0; a.ph_hi = NPH;
    hipLaunchKernelGGL(fwd_kernel, dim3(grid), dim3(NWAVES * 64), LDS_BYTES, stream, a);
#endif
}
```

```cpp
#include <hip/hip_runtime.h>
#include <cstdio>
#include <cstdint>

#define LAS __attribute__((address_space(3)))
#define GAS __attribute__((address_space(1)))
typedef unsigned short bf16;
typedef short bf16x8 __attribute__((ext_vector_type(8)));
typedef float f32x4 __attribute__((ext_vector_type(4)));
typedef float f32x16 __attribute__((ext_vector_type(16)));
typedef unsigned u32x4 __attribute__((ext_vector_type(4)));
typedef unsigned u32x2 __attribute__((ext_vector_type(2)));
typedef float f32x2_t __attribute__((ext_vector_type(2)));
typedef __bf16 bf16x2_t __attribute__((ext_vector_type(2)));

constexpr int NB = 8, SEQ = 4096, T = NB * SEQ, DM = 1024, DEPTH = 4;
constexpr int DIN = 2348, PP = 2560;
constexpr int FF = 3584, NE = 8;
constexpr float EPS = 1e-6f;
constexpr float LOG2E = 1.4426950408889634f;
constexpr int C_CQ = 0, C_CKV = 256, C_NKC = 384, C_NVC = 448, C_CB = 512, C_CC = 768, C_CHV = 1024, C_GU = 1280, C_GV = 1536,
              C_NQ = 1792, C_NKS = 2048, C_NVS = 2112, C_NKW = 2176, C_NVW = 2240, C_KR = 2304, C_NG = 2336;

constexpr size_t MiB = 1u << 20;
constexpr size_t WS_CTL = 0, CTL_ZERO_BYTES = 1 * MiB;
constexpr size_t WS_CS = 1 * MiB;
constexpr size_t WS_LIST = 5 * MiB;
constexpr size_t WS_WL = 7 * MiB;
constexpr size_t WS_SSQ = 9 * MiB;
constexpr size_t WS_SSKV = WS_SSQ + MiB / 2;
constexpr size_t WS_KC = 10 * MiB;
constexpr size_t WS_VCT = WS_KC + 256 * 1024;
constexpr size_t WS_WQKV = 11 * MiB;
constexpr size_t WS_WGM = WS_WQKV + 768 * 1024;
constexpr size_t WS_W2T = WS_WGM + 128 * 1024;
constexpr size_t WS_BPE = WS_W2T + 64 * 1024;
constexpr size_t WS_W1T = 12 * MiB;
constexpr size_t WS_WIN = 14 * MiB;
constexpr size_t WS_WO = 19 * MiB;
constexpr size_t WS_WGU = 21 * MiB;
constexpr size_t WS_WD = 133 * MiB;
constexpr size_t WS_XN = 189 * MiB;
constexpr size_t WS_P = 253 * MiB;
constexpr size_t WS_QN = 414 * MiB;
constexpr size_t WS_QR = 430 * MiB;
constexpr size_t WS_KN = 438 * MiB;
constexpr size_t WS_KR = 454 * MiB;
constexpr size_t WS_VTM = 456 * MiB;
constexpr size_t WS_VTS = 472 * MiB;
constexpr size_t WS_VTW = 476 * MiB;
constexpr size_t WS_Y = 480 * MiB;
constexpr size_t WS_D1 = 544 * MiB;
constexpr size_t WS_ACT = 608 * MiB;
constexpr size_t WS_H = 720 * MiB;
constexpr size_t WS_ACTR = 784 * MiB;
constexpr size_t WS_END = 800 * MiB;
static_assert(WS_P + (size_t)(T + 64) * PP * 2 <= WS_QN, "P");
constexpr int CW_BAR = 4096;
constexpr int CW_CNT = 16384;

constexpr int NWAVES = 8;
constexpr int ARENA_BYTES = 143360;
constexpr int MISC_OFF = ARENA_BYTES;
constexpr int LDS_BYTES = 147456;

__device__ __forceinline__ unsigned pk2(float lo, float hi) { f32x2_t v = {lo, hi}; bf16x2_t b = __builtin_convertvector(v, bf16x2_t); return __builtin_bit_cast(unsigned, b); }
__device__ __forceinline__ float bf2f(unsigned short x) { return __uint_as_float(((unsigned)x) << 16); }
__device__ __forceinline__ float bflo(unsigned w) { return __uint_as_float(w << 16); }
__device__ __forceinline__ float bfhi(unsigned w) { return __uint_as_float(w & 0xffff0000u); }
__device__ __forceinline__ float wave_sum(float v) {
#pragma unroll
    for (int o = 1; o < 64; o <<= 1) v += __shfl_xor(v, o);
    return v;
}
__device__ __forceinline__ float gelu_tanh(float x) {
    const float u = 0.7978845608028654f * (x + 0.044715f * x * x * x);
    const float e = __builtin_amdgcn_exp2f(u * (2.0f * LOG2E));
    const float th = 1.0f - 2.0f * __builtin_amdgcn_rcpf(e + 1.0f);
    return 0.5f * x * (1.0f + th);
}
__device__ __forceinline__ float silu_f(float x) { return x * __builtin_amdgcn_rcpf(1.0f + __builtin_amdgcn_exp2f(-x * LOG2E)); }
__device__ __forceinline__ float sigmoid_f(float x) { return __builtin_amdgcn_rcpf(1.0f + __builtin_amdgcn_exp2f(-x * LOG2E)); }
#define LDS_WAIT() asm volatile("s_waitcnt lgkmcnt(0)" ::: "memory")
#define VM_WAIT() asm volatile("s_waitcnt vmcnt(0)" ::: "memory")

namespace pg8 {
constexpr int BM = 256, BK = 64, HALF = 128, HTB = HALF * BK * 2, STAGE_BYTES = 8 * HTB, NXCD = 8, WGM = 8;
__host__ __device__ __forceinline__ int lds_byte(int r, int c) { const int st = (r >> 4) * 2 + (c >> 5), rr = r & 15, cc = c & 31, ob = rr * 64 + cc * 2; return st * 1024 + (ob ^ (((ob >> 9) & 1) << 5)); }
__host__ __device__ __forceinline__ void stage_rc(int b, int& R, int& C) { const int st = b / 1024, sb = b % 1024, swz = sb ^ (((sb >> 9) & 1) << 5); R = (st >> 1) * 16 + swz / 64; C = (st & 1) * 32 + (swz % 64) / 2; }
__host__ __device__ __forceinline__ int perm32(int rho) { const int n = rho >> 4, i = rho & 15; return 8 * (i >> 2) + 4 * n + (i & 3); }

struct Unit { int pm, pn, e, aux, ne; };

struct RectOrder {
    int nM, nN, nwg, G, c;
    __device__ __forceinline__ void init(int nM_, int nN_, int G_, int c_) { nM = nM_; nN = nN_; nwg = nM * nN; G = G_; c = c_; }
    __device__ __forceinline__ bool get(int i, int& pm, int& pn) const { return getL((long)i * G + c, pm, pn); }
    __device__ __forceinline__ bool getL(long L, int& pm, int& pn) const {
        if (L >= nwg) return false;
        int wgid = (int)L; { const int q = nwg / NXCD, r = nwg % NXCD, xcd = wgid % NXCD, off = wgid / NXCD; wgid = (xcd < r ? xcd * (q + 1) : r * (q + 1) + (xcd - r) * q) + off; }
        const int nig = WGM * nN, gid = wgid / nig, fm = gid * WGM, gsz = (nM - fm) < WGM ? (nM - fm) : WGM;
        pm = fm + ((wgid % nig) % gsz); pn = (wgid % nig) / gsz; return true;
    }
};

template <class Epi, class Sched>
__device__ __forceinline__ void gemm_phase(LAS unsigned char* lds, const char* Abase, const int K, const int ldb  , const Sched& S, const Epi& E) {
    int tid = threadIdx.x; asm volatile("" : "+v"(tid));
    const int wid = __builtin_amdgcn_readfirstlane(tid >> 6), lane = tid & 63, wr = wid >> 2, wc = wid & 3, fr = lane & 15, fq = lane >> 4;
    int nt = K / BK; asm volatile("" : "+s"(nt));
    int R0, C0, R1, C1; stage_rc(tid * 16, R0, C0); stage_rc(tid * 16 + 8192, R1, C1);
    unsigned voffB[2];
    { const int Rb0 = Epi::PERM ? ((R0 & ~31) + perm32(R0 & 31)) : R0, Rb1 = Epi::PERM ? ((R1 & ~31) + perm32(R1 & 31)) : R1;
      voffB[0] = (unsigned)(Rb0 * ldb + C0) * 2u; voffB[1] = (unsigned)(Rb1 * ldb + C1) * 2u; }
    const size_t kstep = (size_t)(BK * 2);
    const size_t hstepB = (size_t)HALF * ldb * 2;
    const unsigned ldsw = (unsigned)wid * 1024u;
    const int aoff = lds_byte(wr * 64 + fr, fq * 8), boff = lds_byte(wc * 32 + fr, fq * 8);
#define PG8_SA(b, h) (((b) * 2 + (h)) * HTB)
#define PG8_SB(b, h) ((4 + (b) * 2 + (h)) * HTB)
#define PG8_GL(ubase, voff, dstoff) do { unsigned _o = (voff); asm volatile("" : "+v"(_o)); __builtin_amdgcn_global_load_lds((const unsigned*)((const char*)(ubase) + _o), (LAS unsigned*)(lds + (dstoff)), 16, 0, 0); } while (0)
#define PG8_STAGE_B(bufoff, gbase) do { PG8_GL(gbase, voffB[0], (bufoff) + ldsw); PG8_GL(gbase, voffB[1], (bufoff) + ldsw + 8192); } while (0)
#define PG8_STAGE_A0(bufoff, ub, kb) do { PG8_GL(Abase + ((ub) + (kb)), va00, (bufoff) + ldsw); PG8_GL(Abase + ((ub) + (kb)), va01, (bufoff) + ldsw + 8192); } while (0)
#define PG8_STAGE_A1(bufoff, ub, kb) do { PG8_GL(Abase + ((ub) + (kb) + hstepA), va10, (bufoff) + ldsw); PG8_GL(Abase + ((ub) + (kb) + hstepA), va11, (bufoff) + ldsw + 8192); } while (0)
#define PG8_LDA(dst, b, h) do { _Pragma("unroll") for (int m = 0; m < 4; ++m) _Pragma("unroll") for (int k = 0; k < 2; ++k) dst[m][k] = *(const LAS bf16x8*)(lds + PG8_SA(b, h) + aoff + m * 2048 + k * 1024); } while (0)
#define PG8_LDB(dst, b, h) do { _Pragma("unroll") for (int n = 0; n < 2; ++n) _Pragma("unroll") for (int k = 0; k < 2; ++k) dst[n][k] = *(const LAS bf16x8*)(lds + PG8_SB(b, h) + boff + n * 2048 + k * 1024); } while (0)
#define PG8_MMA(ai, bj, At, Bt) do { __builtin_amdgcn_s_setprio(1); _Pragma("unroll") for (int m = 0; m < 4; ++m) _Pragma("unroll") for (int n = 0; n < 2; ++n) _Pragma("unroll") for (int k = 0; k < 2; ++k) \
        acc[ai][bj][m][n] = __builtin_amdgcn_mfma_f32_16x16x32_bf16(Bt[n][k], At[m][k], acc[ai][bj][m][n], 0, 0, 0); __builtin_amdgcn_s_setprio(0); } while (0)
#define PG8_WAIT_V(n) asm volatile("s_waitcnt vmcnt(" #n ")" ::: "memory")
#define PG8_WAIT_L(n) asm volatile("s_waitcnt lgkmcnt(" #n ")" ::: "memory")
#define PG8_BAR __builtin_amdgcn_s_barrier()
#define PG8_SCHED __builtin_amdgcn_sched_barrier(0)
    Unit cur, nxt; int ui = 0;
    if (!S.next(0, cur)) return;
    f32x4 acc[2][2][4][2];
    float zf = 0.f; asm volatile("" : "+v"(zf));
#pragma unroll
    for (int a = 0; a < 2; ++a)
#pragma unroll
        for (int b = 0; b < 2; ++b)
#pragma unroll
            for (int m = 0; m < 4; ++m)
#pragma unroll
                for (int n = 0; n < 2; ++n) acc[a][b][m][n] = (f32x4){zf, zf, zf, zf};
    bf16x8 At[4][2], B0[2][2], B1[2][2];
    unsigned va00, va01, va10, va11; size_t cAb, hstepA;
    if constexpr (Sched::GATHER) { va00 = S.arow(cur, R0) + C0 * 2; va01 = S.arow(cur, R1) + C1 * 2; va10 = S.arow(cur, HALF + R0) + C0 * 2; va11 = S.arow(cur, HALF + R1) + C1 * 2; cAb = 0; hstepA = 0; }
    else { const unsigned l2 = S.lda2(); va00 = (unsigned)R0 * l2 + C0 * 2; va01 = (unsigned)R1 * l2 + C1 * 2; va10 = va00; va11 = va01; cAb = S.abase(cur); hstepA = (size_t)HALF * l2; }
    const char* cB = S.bbase(cur);
    PG8_STAGE_B(PG8_SB(0, 0), cB); PG8_STAGE_B(PG8_SB(0, 1), cB + hstepB); PG8_STAGE_A0(PG8_SA(0, 0), cAb, 0); PG8_STAGE_A1(PG8_SA(0, 1), cAb, 0);
    if (wr == 1) PG8_BAR;
    PG8_WAIT_V(2); PG8_BAR;
    PG8_STAGE_B(PG8_SB(1, 0), cB + kstep); PG8_STAGE_A0(PG8_SA(1, 0), cAb, kstep); PG8_STAGE_B(PG8_SB(1, 1), cB + hstepB + kstep);
    PG8_WAIT_V(6); PG8_BAR;
    for (;;) {
        const bool has_next = S.next(ui + 1, nxt);
        const char* nB = cB; size_t nAb = cAb;
        if (has_next) { nB = S.bbase(nxt); if constexpr (!Sched::GATHER) nAb = S.abase(nxt); }
        for (int t = 0; t < nt; t += 2) {
            const bool last = (t == nt - 2);
            const size_t k1 = (size_t)(t + 1) * kstep;
            const size_t k2 = last ? 0 : (size_t)(t + 2) * kstep, k3 = k2 + kstep;
            const size_t ab2 = last ? nAb : cAb;
            const char* b2 = last ? nB : cB + k2; const char* b3 = b2 + kstep;
            PG8_LDB(B0, 0, 0); PG8_LDB(B1, 0, 1); PG8_SCHED; PG8_LDA(At, 0, 0); PG8_STAGE_A1(PG8_SA(1, 1), cAb, k1);
            if constexpr (Sched::GATHER) { if (last && has_next) {
                va00 = S.arow(nxt, R0) + C0 * 2; va01 = S.arow(nxt, R1) + C1 * 2; va10 = S.arow(nxt, HALF + R0) + C0 * 2; va11 = S.arow(nxt, HALF + R1) + C1 * 2; } }
            PG8_WAIT_V(8); PG8_WAIT_L(0); PG8_BAR; PG8_MMA(0, 0, At, B0); PG8_MMA(0, 1, At, B1); PG8_BAR; PG8_SCHED;
            PG8_LDA(At, 0, 1); PG8_STAGE_B(PG8_SB(0, 0), b2); PG8_STAGE_B(PG8_SB(0, 1), b2 + hstepB); PG8_STAGE_A0(PG8_SA(0, 0), ab2, k2);
            PG8_WAIT_V(8); PG8_WAIT_L(0); PG8_BAR; PG8_MMA(1, 0, At, B0); PG8_MMA(1, 1, At, B1); PG8_BAR; PG8_SCHED;
            PG8_LDB(B0, 1, 0); PG8_LDB(B1, 1, 1); PG8_SCHED; PG8_LDA(At, 1, 0); PG8_STAGE_A1(PG8_SA(0, 1), ab2, k2);
            PG8_WAIT_V(8); PG8_WAIT_L(0); PG8_BAR; PG8_MMA(0, 0, At, B0); PG8_MMA(0, 1, At, B1); PG8_BAR; PG8_SCHED;
            PG8_LDA(At, 1, 1); PG8_STAGE_B(PG8_SB(1, 0), b3); PG8_STAGE_B(PG8_SB(1, 1), b3 + hstepB); PG8_STAGE_A0(PG8_SA(1, 0), ab2, k3);
            PG8_WAIT_V(8); PG8_WAIT_L(0); PG8_BAR; PG8_MMA(1, 0, At, B0); PG8_MMA(1, 1, At, B1); PG8_BAR; PG8_SCHED;
        }
        if (wr == 0) PG8_BAR;
        E(acc, cur, wr, wc, fr, fq);
        if (!has_next) break;
        zf = 0.f; asm volatile("" : "+v"(zf));
#pragma unroll
        for (int a = 0; a < 2; ++a)
#pragma unroll
            for (int b = 0; b < 2; ++b)
#pragma unroll
                for (int m = 0; m < 4; ++m)
#pragma unroll
                    for (int n = 0; n < 2; ++n) acc[a][b][m][n] = (f32x4){zf, zf, zf, zf};
        cur = nxt; cB = nB; cAb = nAb; ++ui;
        if (wr == 1) PG8_BAR;
    }
    PG8_WAIT_V(0);
    PG8_BAR;
#undef PG8_SA
#undef PG8_SB
#undef PG8_GL
#undef PG8_STAGE_A0
#undef PG8_STAGE_A1
#undef PG8_STAGE_B
#undef PG8_LDA
#undef PG8_LDB
#undef PG8_MMA
#undef PG8_WAIT_V
#undef PG8_WAIT_L
#undef PG8_BAR
#undef PG8_SCHED
}
}

#define XB_TMO      128
#define XB_XCNT(j)  (256  + 64 * (j))
#define XB_XSUB(j)  (1280 + 64 * (j))
#define XB_XGEN(j)  (2304 + 64 * (j))
#define XB_TOP      3328
#define XB_TOPGEN   3392
#define XCD_BAR_WORDS 3456
#define XB_SPIN_CAP (1u << 18)
__device__ __forceinline__ unsigned xb_ld(unsigned* p)              { return __hip_atomic_load(p, __ATOMIC_RELAXED, __HIP_MEMORY_SCOPE_AGENT); }
__device__ __forceinline__ unsigned xb_add(unsigned* p, unsigned v) { return __hip_atomic_fetch_add(p, v, __ATOMIC_RELAXED, __HIP_MEMORY_SCOPE_AGENT); }
__device__ __forceinline__ unsigned xb_xcc_id() { return (unsigned)__builtin_amdgcn_s_getreg((3 << 11) | 20) & 0xFu; }
#define XB_SPIN(cond, bar) do { unsigned _sp = 0; while (cond) { __builtin_amdgcn_s_sleep(1); \
    if ((++_sp & 255u) == 0u) { if (xb_ld(&(bar)[XB_TMO])) break; if (_sp > XB_SPIN_CAP) { atomicAdd(&(bar)[XB_TMO], 1u); break; } } } } while (0)
struct XcdBarrier { unsigned* bar; unsigned x; volatile LAS unsigned* st; };
__device__ __forceinline__ XcdBarrier xcd_barrier_post(unsigned* bar, volatile LAS unsigned* st) {
    XcdBarrier b; b.bar = bar; b.x = xb_xcc_id(); b.st = st;
    if (threadIdx.x == 0) (void)xb_add(&bar[XB_XCNT(b.x)], 1u);
    return b;
}
__device__ __forceinline__ void xcd_barrier_complete(unsigned* bar, unsigned x, unsigned& nloc, unsigned& nx) {
    const unsigned G = gridDim.x * gridDim.y * gridDim.z;
    unsigned sum, cnt, mine, sp = 0u;
    for (;;) {
        sum = 0u; cnt = 0u; mine = 0u;
#pragma unroll
        for (unsigned j = 0; j < 16; ++j) { const unsigned c = xb_ld(&bar[XB_XCNT(j)]); sum += c; cnt += (c > 0u) ? 1u : 0u; mine = (j == x) ? c : mine; }
        if (sum == G) break;
        __builtin_amdgcn_s_sleep(1);
        if ((++sp & 255u) == 0u) { if (xb_ld(&bar[XB_TMO])) break; if (sp > XB_SPIN_CAP) { atomicAdd(&bar[XB_TMO], 1u); break; } }
    }
    nloc = mine > 0u ? mine : 1u; nx = cnt > 0u ? cnt : 1u;
}
__device__ __forceinline__ void xcd_barrier(const XcdBarrier& b, unsigned* bar) {
    asm volatile("s_waitcnt vmcnt(0)" ::: "memory");
    __syncthreads();
    if (threadIdx.x == 0) {
        __builtin_amdgcn_s_waitcnt(0);
        unsigned nloc = b.st[0], nx = b.st[1];
        if (nloc == 0u) { xcd_barrier_complete(bar, b.x, nloc, nx); b.st[0] = nloc; b.st[1] = nx; }
        const unsigned old = xb_add(&bar[XB_XSUB(b.x)], 1u);
        const unsigned gen = old / nloc;
        if (old + 1u == (gen + 1u) * nloc) {
            __builtin_amdgcn_fence(__ATOMIC_RELEASE, "agent");
            asm volatile("s_waitcnt vmcnt(0)" ::: "memory");
            const unsigned og = xb_add(&bar[XB_TOP], 1u);
            const unsigned tg = og / nx;
            if (og + 1u == (tg + 1u) * nx) xb_add(&bar[XB_TOPGEN], 1u);
            else XB_SPIN(xb_ld(&bar[XB_TOPGEN]) == tg, bar);
            __builtin_amdgcn_fence(__ATOMIC_ACQUIRE, "agent");
            xb_add(&bar[XB_XGEN(b.x)], 1u);
            asm volatile("s_waitcnt vmcnt(0)" ::: "memory");
        } else {
            XB_SPIN(xb_ld(&bar[XB_XGEN(b.x)]) == gen, bar);
            __builtin_amdgcn_fence(__ATOMIC_ACQUIRE, "agent");
            asm volatile("s_waitcnt vmcnt(0)" ::: "memory");
        }
    }
    __syncthreads();
}

struct Args { const float* in[29]; float* out; unsigned char* ws; int ph_lo, ph_hi; };
static_assert(sizeof(Args) == 29 * 8 + 8 + 8 + 8, "Args has no padding");
enum { I_X = 0, I_POS, I_ATTN_NORM, I_W_IN, I_Q_NORM, I_W_UQ, I_KV_NORM, I_W_UKV, I_CONV_W, I_GMLP_LN, I_GMLP_WS, I_GMLP_BS,
       I_PE_K, I_W1_K, I_W2_K, I_PE_V, I_W1_V, I_W2_V, I_GROUP_NORM, I_W_O, I_FFN_NORM, I_DW_GATE, I_DW_UP, I_DW_DOWN,
       I_ROUTER, I_MW_GATE, I_MW_UP, I_MW_DOWN, I_FINAL_NORM };

typedef GAS const float* __attribute__((address_space(4))) const volatile* kargtab_t;
__device__ __forceinline__ const float* argp(int i) { kargtab_t p = (kargtab_t)__builtin_amdgcn_kernarg_segment_ptr(); GAS const float* g = p[i]; return (const float*)g; }

struct Ctx {
    LAS unsigned char* lds;
    GAS unsigned char* ws;
    int tid, lane, wave, G, bid;
};
__device__ __forceinline__ Ctx fresh(const Ctx& c0) { Ctx c = c0; asm volatile("" : "+v"(c.tid)); asm volatile("" : "+s"(c.ws)); asm volatile("" : "+s"(c.lds)); c.lane = c.tid & 63; return c; }

enum { K_WIN = 0, K_UQ, K_UKV, K_ID, K_GATE, K_UP };
__device__ __forceinline__ int map_col(int kind, int j, float& scale) {
    scale = 1.0f;
    switch (kind) {
    case K_WIN:
        if (j < 384) return j;
        if (j < 416) { const int i = j - 384; return C_KR + (i < 16 ? 2 * i : 2 * (i - 16) + 1); }
        if (j < 672) return C_CB + (j - 416);
        if (j < 928) return C_CC + (j - 672);
        if (j < 1184) return C_CHV + (j - 928);
        if (j < 1440) return C_GU + (j - 1184);
        if (j < 1696) return C_GV + (j - 1440);
        if (j < 1952) { scale = 0.125f * LOG2E; return C_NQ + (j - 1696); }
        if (j < 2016) return C_NKC + (j - 1952);
        if (j < 2080) return C_NVC + (j - 2016);
        if (j < 2144) return C_NKS + (j - 2080);
        if (j < 2208) return C_NVS + (j - 2144);
        if (j < 2272) return C_NKW + (j - 2208);
        if (j < 2336) return C_NVW + (j - 2272);
        return C_NG + (j - 2336);
    case K_UQ: {
        const int h = j / 96, x = j % 96; scale = 0.10206207261596575f * LOG2E;
        if (x < 64) return h * 64 + x;
        const int i = x - 64; return 256 + h * 32 + (i < 16 ? 2 * i : 2 * (i - 16) + 1); }
    case K_UKV: {
        const int h = j >> 7, x = j & 127;
        return x < 64 ? 512 + h * 64 + x : 768 + h * 64 + (x - 64); }
    case K_GATE: return (j >> 7) * 256 + (j & 127);
    case K_UP:   return (j >> 7) * 256 + 128 + (j & 127);
    default: return j;
    }
}
__device__ __forceinline__ void conv_item(const float* src, int src_ld, int nsrc, const float* gain, bf16* dst, int dst_ld, int kdst0, int kind, int nblk, int item, LAS float* scr, int lane) {
    const int kb = item / nblk, nb = item % nblk, k0 = 64 * kb, j0 = 64 * nb;
    const int jr = j0 + 4 * (lane & 15), kr = lane >> 4;
    const int jc = jr < nsrc ? jr : nsrc - 4;
    f32x4 v[16];
#pragma unroll
    for (int i = 0; i < 16; ++i) v[i] = *(const f32x4*)(src + (size_t)(k0 + 4 * i + kr) * src_ld + jc);
    float gv[16];
    if (gain) {
#pragma unroll
        for (int i = 0; i < 16; ++i) gv[i] = gain[k0 + 4 * i + kr];
    } else {
#pragma unroll
        for (int i = 0; i < 16; ++i) gv[i] = 1.0f;
    }
#pragma unroll
    for (int i = 0; i < 16; ++i) { const int kk = 4 * i + kr; const float g = gv[i]; LAS float* p = scr + kk * 65 + 4 * (lane & 15);
        p[0] = v[i][0] * g; p[1] = v[i][1] * g; p[2] = v[i][2] * g; p[3] = v[i][3] * g; }
    LDS_WAIT(); asm volatile("" ::: "memory");
    const int c = lane & 7;
#pragma unroll
    for (int jj = 0; jj < 8; ++jj) { const int n = (lane >> 3) + 8 * jj; const int j = j0 + n;
        if (j < nsrc) { float sc; const int drow = map_col(kind, j, sc); const LAS float* s = scr + (8 * c) * 65 + n;
            u32x4 o; o.x = pk2(s[0 * 65] * sc, s[1 * 65] * sc); o.y = pk2(s[2 * 65] * sc, s[3 * 65] * sc); o.z = pk2(s[4 * 65] * sc, s[5 * 65] * sc); o.w = pk2(s[6 * 65] * sc, s[7 * 65] * sc);
            *(u32x4*)(dst + (size_t)drow * dst_ld + kdst0 + k0 + 8 * c) = o; } }
    LDS_WAIT(); asm volatile("" ::: "memory");
}

__device__ __forceinline__ void zero_rect(bf16* dst, int ld, int r0, int r1, int c0, int c1, int gtid, int nthr) {
    const int nch = (c1 - c0) >> 3, total = (r1 - r0) * nch;
    for (int idx = gtid; idx < total; idx += nthr) { const int r = idx / nch, c = idx % nch; unsigned z = 0u; asm volatile("" : "+v"(z)); *(u32x4*)(dst + (size_t)(r0 + r) * ld + c0 + 8 * c) = (u32x4){z, z, z, z}; }
}

__device__ __forceinline__ void convert_weights(const Args& a, const Ctx& c0, int l) {
    const Ctx c = fresh(c0);
    LAS float* scr = (LAS float*)(c.lds + c.wave * 16640);
    const int gw = c.bid * NWAVES + c.wave, NGW = c.G * NWAVES, gtid = c.bid * (NWAVES * 64) + c.tid, NT = c.G * NWAVES * 64;
    GAS unsigned char* ws = c.ws;
    const int nexp = (l & 1) ? NE : 1;
    constexpr int I_WIN = 37 * 16, I_UQ = 6 * 4, I_UKV = 8 * 2, I_WOI = 16 * 16, I_W1 = 4 * 32, I_W2 = 1 * 4, I_GU = 56 * 16, I_DN = 16 * 56;
    const int n_fixed = I_WIN + I_UQ + I_UKV + I_WOI + 2 * I_W1 + 2 * I_W2;
    const int n_total = n_fixed + nexp * (2 * I_GU + I_DN);
    const float* wg_src = (l & 1) ? argp(I_MW_GATE) + (size_t)(l >> 1) * NE * DM * FF : argp(I_DW_GATE) + (size_t)(l >> 1) * DM * FF;
    const float* wu_src = (l & 1) ? argp(I_MW_UP) + (size_t)(l >> 1) * NE * DM * FF : argp(I_DW_UP) + (size_t)(l >> 1) * DM * FF;
    const float* wd_src = (l & 1) ? argp(I_MW_DOWN) + (size_t)(l >> 1) * NE * DM * FF : argp(I_DW_DOWN) + (size_t)(l >> 1) * DM * FF;
    for (int it = gw; it < n_total; it += NGW) {
        int r = it;
        if (r < I_WIN) { conv_item(argp(I_W_IN) + (size_t)l * DM * DIN, DIN, DIN, argp(I_ATTN_NORM) + l * DM, (bf16*)(ws + WS_WIN), DM, 0, K_WIN, 37, r, scr, c.lane); continue; } r -= I_WIN;
        if (r < I_UQ) { conv_item(argp(I_W_UQ) + (size_t)l * 256 * 384, 384, 384, argp(I_Q_NORM) + l * 256, (bf16*)(ws + WS_WQKV), 384, 0, K_UQ, 6, r, scr, c.lane); continue; } r -= I_UQ;
        if (r < I_UKV) { conv_item(argp(I_W_UKV) + (size_t)l * 128 * 512, 512, 512, argp(I_KV_NORM) + l * 128, (bf16*)(ws + WS_WQKV), 384, 256, K_UKV, 8, r, scr, c.lane); continue; } r -= I_UKV;
        if (r < I_WOI) { conv_item(argp(I_W_O) + (size_t)l * DM * DM, DM, DM, argp(I_GROUP_NORM) + l * DM, (bf16*)(ws + WS_WO), DM, 0, K_ID, 16, r, scr, c.lane); continue; } r -= I_WOI;
        if (r < I_W1) { conv_item(argp(I_W1_K) + (size_t)l * 2048 * 256, 256, 256, nullptr, (bf16*)(ws + WS_W1T), 2048, 0, K_ID, 4, r, scr, c.lane); continue; } r -= I_W1;
        if (r < I_W1) { conv_item(argp(I_W1_V) + (size_t)l * 2048 * 256, 256, 256, nullptr, (bf16*)(ws + WS_W1T) + 256 * 2048, 2048, 0, K_ID, 4, r, scr, c.lane); continue; } r -= I_W1;
        if (r < I_W2) { conv_item(argp(I_W2_K) + (size_t)l * 256 * 64, 64, 64, nullptr, (bf16*)(ws + WS_W2T), 256, 0, K_ID, 1, r, scr, c.lane); continue; } r -= I_W2;
        if (r < I_W2) { conv_item(argp(I_W2_V) + (size_t)l * 256 * 64, 64, 64, nullptr, (bf16*)(ws + WS_W2T) + 64 * 256, 256, 0, K_ID, 1, r, scr, c.lane); continue; } r -= I_W2;
        const int e = r / (2 * I_GU + I_DN); r -= e * (2 * I_GU + I_DN);
        if (r < I_GU) { conv_item(wg_src + (size_t)e * DM * FF, FF, FF, argp(I_FFN_NORM) + l * DM, (bf16*)(ws + WS_WGU) + (size_t)e * 2 * FF * DM, DM, 0, K_GATE, 56, r, scr, c.lane); continue; } r -= I_GU;
        if (r < I_GU) { conv_item(wu_src + (size_t)e * DM * FF, FF, FF, argp(I_FFN_NORM) + l * DM, (bf16*)(ws + WS_WGU) + (size_t)e * 2 * FF * DM, DM, 0, K_UP, 56, r, scr, c.lane); continue; } r -= I_GU;
        conv_item(wd_src + (size_t)e * FF * DM, DM, DM, nullptr, (bf16*)(ws + WS_WD) + (size_t)e * DM * FF, FF, 0, K_ID, 16, r, scr, c.lane);
    }
    zero_rect((bf16*)(ws + WS_WIN), DM, DIN, PP, 0, DM, gtid, NT);
    zero_rect((bf16*)(ws + WS_WQKV), 384, 0, 384, 256, 384, gtid, NT);
    zero_rect((bf16*)(ws + WS_WQKV), 384, 384, 512, 0, 384, gtid, NT);
    zero_rect((bf16*)(ws + WS_WQKV), 384, 512, 1024, 0, 256, gtid, NT);
    { const float* wsrc = argp(I_GMLP_WS) + (size_t)l * 4 * 128 * 128; unsigned* d = (unsigned*)(ws + WS_WGM);
      for (int idx = gtid; idx < 4 * 128 * 64; idx += NT) { const int j = (idx & 63) * 2, i = (idx >> 6) & 127;
          const float v0 = (j <= i) ? wsrc[2 * idx] : 0.f, v1 = (j + 1 <= i) ? wsrc[2 * idx + 1] : 0.f; d[idx] = pk2(v0, v1); } }
    for (int o = gw; o < 512; o += NGW) { const int kv = o >> 8, cc = o & 255; const float* pe = argp(kv ? I_PE_V : I_PE_K) + (size_t)l * 2048; const float* w1 = argp(kv ? I_W1_V : I_W1_K) + (size_t)l * 2048 * 256;
        float sacc = 0.f;
#pragma unroll 8
        for (int i = 0; i < 32; ++i) { const int k = i * 64 + c.lane; sacc += pe[k] * w1[(size_t)k * 256 + cc]; }
        sacc = wave_sum(sacc); if (c.lane == 0) ((float*)(ws + WS_BPE))[o] = sacc; }
    if (l == 0) { const int* pos = (const int*)argp(I_POS); f32x2_t* cs = (f32x2_t*)(ws + WS_CS);
        for (int idx = gtid; idx < T * 16; idx += NT) { const int tk = idx >> 4, i = idx & 15;
            const float inv = __builtin_amdgcn_exp2f(-(float)i * (13.287712379549449f / 16.0f));
            const float ang = (float)pos[tk] * inv; float rev = ang * 0.15915494309189535f; rev -= floorf(rev);
            cs[idx] = (f32x2_t){__builtin_amdgcn_cosf(rev), __builtin_amdgcn_sinf(rev)}; } }
}

template <int MODE>
__device__ __forceinline__ void norm_pass(const Args& a, const Ctx& c0, const float* hsrc, const bf16* add0, const bf16* add1, bool write_h, int l) {
    const Ctx c = fresh(c0);
    const int gw = c.bid * NWAVES + c.wave, NGW = c.G * NWAVES, lane = c.lane;
    float* hout = a.out; bf16* XN = (bf16*)(c.ws + WS_XN); bf16* Hb = (bf16*)(c.ws + WS_H);
    constexpr int R = 4;
    for (int row0 = gw; row0 < T; row0 += R * NGW) {
        f32x4 v[R][4]; u32x2 a0[R][4], a1[R][4];
#pragma unroll
        for (int r = 0; r < R; ++r) { const int row = row0 + r * NGW; const size_t ro = (size_t)(row < T ? row : 0) * DM;
#pragma unroll
            for (int j = 0; j < 4; ++j) { a0[r][j] = (u32x2){0u, 0u}; a1[r][j] = (u32x2){0u, 0u}; } }
        if (hsrc) {
#pragma unroll
            for (int r = 0; r < R; ++r) { const int row = row0 + r * NGW; const size_t ro = (size_t)(row < T ? row : 0) * DM;
#pragma unroll
                for (int j = 0; j < 4; ++j) v[r][j] = *(const f32x4*)(hsrc + ro + 4 * lane + 256 * j); }
        } else {
#pragma unroll
            for (int r = 0; r < R; ++r) { const int row = row0 + r * NGW; const size_t ro = (size_t)(row < T ? row : 0) * DM;
#pragma unroll
                for (int j = 0; j < 4; ++j) { const u32x2 hw = *(const u32x2*)(Hb + ro + 4 * lane + 256 * j); v[r][j] = (f32x4){bflo(hw.x), bfhi(hw.x), bflo(hw.y), bfhi(hw.y)}; } }
        }
        if (add0) {
#pragma unroll
            for (int r = 0; r < R; ++r) { const int row = row0 + r * NGW; const size_t ro = (size_t)(row < T ? row : 0) * DM;
#pragma unroll
                for (int j = 0; j < 4; ++j) a0[r][j] = *(const u32x2*)(add0 + ro + 4 * lane + 256 * j); } }
        if (add1) {
#pragma unroll
            for (int r = 0; r < R; ++r) { const int row = row0 + r * NGW; const size_t ro = (size_t)(row < T ? row : 0) * DM;
#pragma unroll
                for (int j = 0; j < 4; ++j) a1[r][j] = *(const u32x2*)(add1 + ro + 4 * lane + 256 * j); } }
#pragma unroll
        for (int r = 0; r < R; ++r) { const int row = row0 + r * NGW; if (row >= T) break; const size_t ro = (size_t)row * DM;
            float ss = 0.f;
#pragma unroll
            for (int j = 0; j < 4; ++j) { f32x4& x = v[r][j];
                x[0] += bflo(a0[r][j].x) + bflo(a1[r][j].x); x[1] += bfhi(a0[r][j].x) + bfhi(a1[r][j].x); x[2] += bflo(a0[r][j].y) + bflo(a1[r][j].y); x[3] += bfhi(a0[r][j].y) + bfhi(a1[r][j].y);
                ss += (x[0] * x[0] + x[1] * x[1]) + (x[2] * x[2] + x[3] * x[3]); }
            const float rstd = 1.0f / sqrtf(wave_sum(ss) * (1.0f / DM) + EPS);
            if (MODE == 2) {
                const float* g = argp(I_FINAL_NORM);
#pragma unroll
                for (int j = 0; j < 4; ++j) { const f32x4 gv = *(const f32x4*)(g + 4 * lane + 256 * j); *(f32x4*)(hout + ro + 4 * lane + 256 * j) = v[r][j] * rstd * gv; }
            } else {
                if (write_h) {
#pragma unroll
                    for (int j = 0; j < 4; ++j) { u32x2 hw; hw.x = pk2(v[r][j][0], v[r][j][1]); hw.y = pk2(v[r][j][2], v[r][j][3]); *(u32x2*)(Hb + ro + 4 * lane + 256 * j) = hw; }
                }
#pragma unroll
                for (int j = 0; j < 4; ++j) { u32x2 w; w.x = pk2(v[r][j][0] * rstd, v[r][j][1] * rstd); w.y = pk2(v[r][j][2] * rstd, v[r][j][3] * rstd); *(u32x2*)(XN + ro + 4 * lane + 256 * j) = w; }
                if (MODE == 1 && (l & 1)) {
                    const float* g = argp(I_FFN_NORM) + l * DM; const float* wr = argp(I_ROUTER) + (size_t)(l >> 1) * DM * NE;
                    float lg[8];
#pragma unroll
                    for (int e = 0; e < 8; ++e) lg[e] = 0.f;
#pragma unroll
                    for (int j = 0; j < 4; ++j) { const f32x4 gv = *(const f32x4*)(g + 4 * lane + 256 * j);
#pragma unroll
                        for (int i = 0; i < 4; ++i) { const float hn = v[r][j][i] * rstd * gv[i]; const int k = 4 * lane + 256 * j + i;
                            const f32x4 w0 = *(const f32x4*)(wr + (size_t)k * 8), w1 = *(const f32x4*)(wr + (size_t)k * 8 + 4);
                            lg[0] += hn * w0.x; lg[1] += hn * w0.y; lg[2] += hn * w0.z; lg[3] += hn * w0.w; lg[4] += hn * w1.x; lg[5] += hn * w1.y; lg[6] += hn * w1.z; lg[7] += hn * w1.w; } }
#pragma unroll
                    for (int e = 0; e < 8; ++e) lg[e] = wave_sum(lg[e]);
                    int i0 = 0; float l0 = lg[0];
#pragma unroll
                    for (int e = 1; e < 8; ++e) if (lg[e] > l0) { l0 = lg[e]; i0 = e; }
                    int i1 = -1; float l1 = -3.0e38f;
#pragma unroll
                    for (int e = 0; e < 8; ++e) if (e != i0 && lg[e] > l1) { l1 = lg[e]; i1 = e; }
                    const float w0 = 1.0f / (1.0f + __expf(l1 - l0)), w1 = 1.0f - w0;
                    if (lane == 0) {
                        unsigned* cnt = (unsigned*)(c.ws + WS_CTL) + CW_CNT + (l >> 1) * 8 * 64;
                        unsigned* list = (unsigned*)(c.ws + WS_LIST) + (size_t)(l >> 1) * NE * T; float* wl = (float*)(c.ws + WS_WL) + (size_t)(l >> 1) * NE * T;
                        const unsigned p0 = __hip_atomic_fetch_add(cnt + 64 * i0, 1u, __ATOMIC_RELAXED, __HIP_MEMORY_SCOPE_AGENT);
                        list[(size_t)i0 * T + p0] = (unsigned)row * 2u; wl[(size_t)i0 * T + p0] = w0;
                        const unsigned p1 = __hip_atomic_fetch_add(cnt + 64 * i1, 1u, __ATOMIC_RELAXED, __HIP_MEMORY_SCOPE_AGENT);
                        list[(size_t)i1 * T + p1] = (unsigned)row * 2u + 1u; wl[(size_t)i1 * T + p1] = w1;
                    }
                }
            }
        }
    }
}

typedef pg8::Unit Unit;
struct SchedPlain {
    pg8::RectOrder R; unsigned lda2_; const char* B; size_t btile;
    __device__ __forceinline__ bool next(int i, Unit& u) const { u.e = 0; u.aux = 0; u.ne = 0; return R.get(i, u.pm, u.pn); }
    static constexpr bool GATHER = false;
    __device__ __forceinline__ size_t abase(const Unit& u) const { return (size_t)u.pm * 256 * lda2_; }
    __device__ __forceinline__ unsigned lda2() const { return lda2_; }
    __device__ __forceinline__ const char* bbase(const Unit& u) const { return B + (size_t)u.pn * btile; }
};
struct MoeMap {
    int pre1, pre2, pre3, pre4, pre5, pre6, pre7, pre8;
    int c0, c1, c2, c3, c4, c5, c6, c7;
    const unsigned* list; const float* wl;
    __device__ __forceinline__ void locate(int pm, int& e, int& lt, int& ne) const {
        e = 0; lt = pm; ne = c0;
        if (pm >= pre1) { e = 1; lt = pm - pre1; ne = c1; } if (pm >= pre2) { e = 2; lt = pm - pre2; ne = c2; } if (pm >= pre3) { e = 3; lt = pm - pre3; ne = c3; }
        if (pm >= pre4) { e = 4; lt = pm - pre4; ne = c4; } if (pm >= pre5) { e = 5; lt = pm - pre5; ne = c5; } if (pm >= pre6) { e = 6; lt = pm - pre6; ne = c6; }
        if (pm >= pre7) { e = 7; lt = pm - pre7; ne = c7; }
    }
};
__device__ __forceinline__ MoeMap make_moemap(const Ctx& c, int l) {
    MoeMap m;
    if (l & 1) {
        unsigned* cnt = (unsigned*)(c.ws + WS_CTL) + CW_CNT + (l >> 1) * 8 * 64;
        int n[8];
#pragma unroll
        for (int e = 0; e < 8; ++e) n[e] = __builtin_amdgcn_readfirstlane((int)__hip_atomic_load(cnt + 64 * e, __ATOMIC_RELAXED, __HIP_MEMORY_SCOPE_AGENT));
        m.c0 = n[0]; m.c1 = n[1]; m.c2 = n[2]; m.c3 = n[3]; m.c4 = n[4]; m.c5 = n[5]; m.c6 = n[6]; m.c7 = n[7];
        m.pre1 = (n[0] + 255) >> 8; m.pre2 = m.pre1 + ((n[1] + 255) >> 8); m.pre3 = m.pre2 + ((n[2] + 255) >> 8); m.pre4 = m.pre3 + ((n[3] + 255) >> 8);
        m.pre5 = m.pre4 + ((n[4] + 255) >> 8); m.pre6 = m.pre5 + ((n[5] + 255) >> 8); m.pre7 = m.pre6 + ((n[6] + 255) >> 8); m.pre8 = m.pre7 + ((n[7] + 255) >> 8);
        m.list = (const unsigned*)(c.ws + WS_LIST) + (size_t)(l >> 1) * NE * T; m.wl = (const float*)(c.ws + WS_WL) + (size_t)(l >> 1) * NE * T;
    } else {
        m.c0 = T; m.c1 = m.c2 = m.c3 = m.c4 = m.c5 = m.c6 = m.c7 = 0;
        m.pre1 = m.pre2 = m.pre3 = m.pre4 = m.pre5 = m.pre6 = m.pre7 = m.pre8 = T / 256;
        m.list = nullptr; m.wl = nullptr;
    }
    return m;
}
struct SchedGateUp {
    static constexpr bool GATHER = true;
    pg8::RectOrder R; MoeMap M; int t0; const char* B;
    int nd;
    __device__ __forceinline__ bool next(int i, Unit& u) const {
        long L;
        if (nd == 0) L = (long)i * R.G + R.c;
        else if (R.c < nd) { if (i >= 4) return false; L = (long)(i + 3) * R.G + R.c; }
        else { if (i < 7) L = (long)i * R.G + R.c; else if (i == 7) { const int o = R.c - nd; if (o >= 3 * nd) return false; L = (long)(o / nd) * R.G + (o % nd); } else return false; }
        int pm, pn; if (!R.getL(L, pm, pn)) return false; u.pm = t0 + pm; u.pn = pn; M.locate(u.pm, u.e, u.aux, u.ne); return true; }
    __device__ __forceinline__ unsigned arow(const Unit& u, int r) const {
        const int ne = u.ne; int idx = u.aux * 256 + r; idx = idx < ne ? idx : ne - 1;
        const unsigned tok = M.list ? (M.list[(size_t)u.e * T + idx] >> 1) : (unsigned)idx;
        return tok * (unsigned)(DM * 2); }
    __device__ __forceinline__ const char* bbase(const Unit& u) const { return B + ((size_t)u.e * 2 * FF + (size_t)u.pn * 256) * DM * 2; }
};
struct SchedDown {
    pg8::RectOrder R; MoeMap M; int t0; const char* B;
    __device__ __forceinline__ bool next(int i, Unit& u) const { int pm, pn; if (!R.get(i, pm, pn)) return false; u.pm = t0 + pm; u.pn = pn; M.locate(u.pm, u.e, u.aux, u.ne); return true; }
    static constexpr bool GATHER = false;
    __device__ __forceinline__ size_t abase(const Unit& u) const { return (size_t)(u.pm - t0) * 256 * (FF * 2); }
    __device__ __forceinline__ unsigned lda2() const { return (unsigned)(FF * 2); }
    __device__ __forceinline__ const char* bbase(const Unit& u) const { return B + ((size_t)u.e * DM + (size_t)u.pn * 256) * FF * 2; }
};

#define EPI_ARGS const f32x4 (&acc)[2][2][4][2], const Unit& u, int wr, int wc, int fr, int fq
struct EpiInProj {
    static constexpr bool PERM = true;
    bf16* P; float* ssq; float* sskv;
    __device__ __forceinline__ void operator()(EPI_ARGS) const {
#pragma unroll
        for (int ai = 0; ai < 2; ++ai)
#pragma unroll
            for (int m = 0; m < 4; ++m) {
                const int row = u.pm * 256 + ai * 128 + wr * 64 + m * 16 + fr;
                float s0 = 0.f, s1 = 0.f;
#pragma unroll
                for (int bj = 0; bj < 2; ++bj) { const f32x4 v0 = acc[ai][bj][m][0], v1 = acc[ai][bj][m][1];
                    u32x4 w; w.x = pk2(v0[0], v0[1]); w.y = pk2(v0[2], v0[3]); w.z = pk2(v1[0], v1[1]); w.w = pk2(v1[2], v1[3]);
                    *(u32x4*)(P + (size_t)row * PP + u.pn * 256 + bj * 128 + wc * 32 + 8 * fq) = w;
                    const float s = (v0[0] * v0[0] + v0[1] * v0[1]) + (v0[2] * v0[2] + v0[3] * v0[3]) + (v1[0] * v1[0] + v1[1] * v1[1]) + (v1[2] * v1[2] + v1[3] * v1[3]);
                    if (bj == 0) s0 = s; else s1 = s; }
                if (u.pn == 0) { float s = s0 + s1; s += __shfl_xor(s, 16); s += __shfl_xor(s, 32); if (fq == 0) ssq[row * 4 + wc] = s; }
                else if (u.pn == 1) { float s = s0; s += __shfl_xor(s, 16); s += __shfl_xor(s, 32); if (fq == 0) sskv[row * 4 + wc] = s; }
            }
    }
};
struct EpiQkv {
    static constexpr bool PERM = true;
    const float* ssq; const float* sskv; const f32x2_t* cs; bf16 *Qn, *Qr, *Kn, *Vt;
    __device__ __forceinline__ float rstd_of(const float* ss, int row, float invn) const { const f32x4 p = *(const f32x4*)(ss + row * 4); return 1.0f / sqrtf(((p.x + p.y) + (p.z + p.w)) * invn + EPS); }
    __device__ __forceinline__ void operator()(EPI_ARGS) const {
        if (u.pn == 0 || u.pn == 2) {
            bf16* O = u.pn == 0 ? Qn : Kn; const float* ss = u.pn == 0 ? ssq : sskv; const float invn = u.pn == 0 ? (1.0f / 256.0f) : (1.0f / 128.0f);
#pragma unroll
            for (int ai = 0; ai < 2; ++ai)
#pragma unroll
                for (int m = 0; m < 4; ++m) { const int row = u.pm * 256 + ai * 128 + wr * 64 + m * 16 + fr; const float rs = rstd_of(ss, row, invn);
#pragma unroll
                    for (int bj = 0; bj < 2; ++bj) { const f32x4 v0 = acc[ai][bj][m][0] * rs, v1 = acc[ai][bj][m][1] * rs;
                        u32x4 w; w.x = pk2(v0[0], v0[1]); w.y = pk2(v0[2], v0[3]); w.z = pk2(v1[0], v1[1]); w.w = pk2(v1[2], v1[3]);
                        *(u32x4*)(O + (size_t)row * 256 + bj * 128 + wc * 32 + 8 * fq) = w; }
                    asm volatile("" ::: "memory"); }
        } else if (u.pn == 1) {
            const int col = wc * 32 + 8 * fq, i0 = (col & 31) >> 1;
#pragma unroll
            for (int ai = 0; ai < 2; ++ai)
#pragma unroll
                for (int m = 0; m < 4; ++m) { const int row = u.pm * 256 + ai * 128 + wr * 64 + m * 16 + fr; const float rq = rstd_of(ssq, row, 1.0f / 256.0f);
                    const f32x4 ca = *(const f32x4*)(cs + (size_t)row * 16 + i0), cb = *(const f32x4*)(cs + (size_t)row * 16 + i0 + 2);
                    const f32x4 v0 = acc[ai][0][m][0] * rq, v1 = acc[ai][0][m][1] * rq;
                    u32x4 w; w.x = pk2(v0[0] * ca[0] - v0[1] * ca[1], v0[0] * ca[1] + v0[1] * ca[0]); w.y = pk2(v0[2] * ca[2] - v0[3] * ca[3], v0[2] * ca[3] + v0[3] * ca[2]);
                    w.z = pk2(v1[0] * cb[0] - v1[1] * cb[1], v1[0] * cb[1] + v1[1] * cb[0]); w.w = pk2(v1[2] * cb[2] - v1[3] * cb[3], v1[2] * cb[3] + v1[3] * cb[2]);
                    *(u32x4*)(Qr + (size_t)row * 128 + col) = w; asm volatile("" ::: "memory"); }
        } else {
#pragma unroll
            for (int ai = 0; ai < 2; ++ai)
#pragma unroll
                for (int m = 0; m < 4; ++m) { const int row = u.pm * 256 + ai * 128 + wr * 64 + m * 16 + fr; const float rk = rstd_of(sskv, row, 1.0f / 128.0f);
                    const int b = row >> 12, sp = row & 4095;
#pragma unroll
                    for (int bj = 0; bj < 2; ++bj) { const int col = bj * 128 + wc * 32 + 8 * fq; const f32x4 v0 = acc[ai][bj][m][0] * rk, v1 = acc[ai][bj][m][1] * rk;
                        unsigned vo = (unsigned)(((b * 4 + (col >> 6)) * 64 + (col & 63)) * SEQ + sp) * 2u; asm volatile("" : "+v"(vo));
                        char* vb = (char*)Vt + vo;
#pragma unroll
                        for (int i = 0; i < 4; ++i) { *(bf16*)(vb + (size_t)i * SEQ * 2) = (bf16)(pk2(v0[i], 0.f) & 0xffffu); *(bf16*)(vb + (size_t)(4 + i) * SEQ * 2) = (bf16)(pk2(v1[i], 0.f) & 0xffffu); } }
                    asm volatile("" ::: "memory"); }
        }
    }
};
struct EpiBf16Plain {
    static constexpr bool PERM = true;
    bf16* O; int ldc;
    __device__ __forceinline__ void operator()(EPI_ARGS) const {
#pragma unroll
        for (int ai = 0; ai < 2; ++ai)
#pragma unroll
            for (int m = 0; m < 4; ++m) { const int row = u.pm * 256 + ai * 128 + wr * 64 + m * 16 + fr;
#pragma unroll
                for (int bj = 0; bj < 2; ++bj) { const f32x4 v0 = acc[ai][bj][m][0], v1 = acc[ai][bj][m][1];
                    u32x4 w; w.x = pk2(v0[0], v0[1]); w.y = pk2(v0[2], v0[3]); w.z = pk2(v1[0], v1[1]); w.w = pk2(v1[2], v1[3]);
                    *(u32x4*)(O + (size_t)row * ldc + u.pn * 256 + bj * 128 + wc * 32 + 8 * fq) = w; } }
    }
};
struct EpiSwiglu {
    static constexpr bool PERM = true;
    bf16* ACT; int t0;
    __device__ __forceinline__ void operator()(EPI_ARGS) const {
#pragma unroll
        for (int ai = 0; ai < 2; ++ai)
#pragma unroll
            for (int m = 0; m < 4; ++m) { const int row = (u.pm - t0) * 256 + ai * 128 + wr * 64 + m * 16 + fr;
                const f32x4 g0 = acc[ai][0][m][0], g1 = acc[ai][0][m][1], u0 = acc[ai][1][m][0], u1 = acc[ai][1][m][1];
                u32x4 w; w.x = pk2(silu_f(g0[0]) * u0[0], silu_f(g0[1]) * u0[1]); w.y = pk2(silu_f(g0[2]) * u0[2], silu_f(g0[3]) * u0[3]);
                w.z = pk2(silu_f(g1[0]) * u1[0], silu_f(g1[1]) * u1[1]); w.w = pk2(silu_f(g1[2]) * u1[2], silu_f(g1[3]) * u1[3]);
                *(u32x4*)(ACT + (size_t)row * FF + u.pn * 128 + wc * 32 + 8 * fq) = w; }
    }
};
struct EpiDown {
    static constexpr bool PERM = true;
    bf16* O2; MoeMap M;
    __device__ __forceinline__ void operator()(EPI_ARGS) const {
        const int ne = u.ne;
#pragma unroll
        for (int ai = 0; ai < 2; ++ai)
#pragma unroll
            for (int m = 0; m < 4; ++m) { const int idx = u.aux * 256 + ai * 128 + wr * 64 + m * 16 + fr;
                if (idx < ne) {
                    unsigned ts = (unsigned)idx * 2u; float w8 = 1.0f;
                    if (M.list) { ts = M.list[(size_t)u.e * T + idx]; w8 = M.wl[(size_t)u.e * T + idx]; }
                    bf16* orow = O2 + ((size_t)(ts & 1u) * T + (ts >> 1)) * DM + u.pn * 256 + wc * 32 + 8 * fq;
#pragma unroll
                    for (int bj = 0; bj < 2; ++bj) { const f32x4 v0 = acc[ai][bj][m][0] * w8, v1 = acc[ai][bj][m][1] * w8;
                        u32x4 w; w.x = pk2(v0[0], v0[1]); w.y = pk2(v0[2], v0[3]); w.z = pk2(v1[0], v1[1]); w.w = pk2(v1[2], v1[3]);
                        *(u32x4*)(orow + bj * 128) = w; } } }
    }
};

__device__ __forceinline__ void prep_thin(const Args& a, const Ctx& c0, int l) {
    const Ctx c = fresh(c0);
    const int gw = c.bid * NWAVES + c.wave, NGW = c.G * NWAVES, gtid = c.bid * (NWAVES * 64) + c.tid, NT = c.G * NWAVES * 64, lane = c.lane;
    const bf16* P = (const bf16*)(c.ws + WS_P);
    { const f32x2_t* cs = (const f32x2_t*)(c.ws + WS_CS); unsigned* Kr = (unsigned*)(c.ws + WS_KR);
      for (int idx = gtid; idx < T * 16; idx += NT) { const int tk = idx >> 4, i = idx & 15;
          const unsigned w = *(const unsigned*)(P + (size_t)tk * PP + C_KR + 2 * i); const float x1 = bflo(w), x2 = bfhi(w); const f32x2_t t = cs[idx];
          Kr[idx] = pk2(x1 * t.x - x2 * t.y, x1 * t.y + x2 * t.x); } }
    { LAS bf16* tl = (LAS bf16*)(c.lds + c.wave * 8448);
      for (int it = gw; it < 2 * NB * 64; it += NGW) { const int which = it >> 9, b = (it >> 6) & 7, st = it & 63;
          const bf16* src = P + (size_t)(b * SEQ + st * 64) * PP + (which ? C_NVW : C_NVS);
          bf16* dst = (bf16*)(c.ws + (which ? WS_VTW : WS_VTS)) + (size_t)b * 64 * SEQ + st * 64;
#pragma unroll
          for (int i = 0; i < 8; ++i) { const int tk = i * 8 + (lane >> 3), dc = lane & 7; const u32x4 w = *(const u32x4*)(src + (size_t)tk * PP + 8 * dc);
              LAS unsigned* t4 = (LAS unsigned*)(tl + tk * 66 + 8 * dc); t4[0] = w.x; t4[1] = w.y; t4[2] = w.z; t4[3] = w.w; }
          LDS_WAIT(); asm volatile("" ::: "memory");
#pragma unroll
          for (int tc = 0; tc < 8; ++tc) { unsigned short e[8];
#pragma unroll
              for (int k = 0; k < 8; ++k) e[k] = tl[(8 * tc + k) * 66 + lane];
              u32x4 o; o.x = e[0] | ((unsigned)e[1] << 16); o.y = e[2] | ((unsigned)e[3] << 16); o.z = e[4] | ((unsigned)e[5] << 16); o.w = e[6] | ((unsigned)e[7] << 16);
              *(u32x4*)(dst + (size_t)lane * SEQ + 8 * tc) = o; }
          LDS_WAIT(); asm volatile("" ::: "memory"); } }
    { const float* cw = argp(I_CONV_W) + (size_t)l * 3 * 256; bf16* Y = (bf16*)(c.ws + WS_Y);
      const f32x4 w0 = *(const f32x4*)(cw + 4 * lane), w1 = *(const f32x4*)(cw + 256 + 4 * lane), w2 = *(const f32x4*)(cw + 512 + 4 * lane);
      constexpr int R = 4;
      for (int row0 = gw; row0 < T; row0 += R * NGW) {
          u32x2 cc[R][3], hv[R][3], cb[R];
#pragma unroll
          for (int r = 0; r < R; ++r) { const int row = (row0 + r * NGW) < T ? (row0 + r * NGW) : 0; const int s = row & (SEQ - 1);
#pragma unroll
              for (int k = 0; k < 3; ++k) { const int sp = s - 2 + k; const size_t ro = (size_t)(sp >= 0 ? row - 2 + k : row) * PP;
                  cc[r][k] = *(const u32x2*)(P + ro + C_CC + 4 * lane); hv[r][k] = *(const u32x2*)(P + ro + C_CHV + 4 * lane); }
              cb[r] = *(const u32x2*)(P + (size_t)row * PP + C_CB + 4 * lane); }
#pragma unroll
          for (int r = 0; r < R; ++r) { const int row = row0 + r * NGW; if (row >= T) break; const int s = row & (SEQ - 1);
              f32x4 accv = {0.f, 0.f, 0.f, 0.f};
#pragma unroll
              for (int k = 0; k < 3; ++k) { const f32x4 wk = k == 0 ? w0 : (k == 1 ? w1 : w2); const float on = (s - 2 + k >= 0) ? 1.0f : 0.0f;
                  accv[0] += on * wk[0] * bflo(cc[r][k].x) * bflo(hv[r][k].x); accv[1] += on * wk[1] * bfhi(cc[r][k].x) * bfhi(hv[r][k].x);
                  accv[2] += on * wk[2] * bflo(cc[r][k].y) * bflo(hv[r][k].y); accv[3] += on * wk[3] * bfhi(cc[r][k].y) * bfhi(hv[r][k].y); }
              accv[0] *= bflo(cb[r].x); accv[1] *= bfhi(cb[r].x); accv[2] *= bflo(cb[r].y); accv[3] *= bfhi(cb[r].y);
              const float ss = wave_sum((accv[0] * accv[0] + accv[1] * accv[1]) + (accv[2] * accv[2] + accv[3] * accv[3]));
              const float rstd = 1.0f / sqrtf(ss * (1.0f / 256.0f) + EPS);
              u32x2 o; o.x = pk2(accv[0] * rstd, accv[1] * rstd); o.y = pk2(accv[2] * rstd, accv[3] * rstd);
              *(u32x2*)(Y + (size_t)row * DM + 256 + 4 * lane) = o; } } }
}
__device__ __forceinline__ void mla_groupnorm(const Ctx& c0) {
    const Ctx c = fresh(c0);
    const int gw = c.bid * NWAVES + c.wave, NGW = c.G * NWAVES, lane = c.lane; bf16* Y = (bf16*)(c.ws + WS_Y);
    for (int row = gw; row < T; row += NGW) { u32x2* p = (u32x2*)(Y + (size_t)row * DM + 4 * lane); const u32x2 w = *p;
        const float x0 = bflo(w.x), x1 = bfhi(w.x), x2 = bflo(w.y), x3 = bfhi(w.y);
        const float ss = wave_sum((x0 * x0 + x1 * x1) + (x2 * x2 + x3 * x3)); const float rstd = 1.0f / sqrtf(ss * (1.0f / 256.0f) + EPS);
        u32x2 o; o.x = pk2(x0 * rstd, x1 * rstd); o.y = pk2(x2 * rstd, x3 * rstd); *p = o; }
}

#define MFMA32(a, b, c) __builtin_amdgcn_mfma_f32_32x32x16_bf16((a), (b), (c), 0, 0, 0)
__device__ __forceinline__ int crow(int r, int hi) { return (r & 3) + 8 * (r >> 2) + 4 * hi; }

__device__ __forceinline__ void gmlp_unit(const Args& a, const Ctx& c0, int l, int unit) {
    const Ctx c = fresh(c0);
    const int lane = c.lane, w = c.wave, r32 = lane & 31, hi = lane >> 5; const int tok0 = unit * 128;
    const bf16* P = (const bf16*)(c.ws + WS_P); bf16* Y = (bf16*)(c.ws + WS_Y);
    LAS bf16* vnT = (LAS bf16*)c.lds;
    LAS bf16* ug = (LAS bf16*)(c.lds + 69632);
    LAS float* stg = (LAS float*)c.lds;
    const f32x4 lg = *(const f32x4*)(argp(I_GMLP_LN) + l * 256 + 4 * lane);
    __syncthreads();
    {   u32x2 wv[16], wu[16];
#pragma unroll
        for (int jj = 0; jj < 16; ++jj) { const size_t ro = (size_t)(tok0 + w * 16 + jj) * PP; wv[jj] = *(const u32x2*)(P + ro + C_GV + 4 * lane); wu[jj] = *(const u32x2*)(P + ro + C_GU + 4 * lane); }
#pragma unroll
        for (int jj = 0; jj < 16; ++jj) { const int j = w * 16 + jj;
            float x[4] = {gelu_tanh(bflo(wv[jj].x)), gelu_tanh(bfhi(wv[jj].x)), gelu_tanh(bflo(wv[jj].y)), gelu_tanh(bfhi(wv[jj].y))};
            const float mean = wave_sum((x[0] + x[1]) + (x[2] + x[3])) * (1.0f / 256.0f);
#pragma unroll
            for (int i = 0; i < 4; ++i) x[i] -= mean;
            const float var = wave_sum((x[0] * x[0] + x[1] * x[1]) + (x[2] * x[2] + x[3] * x[3])) * (1.0f / 256.0f); const float rstd = 1.0f / sqrtf(var + EPS);
#pragma unroll
            for (int i = 0; i < 4; ++i) vnT[(4 * lane + i) * 136 + j] = (bf16)(pk2(x[i] * rstd * lg[i], 0.f) & 0xffffu);
            u32x2 gu; gu.x = pk2(gelu_tanh(bflo(wu[jj].x)), gelu_tanh(bfhi(wu[jj].x))); gu.y = pk2(gelu_tanh(bflo(wu[jj].y)), gelu_tanh(bfhi(wu[jj].y)));
            *(LAS u32x2*)(ug + j * 256 + 4 * lane) = gu; } }
    __syncthreads();
    const int g = w >> 1; const bf16* WG = (const bf16*)(c.ws + WS_WGM) + (size_t)g * 128 * 128;
    f32x16 acc[4];
#pragma unroll
    for (int it = 0; it < 4; ++it)
#pragma unroll
        for (int r = 0; r < 16; ++r) acc[it][r] = 0.f;
#pragma unroll
    for (int ks = 0; ks < 8; ++ks) { const bf16x8 bfr = *(const LAS bf16x8*)(vnT + (32 * w + r32) * 136 + 16 * ks + 8 * hi);
#pragma unroll
        for (int it = 0; it < 4; ++it) { const bf16x8 afr = *(const bf16x8*)(WG + (size_t)(32 * it + r32) * 128 + 16 * ks + 8 * hi); acc[it] = MFMA32(afr, bfr, acc[it]); } }
    const float* bs = argp(I_GMLP_BS) + (size_t)l * 4 * 128 + g * 128; const int col = 32 * w + r32;
#pragma unroll
    for (int it = 0; it < 4; ++it)
#pragma unroll
        for (int r = 0; r < 16; ++r) { const int i = 32 * it + crow(r, hi); acc[it][r] = bf2f(ug[i * 256 + col]) * (acc[it][r] + bs[i]); }
    __syncthreads();
#pragma unroll
    for (int it = 0; it < 4; ++it)
#pragma unroll
        for (int r = 0; r < 16; ++r) { const int i = 32 * it + crow(r, hi); stg[i * 260 + col] = acc[it][r]; }
    __syncthreads();
    for (int jj = 0; jj < 16; ++jj) { const int i = w * 16 + jj; const f32x4 v = *(const LAS f32x4*)(stg + i * 260 + 4 * lane);
        const float ss = wave_sum((v[0] * v[0] + v[1] * v[1]) + (v[2] * v[2] + v[3] * v[3])); const float rstd = 1.0f / sqrtf(ss * (1.0f / 256.0f) + EPS);
        u32x2 o; o.x = pk2(v[0] * rstd, v[1] * rstd); o.y = pk2(v[2] * rstd, v[3] * rstd); *(u32x2*)(Y + (size_t)(tok0 + i) * DM + 512 + 4 * lane) = o; }
    __syncthreads();
}

__device__ __forceinline__ void compress_unit(const Ctx& c0, int unit) {
    const Ctx c = fresh(c0);
    const int lane = c.lane, w = c.wave, r32 = lane & 31, hi = lane >> 5; const int b = unit >> 4, kv = (unit >> 3) & 1, grp = unit & 7;
    const int kh = w >> 2, cg = w & 3;
    const bf16* P = (const bf16*)(c.ws + WS_P);
    const bf16* arow = P + (size_t)(b * SEQ + 16 * (32 * grp + r32)) * PP + (kv ? C_NVC : C_NKC) + 8 * hi;
    const bf16* brow = (const bf16*)(c.ws + WS_W1T) + ((size_t)kv * 256 + 64 * cg + r32) * 2048 + 8 * hi;
    f32x16 acc0, acc1;
#pragma unroll
    for (int r = 0; r < 16; ++r) { acc0[r] = 0.f; acc1[r] = 0.f; }
#pragma unroll 4
    for (int k2 = 0; k2 < 64; ++k2) { const int ks = 64 * kh + k2;
        const bf16x8 af = *(const bf16x8*)(arow + (size_t)(ks >> 2) * PP + 16 * (ks & 3));
        const bf16x8 b0 = *(const bf16x8*)(brow + 16 * ks), b1 = *(const bf16x8*)(brow + (size_t)32 * 2048 + 16 * ks);
        acc0 = MFMA32(af, b0, acc0); acc1 = MFMA32(af, b1, acc1); }
    LAS float* red = (LAS float*)c.lds;
    LAS bf16* Hs = (LAS bf16*)(c.lds + 33280);
    __syncthreads();
    if (kh == 1) {
#pragma unroll
        for (int r = 0; r < 16; ++r) { red[crow(r, hi) * 260 + 64 * cg + r32] = acc0[r]; red[crow(r, hi) * 260 + 64 * cg + 32 + r32] = acc1[r]; } }
    __syncthreads();
    if (kh == 0) { const float bp0 = ((const float*)(c.ws + WS_BPE))[kv * 256 + 64 * cg + r32], bp1 = ((const float*)(c.ws + WS_BPE))[kv * 256 + 64 * cg + 32 + r32];
#pragma unroll
        for (int r = 0; r < 16; ++r) { const int i = crow(r, hi);
            Hs[i * 264 + 64 * cg + r32] = (bf16)(pk2(gelu_tanh(acc0[r] + red[i * 260 + 64 * cg + r32] + bp0), 0.f) & 0xffffu);
            Hs[i * 264 + 64 * cg + 32 + r32] = (bf16)(pk2(gelu_tanh(acc1[r] + red[i * 260 + 64 * cg + 32 + r32] + bp1), 0.f) & 0xffffu); } }
    __syncthreads();
    if (w < 2) {
        const bf16* w2 = (const bf16*)(c.ws + WS_W2T) + ((size_t)kv * 64 + 32 * w + r32) * 256 + 8 * hi;
        f32x16 o;
#pragma unroll
        for (int r = 0; r < 16; ++r) o[r] = 0.f;
#pragma unroll
        for (int ks = 0; ks < 16; ++ks) { const bf16x8 af = *(const LAS bf16x8*)(Hs + r32 * 264 + 16 * ks + 8 * hi); const bf16x8 bf_ = *(const bf16x8*)(w2 + 16 * ks); o = MFMA32(af, bf_, o); }
        const int n = 32 * w + r32;
#pragma unroll
        for (int r = 0; r < 16; ++r) { const int ig = 32 * grp + crow(r, hi); const bf16 val = ig < 255 ? (bf16)(pk2(o[r], 0.f) & 0xffffu) : (bf16)0;
            if (kv == 0) ((bf16*)(c.ws + WS_KC))[((size_t)b * 256 + ig) * 64 + n] = val; else ((bf16*)(c.ws + WS_VCT))[((size_t)b * 64 + n) * 256 + ig] = val; }
    }
    __syncthreads();
}

constexpr int NSLOT = 4, SLOT_BYTES = 20480, SL_K = 0, SL_V = 8192, SL_KR = 16384;
constexpr int AT_RING = 0, AT_PSEL = NSLOT * SLOT_BYTES, AT_SELM = AT_PSEL + 64 * 65 * 4, AT_TACC = AT_SELM + 512, AT_END = AT_TACC + 8 * 4096;
static_assert(AT_END <= ARENA_BYTES, "attention LDS");
struct FState { f32x16 o0, o1; float m, l; };
__device__ __forceinline__ void fstate_init(FState& st) {
#pragma unroll
    for (int r = 0; r < 16; ++r) { st.o0[r] = 0.f; st.o1[r] = 0.f; }
    st.m = -1e30f; st.l = 0.f;
}
struct QLds { LAS const unsigned char* ql; __device__ __forceinline__ bf16x8 operator[](int ks) const { return *(const LAS bf16x8*)(ql + ks * 1024); } };
template <int DK, class QF> __device__ __forceinline__ void qk_tile(f32x16& p0, f32x16& p1, const QF& qf, LAS const unsigned char* Sb, int r32, int hi) {
    const f32x16 zero16 = {0.f, 0.f, 0.f, 0.f, 0.f, 0.f, 0.f, 0.f, 0.f, 0.f, 0.f, 0.f, 0.f, 0.f, 0.f, 0.f};
    const int xa = (r32 >> 1) & 7;
#pragma unroll
    for (int ks = 0; ks < 4; ++ks) {
        const int off = r32 * 128 + (((2 * ks + hi) ^ xa) << 4);
        const bf16x8 ka = *(const LAS bf16x8*)(Sb + SL_K + off);
        const bf16x8 kb = *(const LAS bf16x8*)(Sb + SL_K + 4096 + off);
        if (ks == 0) { p0 = MFMA32(ka, qf[0], zero16); p1 = MFMA32(kb, qf[0], zero16); }
        else { p0 = MFMA32(ka, qf[ks], p0); p1 = MFMA32(kb, qf[ks], p1); }
    }
    if (DK == 96) {
        const int xr = (r32 >> 2) & 3;
#pragma unroll
        for (int ks = 0; ks < 2; ++ks) {
            const int off = r32 * 64 + (((2 * ks + hi) ^ xr) << 4);
            const bf16x8 ka = *(const LAS bf16x8*)(Sb + SL_KR + off);
            const bf16x8 kb = *(const LAS bf16x8*)(Sb + SL_KR + 2048 + off);
            p0 = MFMA32(ka, qf[4 + ks], p0); p1 = MFMA32(kb, qf[4 + ks], p1); } }
}
template <class QF> __device__ __forceinline__ void qk_step(f32x16& p0, f32x16& p1, const QF& qf, LAS const unsigned char* Sb, int r32, int hi, int ks) {
    const f32x16 zero16 = {0.f, 0.f, 0.f, 0.f, 0.f, 0.f, 0.f, 0.f, 0.f, 0.f, 0.f, 0.f, 0.f, 0.f, 0.f, 0.f};
    bf16x8 ka, kb;
    if (ks < 4) { const int off = r32 * 128 + (((2 * ks + hi) ^ ((r32 >> 1) & 7)) << 4); ka = *(const LAS bf16x8*)(Sb + SL_K + off); kb = *(const LAS bf16x8*)(Sb + SL_K + 4096 + off); }
    else { const int off = r32 * 64 + (((2 * (ks - 4) + hi) ^ ((r32 >> 2) & 3)) << 4); ka = *(const LAS bf16x8*)(Sb + SL_KR + off); kb = *(const LAS bf16x8*)(Sb + SL_KR + 2048 + off); }
    const bf16x8 q = qf[ks];
    if (ks == 0) { p0 = MFMA32(ka, q, zero16); p1 = MFMA32(kb, q, zero16); } else { p0 = MFMA32(ka, q, p0); p1 = MFMA32(kb, q, p1); }
}
__device__ __forceinline__ void pv_step(f32x16& o0, f32x16& o1, const f32x16& p0, const f32x16& p1, LAS const unsigned char* Sb, int r32, int hi, int s) {
    const int xv = (r32 >> 1) & 7, b = 8 * (s & 1);
    u32x4 pw;
    if (s < 2) { pw.x = pk2(p0[b], p0[b + 1]); pw.y = pk2(p0[b + 2], p0[b + 3]); pw.z = pk2(p0[b + 4], p0[b + 5]); pw.w = pk2(p0[b + 6], p0[b + 7]); }
    else       { pw.x = pk2(p1[b], p1[b + 1]); pw.y = pk2(p1[b + 2], p1[b + 3]); pw.z = pk2(p1[b + 4], p1[b + 5]); pw.w = pk2(p1[b + 6], p1[b + 7]); }
    const bf16x8 pf = __builtin_bit_cast(bf16x8, pw);
#pragma unroll
    for (int db = 0; db < 2; ++db) {
        LAS const unsigned char* vrow = Sb + SL_V + (32 * db + r32) * 128 + 8 * hi;
        const u32x2 lo = *(const LAS u32x2*)(vrow + (((2 * s) ^ xv) << 4)), hh = *(const LAS u32x2*)(vrow + (((2 * s + 1) ^ xv) << 4));
        const u32x4 vv = {lo.x, lo.y, hh.x, hh.y}; const bf16x8 vf = __builtin_bit_cast(bf16x8, vv);
        if (db == 0) o0 = MFMA32(vf, pf, o0); else o1 = MFMA32(vf, pf, o1); }
}
__device__ __forceinline__ void pv_tile(f32x16& o0, f32x16& o1, const f32x16& p0, const f32x16& p1, LAS const unsigned char* Sb, int r32, int hi) {
    const int xv = (r32 >> 1) & 7;
#pragma unroll
    for (int s = 0; s < 4; ++s) {
        const int b = 8 * (s & 1);
        u32x4 pw;
        if (s < 2) { pw.x = pk2(p0[b], p0[b + 1]); pw.y = pk2(p0[b + 2], p0[b + 3]); pw.z = pk2(p0[b + 4], p0[b + 5]); pw.w = pk2(p0[b + 6], p0[b + 7]); }
        else       { pw.x = pk2(p1[b], p1[b + 1]); pw.y = pk2(p1[b + 2], p1[b + 3]); pw.z = pk2(p1[b + 4], p1[b + 5]); pw.w = pk2(p1[b + 6], p1[b + 7]); }
        const bf16x8 pf = __builtin_bit_cast(bf16x8, pw);
#pragma unroll
        for (int db = 0; db < 2; ++db) {
            LAS const unsigned char* vrow = Sb + SL_V + (32 * db + r32) * 128 + 8 * hi;
            const u32x2 lo = *(const LAS u32x2*)(vrow + (((2 * s) ^ xv) << 4)), hh = *(const LAS u32x2*)(vrow + (((2 * s + 1) ^ xv) << 4));
            const u32x4 vv = {lo.x, lo.y, hh.x, hh.y}; const bf16x8 vf = __builtin_bit_cast(bf16x8, vv);
            if (db == 0) o0 = MFMA32(vf, pf, o0); else o1 = MFMA32(vf, pf, o1); }
    }
}
template <bool MASKED> __device__ __forceinline__ void softmax_step(FState& st, f32x16& p0, f32x16& p1, bool lane_on = true) {
    float mx = fmaxf(p0[0], p1[0]);
#pragma unroll
    for (int r = 1; r < 16; ++r) mx = fmaxf(mx, fmaxf(p0[r], p1[r]));
    mx = fmaxf(mx, __shfl_xor(mx, 32));
    if (!MASKED) mx = lane_on ? mx : -1e30f;
    if (__any(mx > st.m)) {
        const float mnew = fmaxf(st.m, mx), alpha = __builtin_amdgcn_exp2f(st.m - mnew); st.m = mnew;
        st.l *= alpha;
#pragma unroll
        for (int r = 0; r < 16; ++r) { st.o0[r] *= alpha; st.o1[r] *= alpha; }
    }
    float rs = 0.f;
    if (MASKED) {
        const float m = st.m;
#pragma unroll
        for (int r = 0; r < 16; ++r) { p0[r] = p0[r] > -1e29f ? __builtin_amdgcn_exp2f(p0[r] - m) : 0.f; p1[r] = p1[r] > -1e29f ? __builtin_amdgcn_exp2f(p1[r] - m) : 0.f; rs += p0[r] + p1[r]; }
    } else {
        const float m = lane_on ? st.m : 1e30f;
#pragma unroll
        for (int r = 0; r < 16; ++r) { p0[r] = __builtin_amdgcn_exp2f(p0[r] - m); p1[r] = __builtin_amdgcn_exp2f(p1[r] - m); rs += p0[r] + p1[r]; }
    }
    st.l += rs;
}
__device__ __forceinline__ float max_xor32(float v) { const auto rr = __builtin_amdgcn_permlane32_swap(__float_as_uint(v), __float_as_uint(v), false, false); return fmaxf(__uint_as_float(rr[0]), __uint_as_float(rr[1])); }
#define SMX_I(P0, P1, AL, MEFF, ON) do { float mx_ = fmaxf(P0[0], P1[0]); \
    _Pragma("unroll") for (int r = 1; r < 16; ++r) mx_ = fmaxf(mx_, fmaxf(P0[r], P1[r])); \
    mx_ = max_xor32(mx_); if (LANEON_) mx_ = (ON) ? mx_ : -1e30f; \
    const float mn_ = fmaxf(st.m, mx_); AL = __builtin_amdgcn_exp2f(st.m - mn_); st.m = mn_; MEFF = LANEON_ ? ((ON) ? mn_ : 1e30f) : mn_; } while (0)
#define SMX_II(P, MEFF, RS) do { _Pragma("unroll") for (int r = 0; r < 16; ++r) { P[r] = __builtin_amdgcn_exp2f(P[r] - MEFF); RS += P[r]; } } while (0)
#define SMX_III(AL, RS) do { st.l = st.l * AL + RS; _Pragma("unroll") for (int r = 0; r < 16; ++r) { st.o0[r] *= AL; st.o1[r] *= AL; } } while (0)
#define SBAR0 __builtin_amdgcn_sched_barrier(0)
#define PAIR_NB(DK, LANEON, ONA, ONB) do { constexpr bool LANEON_ = LANEON; \
    f32x16 a0, a1, b0, b1; float alA, mA, rsA = 0.f, alB, mB, rsB = 0.f; \
    qk_tile<DK>(a0, a1, qf, SbA, r32, hi); SBAR0; \
    qk_step(b0, b1, qf, SbB, r32, hi, 0); qk_step(b0, b1, qf, SbB, r32, hi, 1); SMX_I(a0, a1, alA, mA, (ONA)); SBAR0; \
    qk_step(b0, b1, qf, SbB, r32, hi, 2); qk_step(b0, b1, qf, SbB, r32, hi, 3); SMX_II(a0, mA, rsA); SBAR0; \
    if (DK == 96) { qk_step(b0, b1, qf, SbB, r32, hi, 4); qk_step(b0, b1, qf, SbB, r32, hi, 5); } SMX_II(a1, mA, rsA); SMX_III(alA, rsA); SBAR0; \
    pv_step(st.o0, st.o1, a0, a1, SbA, r32, hi, 0); pv_step(st.o0, st.o1, a0, a1, SbA, r32, hi, 1); SMX_I(b0, b1, alB, mB, (ONB)); SMX_II(b0, mB, rsB); SBAR0; \
    pv_step(st.o0, st.o1, a0, a1, SbA, r32, hi, 2); pv_step(st.o0, st.o1, a0, a1, SbA, r32, hi, 3); SMX_II(b1, mB, rsB); SBAR0; \
    SMX_III(alB, rsB); pv_tile(st.o0, st.o1, b0, b1, SbB, r32, hi); } while (0)
template <int DK> struct DmaLoader {
    const char *k1, *k2, *v; unsigned ks1, ks2, vs;
    unsigned o1, o2, ov;
    unsigned ldsbase, w;
    __device__ __forceinline__ void init(const bf16* k1_, int kp1, const bf16* k2_, int kp2, const bf16* v_, int vp, int lane, int wave, LAS unsigned char* lds) {
        k1 = (const char*)k1_; k2 = (const char*)k2_; v = (const char*)v_; ks1 = 64u * kp1 * 2u; ks2 = 64u * kp2 * 2u; vs = 128u; w = (unsigned)wave;
        ldsbase = (unsigned)(uintptr_t)lds + AT_RING;
        { const int key = 8 * wave + (lane >> 3), cc = (lane & 7) ^ ((key >> 1) & 7); o1 = ((unsigned)key * kp1 + 8u * cc) * 2u; }
        { const int key = 16 * (wave & 3) + (lane >> 2), cc = (lane & 3) ^ ((key >> 2) & 3); o2 = ((unsigned)key * kp2 + 8u * cc) * 2u; }
        { const int d = 8 * wave + (lane >> 3), kc = (lane & 7) ^ ((d >> 1) & 7); ov = ((unsigned)d * vp + 8u * kc) * 2u; }
    }
    __device__ __forceinline__ void issue(int j, int slot) const {
        const unsigned sb = ldsbase + (unsigned)slot * SLOT_BYTES;
        __builtin_amdgcn_global_load_lds((const unsigned*)(k1 + (size_t)j * ks1 + o1), (LAS unsigned*)(uintptr_t)(sb + SL_K + w * 1024u), 16, 0, 0);
        __builtin_amdgcn_global_load_lds((const unsigned*)(v + (size_t)j * vs + ov), (LAS unsigned*)(uintptr_t)(sb + SL_V + w * 1024u), 16, 0, 0);
        if (DK == 96) __builtin_amdgcn_global_load_lds((const unsigned*)(k2 + (size_t)j * ks2 + o2), (LAS unsigned*)(uintptr_t)(sb + SL_KR + (w & 3u) * 1024u), 16, 0, 0);
    }
};
#define ATT_WAITV(n) asm volatile("s_waitcnt vmcnt(" #n ")" ::: "memory")
#define TILE_BEGIN(L, J0, J1, WAITSTMT) { \
    const int _j0 = (J0), _j1 = (J1); \
    __syncthreads(); \
    if (_j0 < _j1) { \
    _Pragma("unroll") for (int _p = 0; _p < 3; ++_p) (L).issue((_j0 + _p) < _j1 ? (_j0 + _p) : (_j1 - 1), _p); \
    for (int j = _j0; j < _j1; ++j) { \
        WAITSTMT; __builtin_amdgcn_s_barrier(); asm volatile("" ::: "memory"); \
        (L).issue((j + 3) < _j1 ? (j + 3) : (_j1 - 1), (j - _j0 + 3) & 3); \
        LAS const unsigned char* Sb = c.lds + AT_RING + ((j - _j0) & 3) * SLOT_BYTES;
#define TILE_END(L) \
    } } \
    ATT_WAITV(0); __builtin_amdgcn_s_barrier(); asm volatile("" ::: "memory"); }

#define TILE2_BEGIN(L, J0, J1) { \
    const int _j0 = (J0), _j1 = (J1), _npair = (_j1 - _j0 + 1) >> 1; \
    __syncthreads(); \
    if (_npair > 0) { \
    (L).issue(_j0, 0); (L).issue((_j0 + 1) < _j1 ? (_j0 + 1) : (_j1 - 1), 1); \
    for (int _i = 0; _i < _npair; ++_i) { \
        const int j = _j0 + 2 * _i; const bool hasB = (j + 1) < _j1; \
        ATT_WAITV(0); __builtin_amdgcn_s_barrier(); asm volatile("" ::: "memory"); \
        { const int _jn = j + 2, _s = ((_i + 1) & 1) * 2; (L).issue(_jn < _j1 ? _jn : (_j1 - 1), _s); (L).issue((_jn + 1) < _j1 ? (_jn + 1) : (_j1 - 1), _s + 1); } \
        LAS const unsigned char* SbA = c.lds + AT_RING + ((_i & 1) * 2) * SLOT_BYTES; LAS const unsigned char* SbB = SbA + SLOT_BYTES;
#define TILE2_END(L) \
    } } \
    ATT_WAITV(0); __builtin_amdgcn_s_barrier(); asm volatile("" ::: "memory"); }

__device__ __forceinline__ void mla_unit(const Ctx& c0, int b, int h, int qb) {
    const Ctx c = fresh(c0);
    const int lane = c.lane, w = c.wave, r32 = lane & 31, hi = lane >> 5;
    const int qpos = 256 * qb + 32 * w + r32; const int row = b * SEQ + qpos;
    const bf16* Qn = (const bf16*)(c.ws + WS_QN); const bf16* Qr = (const bf16*)(c.ws + WS_QR);
    LAS unsigned char* qimg = c.lds + NSLOT * SLOT_BYTES + w * 6144 + lane * 16;
    __syncthreads();
#pragma unroll
    for (int ks = 0; ks < 4; ++ks) *(LAS bf16x8*)(qimg + ks * 1024) = *(const bf16x8*)(Qn + (size_t)row * 256 + h * 64 + 16 * ks + 8 * hi);
#pragma unroll
    for (int ks = 0; ks < 2; ++ks) *(LAS bf16x8*)(qimg + (4 + ks) * 1024) = *(const bf16x8*)(Qr + (size_t)row * 128 + h * 32 + 16 * ks + 8 * hi);
    const QLds qf{qimg};
    DmaLoader<96> L; L.init((const bf16*)(c.ws + WS_KN) + (size_t)b * SEQ * 256 + h * 64, 256, (const bf16*)(c.ws + WS_KR) + (size_t)b * SEQ * 32, 32, (const bf16*)(c.ws + WS_VTM) + (size_t)(b * 4 + h) * 64 * SEQ, SEQ, lane, w, c.lds);
    FState st; fstate_init(st);
    const int wmax = 256 * qb + 32 * w + 31;
#define MLA_SM(P0, P1, JJ) do { if (64 * (JJ) + 63 > 256 * qb + 32 * w) { \
            _Pragma("unroll") for (int r = 0; r < 16; ++r) { const int k0 = 64 * (JJ) + crow(r, hi); if (k0 > qpos) P0[r] = -1e30f; if (k0 + 32 > qpos) P1[r] = -1e30f; } \
            softmax_step<true>(st, P0, P1); } else softmax_step<false>(st, P0, P1); } while (0)
    TILE2_BEGIN(L, 0, 4 * qb)
        PAIR_NB(96, false, true, true);
    TILE2_END(L)
    TILE2_BEGIN(L, 4 * qb, 4 * qb + 4)
        const bool needA = 64 * j <= wmax, needB = hasB && (64 * (j + 1) <= wmax);
        if (needB) {
            f32x16 a0, a1, b0, b1; qk_tile<96>(a0, a1, qf, SbA, r32, hi); __builtin_amdgcn_sched_barrier(0); qk_tile<96>(b0, b1, qf, SbB, r32, hi);
            MLA_SM(a0, a1, j); __builtin_amdgcn_sched_barrier(0); pv_tile(st.o0, st.o1, a0, a1, SbA, r32, hi); __builtin_amdgcn_sched_barrier(0);
            MLA_SM(b0, b1, j + 1); __builtin_amdgcn_sched_barrier(0); pv_tile(st.o0, st.o1, b0, b1, SbB, r32, hi);
        } else if (needA) {
            f32x16 a0, a1; qk_tile<96>(a0, a1, qf, SbA, r32, hi);
            MLA_SM(a0, a1, j); pv_tile(st.o0, st.o1, a0, a1, SbA, r32, hi);
        }
    TILE2_END(L)
#undef MLA_SM
    const float lt = st.l + __shfl_xor(st.l, 32); const float inv = 1.0f / lt;
    int qp2 = qpos; asm volatile("" : "+v"(qp2));
    bf16* Y = (bf16*)(c.ws + WS_Y) + (size_t)(b * SEQ + qp2) * DM + h * 64;
#pragma unroll
    for (int g = 0; g < 4; ++g) {
        u32x2 o; o.x = pk2(st.o0[4 * g] * inv, st.o0[4 * g + 1] * inv); o.y = pk2(st.o0[4 * g + 2] * inv, st.o0[4 * g + 3] * inv); *(u32x2*)(Y + 8 * g + 4 * hi) = o;
        u32x2 o2; o2.x = pk2(st.o1[4 * g] * inv, st.o1[4 * g + 1] * inv); o2.y = pk2(st.o1[4 * g + 2] * inv, st.o1[4 * g + 3] * inv); *(u32x2*)(Y + 32 + 8 * g + 4 * hi) = o2; }
}

__device__ __forceinline__ void nsa_unit(const Ctx& c0, int b, int qt) {
    const Ctx c = fresh(c0);
    const int lane = c.lane, w = c.wave, r32 = lane & 31, hi = lane >> 5;
    const int tl = 8 * w + (r32 & 7), head = r32 >> 3, tok = 64 * qt + tl; const int row = b * SEQ + tok;
    const bf16* P = (const bf16*)(c.ws + WS_P);
    bf16x8 qf[4];
#pragma unroll
    for (int ks = 0; ks < 4; ++ks) qf[ks] = *(const bf16x8*)(P + (size_t)row * PP + C_NQ + head * 64 + 16 * ks + 8 * hi);
#define NSA_GATE(br) ({ int t_ = tok; asm volatile("" : "+v"(t_)); sigmoid_f(bf2f(P[(size_t)(b * SEQ + t_) * PP + C_NG + head * 3 + (br)])); })
    LAS float* psel = (LAS float*)(c.lds + AT_PSEL); LAS unsigned long long* selm = (LAS unsigned long long*)(c.lds + AT_SELM);
    __syncthreads();
    for (int i = c.tid; i < 64 * 65; i += NWAVES * 64) psel[i] = 0.f;
    LAS unsigned* tacc = (LAS unsigned*)(c.lds + AT_TACC) + w * 1024 + lane;
    DmaLoader<64> L; L.init((const bf16*)(c.ws + WS_KC) + (size_t)b * 256 * 64, 64, nullptr, 0, (const bf16*)(c.ws + WS_VCT) + (size_t)b * 64 * 256, 256, lane, w, c.lds);
    const int ntc = (4 * qt + 2) / 64 + 1;
    float cm = -1e30f, cl = 0.f;
    TILE_BEGIN(L, 0, ntc, ATT_WAITV(4))
        f32x16 p0, p1; qk_tile<64>(p0, p1, qf, Sb, r32, hi);
        float mx = -1e30f;
#pragma unroll
        for (int r = 0; r < 16; ++r) { const int c0 = 64 * j + crow(r, hi); if (16 * c0 + 31 > tok) p0[r] = -1e30f; if (16 * (c0 + 32) + 31 > tok) p1[r] = -1e30f; mx = fmaxf(mx, fmaxf(p0[r], p1[r])); }
        mx = fmaxf(mx, __shfl_xor(mx, 32));
        const float mnew = fmaxf(cm, mx); float rs = 0.f;
#pragma unroll
        for (int r = 0; r < 16; ++r) { rs += (p0[r] > -1e29f ? __builtin_amdgcn_exp2f(p0[r] - mnew) : 0.f) + (p1[r] > -1e29f ? __builtin_amdgcn_exp2f(p1[r] - mnew) : 0.f); }
        cl = cl * __builtin_amdgcn_exp2f(cm - mnew) + rs; cm = mnew;
    TILE_END(L)
    cl += __shfl_xor(cl, 32);
    const float cinv = cl > 0.f ? 1.0f / cl : 0.f;
    {
        f32x16 o0, o1;
#pragma unroll
        for (int r = 0; r < 16; ++r) { o0[r] = 0.f; o1[r] = 0.f; }
        TILE_BEGIN(L, 0, ntc, ATT_WAITV(4))
            f32x16 p0, p1; qk_tile<64>(p0, p1, qf, Sb, r32, hi);
#pragma unroll
            for (int r = 0; r < 16; ++r) { const int c0 = 64 * j + crow(r, hi);
                p0[r] = (16 * c0 + 31 <= tok) ? __builtin_amdgcn_exp2f(p0[r] - cm) * cinv : 0.f; p1[r] = (16 * (c0 + 32) + 31 <= tok) ? __builtin_amdgcn_exp2f(p1[r] - cm) * cinv : 0.f; }
#pragma unroll
            for (int half = 0; half < 2; ++half)
#pragma unroll
                for (int g = 0; g < 4; ++g) {
                    float av, bv;
                    if (half == 0) { av = p0[4 * g] + p0[4 * g + 1] + p0[4 * g + 2] + 0.5f * p0[4 * g + 3]; bv = 0.5f * p0[4 * g + 3]; }
                    else           { av = p1[4 * g] + p1[4 * g + 1] + p1[4 * g + 2] + 0.5f * p1[4 * g + 3]; bv = 0.5f * p1[4 * g + 3]; }
                    av += __shfl_xor(av, 8); av += __shfl_xor(av, 16); bv += __shfl_xor(bv, 8); bv += __shfl_xor(bv, 16);
                    if (head == 0) { const int n = 16 * j + 8 * half + 2 * g + hi; (void)__hip_atomic_fetch_add(psel + tl * 65 + n, av, __ATOMIC_RELAXED, __HIP_MEMORY_SCOPE_WORKGROUP); (void)__hip_atomic_fetch_add(psel + tl * 65 + n + 1, bv, __ATOMIC_RELAXED, __HIP_MEMORY_SCOPE_WORKGROUP); }
                }
            pv_tile(o0, o1, p0, p1, Sb, r32, hi);
        TILE_END(L)
        { const float g0 = NSA_GATE(0);
#pragma unroll
        for (int r = 0; r < 16; ++r) tacc[r * 64] = pk2(g0 * o0[r], g0 * o1[r]); }
    }
    __syncthreads();
    for (int tt = 0; tt < 8; ++tt) {
        const int tk = 8 * w + tt; float sc = psel[tk * 65 + lane];
        if (lane > qt) sc = -1.0f; else if (lane == 0 || lane == qt || lane == qt - 1) sc = 1e4f;
        int rank = 0;
        for (int n = 0; n < 64; ++n) { const float so = __builtin_bit_cast(float, __builtin_amdgcn_readlane(__builtin_bit_cast(int, sc), n)); rank += (so > sc || (so == sc && n < lane)) ? 1 : 0; }
        const unsigned long long mk = __ballot(rank < 16);
        if (lane == 0) selm[tk] = mk;
    }
    __syncthreads();
    const unsigned long long smask = selm[tl];
    {
        L.init(P + (size_t)b * SEQ * PP + C_NKS, PP, nullptr, 0, (const bf16*)(c.ws + WS_VTS) + (size_t)b * 64 * SEQ, SEQ, lane, w, c.lds);
        FState st; fstate_init(st);
#define SEL_SM(P0, P1, JJ) do { if ((JJ) == qt) { \
            _Pragma("unroll") for (int r = 0; r < 16; ++r) { const int k0 = 64 * (JJ) + crow(r, hi); if (k0 > tok) P0[r] = -1e30f; if (k0 + 32 > tok) P1[r] = -1e30f; } \
            softmax_step<true>(st, P0, P1);   \
        } else softmax_step<false>(st, P0, P1, (bool)((smask >> (JJ)) & 1ull)); } while (0)
        const int qe = qt & ~1;
        TILE2_BEGIN(L, 0, qe)
            PAIR_NB(64, true, (bool)((smask >> j) & 1ull), (bool)((smask >> (j + 1)) & 1ull));
        TILE2_END(L)
        TILE2_BEGIN(L, qe, qt + 1)
            if (hasB) {
                f32x16 a0, a1, b0, b1; qk_tile<64>(a0, a1, qf, SbA, r32, hi); __builtin_amdgcn_sched_barrier(0); qk_tile<64>(b0, b1, qf, SbB, r32, hi);
                SEL_SM(a0, a1, j); __builtin_amdgcn_sched_barrier(0); pv_tile(st.o0, st.o1, a0, a1, SbA, r32, hi); __builtin_amdgcn_sched_barrier(0);
                SEL_SM(b0, b1, j + 1); __builtin_amdgcn_sched_barrier(0); pv_tile(st.o0, st.o1, b0, b1, SbB, r32, hi);
            } else {
                f32x16 a0, a1; qk_tile<64>(a0, a1, qf, SbA, r32, hi);
                SEL_SM(a0, a1, j); pv_tile(st.o0, st.o1, a0, a1, SbA, r32, hi);
            }
        TILE2_END(L)
#undef SEL_SM
        const float lt = st.l + __shfl_xor(st.l, 32); const float f = lt > 0.f ? NSA_GATE(1) / lt : 0.f;
#pragma unroll
        for (int r = 0; r < 16; ++r) { const unsigned t = tacc[r * 64]; tacc[r * 64] = pk2(bflo(t) + f * st.o0[r], bfhi(t) + f * st.o1[r]); }
    }
    f32x16 t0, t1;
    {
        L.init(P + (size_t)b * SEQ * PP + C_NKW, PP, nullptr, 0, (const bf16*)(c.ws + WS_VTW) + (size_t)b * 64 * SEQ, SEQ, lane, w, c.lds);
        FState st; fstate_init(st);
        TILE_BEGIN(L, (qt >= 8 ? qt - 8 : 0), qt + 1, ATT_WAITV(4))
            f32x16 p0, p1; qk_tile<64>(p0, p1, qf, Sb, r32, hi);
            if (j == qt || j + 8 == qt) {
#pragma unroll
                for (int r = 0; r < 16; ++r) { const int k0 = 64 * j + crow(r, hi); if (k0 > tok || k0 + 512 <= tok) p0[r] = -1e30f; if (k0 + 32 > tok || k0 + 32 + 512 <= tok) p1[r] = -1e30f; }
                softmax_step<true>(st, p0, p1);
            } else softmax_step<false>(st, p0, p1);
            pv_tile(st.o0, st.o1, p0, p1, Sb, r32, hi);
        TILE_END(L)
        const float lt = st.l + __shfl_xor(st.l, 32); const float f = lt > 0.f ? NSA_GATE(2) / lt : 0.f;
#pragma unroll
        for (int r = 0; r < 16; ++r) { const unsigned t = tacc[r * 64]; t0[r] = bflo(t) + f * st.o0[r]; t1[r] = bfhi(t) + f * st.o1[r]; }
    }
    float ss = 0.f;
#pragma unroll
    for (int r = 0; r < 16; ++r) ss += t0[r] * t0[r] + t1[r] * t1[r];
    ss += __shfl_xor(ss, 32); ss += __shfl_xor(ss, 8); ss += __shfl_xor(ss, 16);
    const float rstd = 1.0f / sqrtf(ss * (1.0f / 256.0f) + EPS);
    int tk2 = tok; asm volatile("" : "+v"(tk2));
    bf16* Y = (bf16*)(c.ws + WS_Y) + (size_t)(b * SEQ + tk2) * DM + 768 + head * 64;
#pragma unroll
    for (int g = 0; g < 4; ++g) {
        u32x2 o; o.x = pk2(t0[4 * g] * rstd, t0[4 * g + 1] * rstd); o.y = pk2(t0[4 * g + 2] * rstd, t0[4 * g + 3] * rstd); *(u32x2*)(Y + 8 * g + 4 * hi) = o;
        u32x2 o2; o2.x = pk2(t1[4 * g] * rstd, t1[4 * g + 1] * rstd); o2.y = pk2(t1[4 * g + 2] * rstd, t1[4 * g + 3] * rstd); *(u32x2*)(Y + 32 + 8 * g + 4 * hi) = o2; }
}

#ifndef PHMASK
#define PHMASK 0xFFFF
#endif
#define PHON(k) ((PHMASK >> (k)) & 1)
#ifndef SUBMASK
#define SUBMASK 0xFF
#endif
#define SUBON(k) ((SUBMASK >> (k)) & 1)
#ifndef REPMASK
#define REPMASK 0
#endif
#define NREP(k) (((REPMASK >> (k)) & 1) ? 2 : 1)
constexpr int PH_PER_LAYER = 17, PH_FINAL = DEPTH * PH_PER_LAYER, NPH = PH_FINAL + 1;
__global__ void __launch_bounds__(NWAVES * 64, 2) fwd_kernel(Args a) {
    extern __shared__ __attribute__((aligned(16))) unsigned char lds_raw[];
    Ctx c; c.lds = (LAS unsigned char*)lds_raw; c.ws = (GAS unsigned char*)a.ws; c.tid = threadIdx.x; c.lane = c.tid & 63; c.wave = __builtin_amdgcn_readfirstlane(c.tid >> 6); c.G = gridDim.x; c.bid = blockIdx.x;
    volatile LAS unsigned* MISC = (volatile LAS unsigned*)(c.lds + MISC_OFF);
    if (c.tid < 64) MISC[c.tid] = 0u;
    __syncthreads();
    const int lo = a.ph_lo, hi = a.ph_hi;
    const bool multi = (hi - lo) > 1;
    XcdBarrier bar; bar.bar = (unsigned*)(c.ws + WS_CTL) + CW_BAR; bar.x = 0; bar.st = nullptr;
    if (multi) bar = xcd_barrier_post((unsigned*)(c.ws + WS_CTL) + CW_BAR, MISC + 8);
#define IN(k) (lo <= (k) && (k) < hi)
#define SEAM(k) do { if ((k) + 1 < hi) { xcd_barrier(bar, (unsigned*)(c.ws + WS_CTL) + CW_BAR); if (NREP(15) > 1) xcd_barrier(bar, (unsigned*)(c.ws + WS_CTL) + CW_BAR); } } while (0)
    for (int l = 0; l < DEPTH; ++l) {
        GAS unsigned char* ws = c.ws; asm volatile("" : "+s"(ws));
        const int pb = l * PH_PER_LAYER;
        const bool moe = (l & 1) != 0;
        if (PHON(0) && IN(pb + 0)) {
            for (int rep_ = 0; rep_ < NREP(0); ++rep_) convert_weights(a, c, l);
            const bf16* O2 = (const bf16*)(ws + WS_P);
            norm_pass<0>(a, c, l == 0 ? argp(I_X) : nullptr, l > 0 ? O2 : nullptr, (l > 0 && ((l - 1) & 1)) ? O2 + (size_t)T * DM : nullptr, l > 0, l);
            if (NREP(10) > 1) { xcd_barrier(bar, (unsigned*)(c.ws + WS_CTL) + CW_BAR); norm_pass<0>(a, c, l == 0 ? argp(I_X) : nullptr, nullptr, nullptr, false, l); }
            SEAM(pb + 0);
        }
        if (PHON(1) && IN(pb + 1)) for (int rep_ = 0; rep_ < NREP(1); ++rep_) {
            SchedPlain S; S.R.init(T / 256, PP / 256, c.G, c.bid); S.lda2_ = DM * 2; S.B = (const char*)(ws + WS_WIN); S.btile = (size_t)256 * DM * 2;
            EpiInProj E{(bf16*)(ws + WS_P), (float*)(ws + WS_SSQ), (float*)(ws + WS_SSKV)};
            pg8::gemm_phase<EpiInProj, SchedPlain>(c.lds, (const char*)(ws + WS_XN), DM, DM, S, E);
            if (rep_ + 1 < NREP(1)) xcd_barrier(bar, (unsigned*)(c.ws + WS_CTL) + CW_BAR); else SEAM(pb + 1);
        }
        if (PHON(2) && IN(pb + 2)) for (int rep_ = 0; rep_ < NREP(2); ++rep_) {
            if (SUBON(0)) for (int r2_ = 0; r2_ < NREP(11); ++r2_) { SchedPlain S; S.R.init(T / 256, 4, c.G, c.bid); S.lda2_ = PP * 2; S.B = (const char*)(ws + WS_WQKV); S.btile = (size_t)256 * 384 * 2;
              EpiQkv E{(const float*)(ws + WS_SSQ), (const float*)(ws + WS_SSKV), (const f32x2_t*)(ws + WS_CS), (bf16*)(ws + WS_QN), (bf16*)(ws + WS_QR), (bf16*)(ws + WS_KN), (bf16*)(ws + WS_VTM)};
              pg8::gemm_phase<EpiQkv, SchedPlain>(c.lds, (const char*)(ws + WS_P), 384, 384, S, E); }
            if (SUBON(1)) for (int r2_ = 0; r2_ < NREP(12); ++r2_) for (int u = c.bid; u < NB * 32; u += c.G) gmlp_unit(a, c, l, u);
            if (SUBON(2)) for (int r2_ = 0; r2_ < NREP(13); ++r2_) for (int u = c.bid; u < 128; u += c.G) compress_unit(c, u);
            __syncthreads();
            if (SUBON(3)) for (int r2_ = 0; r2_ < NREP(14); ++r2_) prep_thin(a, c, l);
            if (rep_ + 1 < NREP(2)) xcd_barrier(bar, (unsigned*)(c.ws + WS_CTL) + CW_BAR); else SEAM(pb + 2);
        }
        if (PHON(3) && IN(pb + 3)) for (int rep_ = 0; rep_ < NREP(3); ++rep_) {
            const int vcu = (c.G % 8 == 0) ? (c.bid % 8) * (c.G / 8) + c.bid / 8 : c.bid;
            if (SUBON(0)) for (int u = vcu; u < 256; u += c.G) for (int rep = 0; rep < 2; ++rep) { const int bh = u >> 3, s = u & 7; mla_unit(c, bh >> 2, bh & 3, rep ? 15 - s : s); }
            if (SUBON(1)) for (int u = vcu; u < 256; u += c.G) for (int rep = 0; rep < 2; ++rep) { const int b = u >> 5, s = u & 31; nsa_unit(c, b, rep ? 63 - s : s); }
            if (rep_ + 1 < NREP(3)) xcd_barrier(bar, (unsigned*)(c.ws + WS_CTL) + CW_BAR); else SEAM(pb + 3);
        }
        if (PHON(4) && IN(pb + 4)) { mla_groupnorm(c); SEAM(pb + 4); }
        if (PHON(5) && IN(pb + 5)) for (int rep_ = 0; rep_ < NREP(5); ++rep_) {
            SchedPlain S; S.R.init(T / 256, 4, c.G, c.bid); S.lda2_ = DM * 2; S.B = (const char*)(ws + WS_WO); S.btile = (size_t)256 * DM * 2;
            EpiBf16Plain E{(bf16*)(ws + WS_D1), DM};
            pg8::gemm_phase<EpiBf16Plain, SchedPlain>(c.lds, (const char*)(ws + WS_Y), DM, DM, S, E);
            if (rep_ + 1 < NREP(5)) xcd_barrier(bar, (unsigned*)(c.ws + WS_CTL) + CW_BAR); else SEAM(pb + 5);
        }
        if (PHON(6) && IN(pb + 6)) {
            norm_pass<1>(a, c, l == 0 ? argp(I_X) : nullptr, (const bf16*)(ws + WS_D1), nullptr, true, l);
            SEAM(pb + 6);
        }
        if (PHON(7) && IN(pb + 7)) {
            const MoeMap M = make_moemap(c, l);
            const int P8 = M.pre8, rem = P8 & 63, NF = P8 >> 6, nsteps = rem > 0 ? 2 * NF + 1 : 2 * NF;
            for (int sidx = 0; sidx < nsteps; ++sidx) {
                int dk = -2, gk = -2; bool mixed = false;
                if (rem > 0) { if (sidx == 0) gk = -1; else if (sidx == 1) { dk = -1; gk = 0; mixed = true; } else if ((sidx & 1) == 0) dk = sidx / 2 - 1; else gk = (sidx - 1) / 2; }
                else { if ((sidx & 1) == 0) gk = sidx / 2; else dk = sidx / 2; }
                if (dk != -2) {
                    const int t0 = dk < 0 ? 0 : rem + 64 * dk, nM = dk < 0 ? rem : 64;
                    SchedDown S; S.R.init(nM, 4, c.G, c.bid); S.M = M; S.t0 = t0; S.B = (const char*)(ws + WS_WD);
                    EpiDown E{(bf16*)(ws + WS_P), M};
                    pg8::gemm_phase<EpiDown, SchedDown>(c.lds, (const char*)(ws + (dk < 0 ? WS_ACTR : WS_ACT)), FF, FF, S, E);
                }
                if (gk != -2) {
                    const int t0 = gk < 0 ? 0 : rem + 64 * gk, nM = gk < 0 ? rem : 64;
                    SchedGateUp S; S.R.init(nM, 2 * FF / 256, c.G, c.bid); S.M = M; S.t0 = t0; S.B = (const char*)(ws + WS_WGU);
                    S.nd = (mixed && c.G == 256) ? rem * 4 : 0;
                    EpiSwiglu E{(bf16*)(ws + (gk < 0 ? WS_ACTR : WS_ACT)), t0};
                    pg8::gemm_phase<EpiSwiglu, SchedGateUp>(c.lds, (const char*)(ws + WS_XN), DM, DM, S, E);
                }
                xcd_barrier(bar, (unsigned*)(c.ws + WS_CTL) + CW_BAR);
            }
        }
    }
    if (PHON(9) && IN(PH_FINAL)) {
        GAS unsigned char* ws = c.ws;
        const bf16* O2 = (const bf16*)(ws + WS_P);
        norm_pass<2>(a, c, nullptr, O2, O2 + (size_t)T * DM, false, DEPTH - 1);
    }
#undef IN
#undef SEAM
}

#ifndef MK_MULTI_LAUNCH
#define MK_MULTI_LAUNCH 0
#endif
extern "C" void kernel_launch(void* const* d_in, const int* in_sizes, int n_in, void* d_out, int out_size, void* d_ws, size_t ws_size, hipStream_t stream) {
    static int grid = 0;
    if (grid == 0) {
        if (n_in != 29 || out_size != T * DM || ws_size < WS_END) { fprintf(stderr, "kernel_launch: unexpected shapes (n_in %d, out %d, ws %zu < %zu)\n", n_in, out_size, ws_size, (size_t)WS_END); grid = -1; return; }
        int dev = 0, cus = 0, per_cu = 0;
        if (hipGetDevice(&dev) != hipSuccess || hipDeviceGetAttribute(&cus, hipDeviceAttributeMultiprocessorCount, dev) != hipSuccess) { grid = -1; return; }
        if (hipFuncSetAttribute((const void*)fwd_kernel, hipFuncAttributeMaxDynamicSharedMemorySize, LDS_BYTES) != hipSuccess) { fprintf(stderr, "kernel_launch: hipFuncSetAttribute failed\n"); grid = -1; return; }
        if (hipOccupancyMaxActiveBlocksPerMultiprocessor(&per_cu, (const void*)fwd_kernel, NWAVES * 64, LDS_BYTES) != hipSuccess || per_cu < 1) { fprintf(stderr, "kernel_launch: occupancy query says %d\n", per_cu); }
        (void)hipGetLastError();
        grid = cus;
    }
    if (grid < 0) return;
    (void)hipMemsetAsync((char*)d_ws + WS_CTL, 0, CTL_ZERO_BYTES, stream);
    Args a{};
    for (int i = 0; i < 29; ++i) a.in[i] = (const float*)d_in[i];
    a.out = (float*)d_out; a.ws = (unsigned char*)d_ws;
#if MK_MULTI_LAUNCH
    for (int p = 0; p < NPH; ++p) {
        const int l = p / PH_PER_LAYER, q = p % PH_PER_LAYER;
        if (p < PH_FINAL && q >= 7) { const int ch = (q - 7) >> 1; if (ch >= ((l & 1) ? 5 : 2)) continue; }
        a.ph_lo = p; a.ph_hi = p + 1;
        hipLaunchKernelGGL(fwd_kernel, dim3(grid), dim3(NWAVES * 64), LDS_BYTES, stream, a);
    }
#else
    a.ph_lo = 0; a.ph_hi = NPH;
    hipLaunchKernelGGL(fwd_kernel, dim3(grid), dim3(NWAVES * 64), LDS_BYTES, stream, a);
#endif
}
```

```cpp
#include <hip/hip_runtime.h>
#include <cstdio>
#include <cstdint>

#define LAS __attribute__((address_space(3)))
#define GAS __attribute__((address_space(1)))
typedef unsigned short bf16;
typedef short bf16x8 __attribute__((ext_vector_type(8)));
typedef float f32x4 __attribute__((ext_vector_type(4)));
typedef float f32x16 __attribute__((ext_vector_type(16)));
typedef unsigned u32x4 __attribute__((ext_vector_type(4)));
typedef unsigned u32x2 __attribute__((ext_vector_type(2)));
typedef float f32x2_t __attribute__((ext_vector_type(2)));
typedef __bf16 bf16x2_t __attribute__((ext_vector_type(2)));

constexpr int NB = 8, SEQ = 4096, T = NB * SEQ, DM = 1024, DEPTH = 4;
constexpr int DIN = 2348, PP = 2560;
constexpr int FF = 3584, NE = 8;
constexpr float EPS = 1e-6f;
constexpr float LOG2E = 1.4426950408889634f;
constexpr int C_CQ = 0, C_CKV = 256, C_NKC = 384, C_NVC = 448, C_CB = 512, C_CC = 768, C_CHV = 1024, C_GU = 1280, C_GV = 1536,
              C_NQ = 1792, C_NKS = 2048, C_NVS = 2112, C_NKW = 2176, C_NVW = 2240, C_KR = 2304, C_NG = 2336;

constexpr size_t MiB = 1u << 20;
constexpr size_t WS_CTL = 0, CTL_ZERO_BYTES = 1 * MiB;
constexpr size_t WS_CS = 1 * MiB;
constexpr size_t WS_LIST = 5 * MiB;
constexpr size_t WS_WL = 7 * MiB;
constexpr size_t WS_SSQ = 9 * MiB;
constexpr size_t WS_SSKV = WS_SSQ + MiB / 2;
constexpr size_t WS_KC = 10 * MiB;
constexpr size_t WS_VCT = WS_KC + 256 * 1024;
constexpr size_t WS_WQKV = 11 * MiB;
constexpr size_t WS_WGM = WS_WQKV + 768 * 1024;
constexpr size_t WS_W2T = WS_WGM + 128 * 1024;
constexpr size_t WS_BPE = WS_W2T + 64 * 1024;
constexpr size_t WS_W1T = 12 * MiB;
constexpr size_t WS_WIN = 14 * MiB;
constexpr size_t WS_WO = 19 * MiB;
constexpr size_t WS_WGU = 21 * MiB;
constexpr size_t WS_WD = 133 * MiB;
constexpr size_t WS_XN = 189 * MiB;
constexpr size_t WS_P = 253 * MiB;
constexpr size_t WS_QN = 414 * MiB;
constexpr size_t WS_QR = 430 * MiB;
constexpr size_t WS_KN = 438 * MiB;
constexpr size_t WS_KR = 454 * MiB;
constexpr size_t WS_VTM = 456 * MiB;
constexpr size_t WS_VTS = 472 * MiB;
constexpr size_t WS_VTW = 476 * MiB;
constexpr size_t WS_Y = 480 * MiB;
constexpr size_t WS_D1 = 544 * MiB;
constexpr size_t WS_ACT = 608 * MiB;
constexpr size_t WS_H = 720 * MiB;
constexpr size_t WS_ACTR = 784 * MiB;
constexpr size_t WS_END = 800 * MiB;
static_assert(WS_P + (size_t)(T + 64) * PP * 2 <= WS_QN, "P");
constexpr int CW_BAR = 4096;
constexpr int CW_CNT = 16384;

constexpr int NWAVES = 8;
constexpr int ARENA_BYTES = 143360;
constexpr int MISC_OFF = ARENA_BYTES;
constexpr int LDS_BYTES = 147456;

__device__ __forceinline__ unsigned pk2(float lo, float hi) { f32x2_t v = {lo, hi}; bf16x2_t b = __builtin_convertvector(v, bf16x2_t); return __builtin_bit_cast(unsigned, b); }
__device__ __forceinline__ float bf2f(unsigned short x) { return __uint_as_float(((unsigned)x) << 16); }
__device__ __forceinline__ float bflo(unsigned w) { return __uint_as_float(w << 16); }
__device__ __forceinline__ float bfhi(unsigned w) { return __uint_as_float(w & 0xffff0000u); }
__device__ __forceinline__ float wave_sum(float v) {
#pragma unroll
    for (int o = 1; o < 64; o <<= 1) v += __shfl_xor(v, o);
    return v;
}
__device__ __forceinline__ float gelu_tanh(float x) {
    const float u = 0.7978845608028654f * (x + 0.044715f * x * x * x);
    const float e = __builtin_amdgcn_exp2f(u * (2.0f * LOG2E));
    const float th = 1.0f - 2.0f * __builtin_amdgcn_rcpf(e + 1.0f);
    return 0.5f * x * (1.0f + th);
}
__device__ __forceinline__ float silu_f(float x) { return x * __builtin_amdgcn_rcpf(1.0f + __builtin_amdgcn_exp2f(-x * LOG2E)); }
__device__ __forceinline__ float sigmoid_f(float x) { return __builtin_amdgcn_rcpf(1.0f + __builtin_amdgcn_exp2f(-x * LOG2E)); }
#define LDS_WAIT() asm volatile("s_waitcnt lgkmcnt(0)" ::: "memory")
#define VM_WAIT() asm volatile("s_waitcnt vmcnt(0)" ::: "memory")

namespace pg8 {
constexpr int BM = 256, BK = 64, HALF = 128, HTB = HALF * BK * 2, STAGE_BYTES = 8 * HTB, NXCD = 8, WGM = 8;
__host__ __device__ __forceinline__ int lds_byte(int r, int c) { const int st = (r >> 4) * 2 + (c >> 5), rr = r & 15, cc = c & 31, ob = rr * 64 + cc * 2; return st * 1024 + (ob ^ (((ob >> 9) & 1) << 5)); }
__host__ __device__ __forceinline__ void stage_rc(int b, int& R, int& C) { const int st = b / 1024, sb = b % 1024, swz = sb ^ (((sb >> 9) & 1) << 5); R = (st >> 1) * 16 + swz / 64; C = (st & 1) * 32 + (swz % 64) / 2; }
__host__ __device__ __forceinline__ int perm32(int rho) { const int n = rho >> 4, i = rho & 15; return 8 * (i >> 2) + 4 * n + (i & 3); }

struct Unit { int pm, pn, e, aux, ne; };

struct RectOrder {
    int nM, nN, nwg, G, c;
    __device__ __forceinline__ void init(int nM_, int nN_, int G_, int c_) { nM = nM_; nN = nN_; nwg = nM * nN; G = G_; c = c_; }
    __device__ __forceinline__ bool get(int i, int& pm, int& pn) const { return getL((long)i * G + c, pm, pn); }
    __device__ __forceinline__ bool getL(long L, int& pm, int& pn) const {
        if (L >= nwg) return false;
        int wgid = (int)L; { const int q = nwg / NXCD, r = nwg % NXCD, xcd = wgid % NXCD, off = wgid / NXCD; wgid = (xcd < r ? xcd * (q + 1) : r * (q + 1) + (xcd - r) * q) + off; }
        const int nig = WGM * nN, gid = wgid / nig, fm = gid * WGM, gsz = (nM - fm) < WGM ? (nM - fm) : WGM;
        pm = fm + ((wgid % nig) % gsz); pn = (wgid % nig) / gsz; return true;
    }
};

template <class Epi, class Sched>
__device__ __forceinline__ void gemm_phase(LAS unsigned char* lds, const char* Abase, const int K, const int ldb  , const Sched& S, const Epi& E) {
    int tid = threadIdx.x; asm volatile("" : "+v"(tid));
    const int wid = __builtin_amdgcn_readfirstlane(tid >> 6), lane = tid & 63, wr = wid >> 2, wc = wid & 3, fr = lane & 15, fq = lane >> 4;
    int nt = K / BK; asm volatile("" : "+s"(nt));
    int R0, C0, R1, C1; stage_rc(tid * 16, R0, C0); stage_rc(tid * 16 + 8192, R1, C1);
    unsigned voffB[2];
    { const int Rb0 = Epi::PERM ? ((R0 & ~31) + perm32(R0 & 31)) : R0, Rb1 = Epi::PERM ? ((R1 & ~31) + perm32(R1 & 31)) : R1;
      voffB[0] = (unsigned)(Rb0 * ldb + C0) * 2u; voffB[1] = (unsigned)(Rb1 * ldb + C1) * 2u; }
    const size_t kstep = (size_t)(BK * 2);
    const size_t hstepB = (size_t)HALF * ldb * 2;
    const unsigned ldsw = (unsigned)wid * 1024u;
    const int aoff = lds_byte(wr * 64 + fr, fq * 8), boff = lds_byte(wc * 32 + fr, fq * 8);
#define PG8_SA(b, h) (((b) * 2 + (h)) * HTB)
#define PG8_SB(b, h) ((4 + (b) * 2 + (h)) * HTB)
#define PG8_GL(ubase, voff, dstoff) do { unsigned _o = (voff); asm volatile("" : "+v"(_o)); __builtin_amdgcn_global_load_lds((const unsigned*)((const char*)(ubase) + _o), (LAS unsigned*)(lds + (dstoff)), 16, 0, 0); } while (0)
#define PG8_STAGE_B(bufoff, gbase) do { PG8_GL(gbase, voffB[0], (bufoff) + ldsw); PG8_GL(gbase, voffB[1], (bufoff) + ldsw + 8192); } while (0)
#define PG8_STAGE_A0(bufoff, ub, kb) do { PG8_GL(Abase + ((ub) + (kb)), va00, (bufoff) + ldsw); PG8_GL(Abase + ((ub) + (kb)), va01, (bufoff) + ldsw + 8192); } while (0)
#define PG8_STAGE_A1(bufoff, ub, kb) do { PG8_GL(Abase + ((ub) + (kb) + hstepA), va10, (bufoff) + ldsw); PG8_GL(Abase + ((ub) + (kb) + hstepA), va11, (bufoff) + ldsw + 8192); } while (0)
#define PG8_LDA(dst, b, h) do { _Pragma("unroll") for (int m = 0; m < 4; ++m) _Pragma("unroll") for (int k = 0; k < 2; ++k) dst[m][k] = *(const LAS bf16x8*)(lds + PG8_SA(b, h) + aoff + m * 2048 + k * 1024); } while (0)
#define PG8_LDB(dst, b, h) do { _Pragma("unroll") for (int n = 0; n < 2; ++n) _Pragma("unroll") for (int k = 0; k < 2; ++k) dst[n][k] = *(const LAS bf16x8*)(lds + PG8_SB(b, h) + boff + n * 2048 + k * 1024); } while (0)
#define PG8_MMA(ai, bj, At, Bt) do { __builtin_amdgcn_s_setprio(1); _Pragma("unroll") for (int m = 0; m < 4; ++m) _Pragma("unroll") for (int n = 0; n < 2; ++n) _Pragma("unroll") for (int k = 0; k < 2; ++k) \
        acc[ai][bj][m][n] = __builtin_amdgcn_mfma_f32_16x16x32_bf16(Bt[n][k], At[m][k], acc[ai][bj][m][n], 0, 0, 0); __builtin_amdgcn_s_setprio(0); } while (0)
#define PG8_WAIT_V(n) asm volatile("s_waitcnt vmcnt(" #n ")" ::: "memory")
#define PG8_WAIT_L(n) asm volatile("s_waitcnt lgkmcnt(" #n ")" ::: "memory")
#define PG8_BAR __builtin_amdgcn_s_barrier()
#define PG8_SCHED __builtin_amdgcn_sched_barrier(0)
    Unit cur, nxt; int ui = 0;
    if (!S.next(0, cur)) return;
    f32x4 acc[2][2][4][2];
    float zf = 0.f; asm volatile("" : "+v"(zf));
#pragma unroll
    for (int a = 0; a < 2; ++a)
#pragma unroll
        for (int b = 0; b < 2; ++b)
#pragma unroll
            for (int m = 0; m < 4; ++m)
#pragma unroll
                for (int n = 0; n < 2; ++n) acc[a][b][m][n] = (f32x4){zf, zf, zf, zf};
    bf16x8 At[4][2], B0[2][2], B1[2][2];
    unsigned va00, va01, va10, va11; size_t cAb, hstepA;
    if constexpr (Sched::GATHER) { va00 = S.arow(cur, R0) + C0 * 2; va01 = S.arow(cur, R1) + C1 * 2; va10 = S.arow(cur, HALF + R0) + C0 * 2; va11 = S.arow(cur, HALF + R1) + C1 * 2; cAb = 0; hstepA = 0; }
    else { const unsigned l2 = S.lda2(); va00 = (unsigned)R0 * l2 + C0 * 2; va01 = (unsigned)R1 * l2 + C1 * 2; va10 = va00; va11 = va01; cAb = S.abase(cur); hstepA = (size_t)HALF * l2; }
    const char* cB = S.bbase(cur);
    PG8_STAGE_B(PG8_SB(0, 0), cB); PG8_STAGE_B(PG8_SB(0, 1), cB + hstepB); PG8_STAGE_A0(PG8_SA(0, 0), cAb, 0); PG8_STAGE_A1(PG8_SA(0, 1), cAb, 0);
    if (wr == 1) PG8_BAR;
    PG8_WAIT_V(2); PG8_BAR;
    PG8_STAGE_B(PG8_SB(1, 0), cB + kstep); PG8_STAGE_A0(PG8_SA(1, 0), cAb, kstep); PG8_STAGE_B(PG8_SB(1, 1), cB + hstepB + kstep);
    PG8_WAIT_V(6); PG8_BAR;
    for (;;) {
        const bool has_next = S.next(ui + 1, nxt);
        const char* nB = cB; size_t nAb = cAb;
        if (has_next) { nB = S.bbase(nxt); if constexpr (!Sched::GATHER) nAb = S.abase(nxt); }
        for (int t = 0; t < nt; t += 2) {
            const bool last = (t == nt - 2);
            const size_t k1 = (size_t)(t + 1) * kstep;
            const size_t k2 = last ? 0 : (size_t)(t + 2) * kstep, k3 = k2 + kstep;
            const size_t ab2 = last ? nAb : cAb;
            const char* b2 = last ? nB : cB + k2; const char* b3 = b2 + kstep;
            PG8_LDB(B0, 0, 0); PG8_LDB(B1, 0, 1); PG8_SCHED; PG8_LDA(At, 0, 0); PG8_STAGE_A1(PG8_SA(1, 1), cAb, k1);
            if constexpr (Sched::GATHER) { if (last && has_next) {
                va00 = S.arow(nxt, R0) + C0 * 2; va01 = S.arow(nxt, R1) + C1 * 2; va10 = S.arow(nxt, HALF + R0) + C0 * 2; va11 = S.arow(nxt, HALF + R1) + C1 * 2; } }
            PG8_WAIT_V(8); PG8_WAIT_L(0); PG8_BAR; PG8_MMA(0, 0, At, B0); PG8_MMA(0, 1, At, B1); PG8_BAR; PG8_SCHED;
            PG8_LDA(At, 0, 1); PG8_STAGE_B(PG8_SB(0, 0), b2); PG8_STAGE_B(PG8_SB(0, 1), b2 + hstepB); PG8_STAGE_A0(PG8_SA(0, 0), ab2, k2);
            PG8_WAIT_V(8); PG8_WAIT_L(0); PG8_BAR; PG8_MMA(1, 0, At, B0); PG8_MMA(1, 1, At, B1); PG8_BAR; PG8_SCHED;
            PG8_LDB(B0, 1, 0); PG8_LDB(B1, 1, 1); PG8_SCHED; PG8_LDA(At, 1, 0); PG8_STAGE_A1(PG8_SA(0, 1), ab2, k2);
            PG8_WAIT_V(8); PG8_WAIT_L(0); PG8_BAR; PG8_MMA(0, 0, At, B0); PG8_MMA(0, 1, At, B1); PG8_BAR; PG8_SCHED;
            PG8_LDA(At, 1, 1); PG8_STAGE_B(PG8_SB(1, 0), b3); PG8_STAGE_B(PG8_SB(1, 1), b3 + hstepB); PG8_STAGE_A0(PG8_SA(1, 0), ab2, k3);
            PG8_WAIT_V(8); PG8_WAIT_L(0); PG8_BAR; PG8_MMA(1, 0, At, B0); PG8_MMA(1, 1, At, B1); PG8_BAR; PG8_SCHED;
        }
        if (wr == 0) PG8_BAR;
        E(acc, cur, wr, wc, fr, fq);
        if (!has_next) break;
        zf = 0.f; asm volatile("" : "+v"(zf));
#pragma unroll
        for (int a = 0; a < 2; ++a)
#pragma unroll
            for (int b = 0; b < 2; ++b)
#pragma unroll
                for (int m = 0; m < 4; ++m)
#pragma unroll
                    for (int n = 0; n < 2; ++n) acc[a][b][m][n] = (f32x4){zf, zf, zf, zf};
        cur = nxt; cB = nB; cAb = nAb; ++ui;
        if (wr == 1) PG8_BAR;
    }
    PG8_WAIT_V(0);
    PG8_BAR;
#undef PG8_SA
#undef PG8_SB
#undef PG8_GL
#undef PG8_STAGE_A0
#undef PG8_STAGE_A1
#undef PG8_STAGE_B
#undef PG8_LDA
#undef PG8_LDB
#undef PG8_MMA
#undef PG8_WAIT_V
#undef PG8_WAIT_L
#undef PG8_BAR
#undef PG8_SCHED
}
}

#define XB_TMO      128
#define XB_XCNT(j)  (256  + 64 * (j))
#define XB_XSUB(j)  (1280 + 64 * (j))
#define XB_XGEN(j)  (2304 + 64 * (j))
#define XB_TOP      3328
#define XB_TOPGEN   3392
#define XCD_BAR_WORDS 3456
#define XB_SPIN_CAP (1u << 18)
__device__ __forceinline__ unsigned xb_ld(unsigned* p)              { return __hip_atomic_load(p, __ATOMIC_RELAXED, __HIP_MEMORY_SCOPE_AGENT); }
__device__ __forceinline__ unsigned xb_add(unsigned* p, unsigned v) { return __hip_atomic_fetch_add(p, v, __ATOMIC_RELAXED, __HIP_MEMORY_SCOPE_AGENT); }
__device__ __forceinline__ unsigned xb_xcc_id() { return (unsigned)__builtin_amdgcn_s_getreg((3 << 11) | 20) & 0xFu; }
#define XB_SPIN(cond, bar) do { unsigned _sp = 0; while (cond) { __builtin_amdgcn_s_sleep(1); \
    if ((++_sp & 255u) == 0u) { if (xb_ld(&(bar)[XB_TMO])) break; if (_sp > XB_SPIN_CAP) { atomicAdd(&(bar)[XB_TMO], 1u); break; } } } } while (0)
struct XcdBarrier { unsigned* bar; unsigned x; volatile LAS unsigned* st; };
__device__ __forceinline__ XcdBarrier xcd_barrier_post(unsigned* bar, volatile LAS unsigned* st) {
    XcdBarrier b; b.bar = bar; b.x = xb_xcc_id(); b.st = st;
    if (threadIdx.x == 0) (void)xb_add(&bar[XB_XCNT(b.x)], 1u);
    return b;
}
__device__ __forceinline__ void xcd_barrier_complete(unsigned* bar, unsigned x, unsigned& nloc, unsigned& nx) {
    const unsigned G = gridDim.x * gridDim.y * gridDim.z;
    unsigned sum, cnt, mine, sp = 0u;
    for (;;) {
        sum = 0u; cnt = 0u; mine = 0u;
#pragma unroll
        for (unsigned j = 0; j < 16; ++j) { const unsigned c = xb_ld(&bar[XB_XCNT(j)]); sum += c; cnt += (c > 0u) ? 1u : 0u; mine = (j == x) ? c : mine; }
        if (sum == G) break;
        __builtin_amdgcn_s_sleep(1);
        if ((++sp & 255u) == 0u) { if (xb_ld(&bar[XB_TMO])) break; if (sp > XB_SPIN_CAP) { atomicAdd(&bar[XB_TMO], 1u); break; } }
    }
    nloc = mine > 0u ? mine : 1u; nx = cnt > 0u ? cnt : 1u;
}
__device__ __forceinline__ void xcd_barrier(const XcdBarrier& b, unsigned* bar) {
    asm volatile("s_waitcnt vmcnt(0)" ::: "memory");
    __syncthreads();
    if (threadIdx.x == 0) {
        __builtin_amdgcn_s_waitcnt(0);
        unsigned nloc = b.st[0], nx = b.st[1];
        if (nloc == 0u) { xcd_barrier_complete(bar, b.x, nloc, nx); b.st[0] = nloc; b.st[1] = nx; }
        const unsigned old = xb_add(&bar[XB_XSUB(b.x)], 1u);
        const unsigned gen = old / nloc;
        if (old + 1u == (gen + 1u) * nloc) {
            __builtin_amdgcn_fence(__ATOMIC_RELEASE, "agent");
            asm volatile("s_waitcnt vmcnt(0)" ::: "memory");
            const unsigned og = xb_add(&bar[XB_TOP], 1u);
            const unsigned tg = og / nx;
            if (og + 1u == (tg + 1u) * nx) xb_add(&bar[XB_TOPGEN], 1u);
            else XB_SPIN(xb_ld(&bar[XB_TOPGEN]) == tg, bar);
            __builtin_amdgcn_fence(__ATOMIC_ACQUIRE, "agent");
            xb_add(&bar[XB_XGEN(b.x)], 1u);
            asm volatile("s_waitcnt vmcnt(0)" ::: "memory");
        } else {
            XB_SPIN(xb_ld(&bar[XB_XGEN(b.x)]) == gen, bar);
            __builtin_amdgcn_fence(__ATOMIC_ACQUIRE, "agent");
            asm volatile("s_waitcnt vmcnt(0)" ::: "memory");
        }
    }
    __syncthreads();
}

struct Args { const float* in[29]; float* out; unsigned char* ws; int ph_lo, ph_hi; };
static_assert(sizeof(Args) == 29 * 8 + 8 + 8 + 8, "Args has no padding");
enum { I_X = 0, I_POS, I_ATTN_NORM, I_W_IN, I_Q_NORM, I_W_UQ, I_KV_NORM, I_W_UKV, I_CONV_W, I_GMLP_LN, I_GMLP_WS, I_GMLP_BS,
       I_PE_K, I_W1_K, I_W2_K, I_PE_V, I_W1_V, I_W2_V, I_GROUP_NORM, I_W_O, I_FFN_NORM, I_DW_GATE, I_DW_UP, I_DW_DOWN,
       I_ROUTER, I_MW_GATE, I_MW_UP, I_MW_DOWN, I_FINAL_NORM };

typedef GAS const float* __attribute__((address_space(4))) const volatile* kargtab_t;
__device__ __forceinline__ const float* argp(int i) { kargtab_t p = (kargtab_t)__builtin_amdgcn_kernarg_segment_ptr(); GAS const float* g = p[i]; return (const float*)g; }

struct Ctx {
    LAS unsigned char* lds;
    GAS unsigned char* ws;
    int tid, lane, wave, G, bid;
};
__device__ __forceinline__ Ctx fresh(const Ctx& c0) { Ctx c = c0; asm volatile("" : "+v"(c.tid)); asm volatile("" : "+s"(c.ws)); asm volatile("" : "+s"(c.lds)); c.lane = c.tid & 63; return c; }

enum { K_WIN = 0, K_UQ, K_UKV, K_ID, K_GATE, K_UP };
__device__ __forceinline__ int map_col(int kind, int j, float& scale) {
    scale = 1.0f;
    switch (kind) {
    case K_WIN:
        if (j < 384) return j;
        if (j < 416) { const int i = j - 384; return C_KR + (i < 16 ? 2 * i : 2 * (i - 16) + 1); }
        if (j < 672) return C_CB + (j - 416);
        if (j < 928) return C_CC + (j - 672);
        if (j < 1184) return C_CHV + (j - 928);
        if (j < 1440) return C_GU + (j - 1184);
        if (j < 1696) return C_GV + (j - 1440);
        if (j < 1952) { scale = 0.125f * LOG2E; return C_NQ + (j - 1696); }
        if (j < 2016) return C_NKC + (j - 1952);
        if (j < 2080) return C_NVC + (j - 2016);
        if (j < 2144) return C_NKS + (j - 2080);
        if (j < 2208) return C_NVS + (j - 2144);
        if (j < 2272) return C_NKW + (j - 2208);
        if (j < 2336) return C_NVW + (j - 2272);
        return C_NG + (j - 2336);
    case K_UQ: {
        const int h = j / 96, x = j % 96; scale = 0.10206207261596575f * LOG2E;
        if (x < 64) return h * 64 + x;
        const int i = x - 64; return 256 + h * 32 + (i < 16 ? 2 * i : 2 * (i - 16) + 1); }
    case K_UKV: {
        const int h = j >> 7, x = j & 127;
        return x < 64 ? 512 + h * 64 + x : 768 + h * 64 + (x - 64); }
    case K_GATE: return (j >> 7) * 256 + (j & 127);
    case K_UP:   return (j >> 7) * 256 + 128 + (j & 127);
    default: return j;
    }
}
__device__ __forceinline__ void conv_item(const float* src, int src_ld, int nsrc, const float* gain, bf16* dst, int dst_ld, int kdst0, int kind, int nblk, int item, LAS float* scr, int lane) {
    const int kb = item / nblk, nb = item % nblk, k0 = 64 * kb, j0 = 64 * nb;
    const int jr = j0 + 4 * (lane & 15), kr = lane >> 4;
    const int jc = jr < nsrc ? jr : nsrc - 4;
    f32x4 v[16];
#pragma unroll
    for (int i = 0; i < 16; ++i) v[i] = *(const f32x4*)(src + (size_t)(k0 + 4 * i + kr) * src_ld + jc);
    float gv[16];
    if (gain) {
#pragma unroll
        for (int i = 0; i < 16; ++i) gv[i] = gain[k0 + 4 * i + kr];
    } else {
#pragma unroll
        for (int i = 0; i < 16; ++i) gv[i] = 1.0f;
    }
#pragma unroll
    for (int i = 0; i < 16; ++i) { const int kk = 4 * i + kr; const float g = gv[i]; LAS float* p = scr + kk * 65 + 4 * (lane & 15);
        p[0] = v[i][0] * g; p[1] = v[i][1] * g; p[2] = v[i][2] * g; p[3] = v[i][3] * g; }
    LDS_WAIT(); asm volatile("" ::: "memory");
    const int c = lane & 7;
#pragma unroll
    for (int jj = 0; jj < 8; ++jj) { const int n = (lane >> 3) + 8 * jj; const int j = j0 + n;
        if (j < nsrc) { float sc; const int drow = map_col(kind, j, sc); const LAS float* s = scr + (8 * c) * 65 + n;
            u32x4 o; o.x = pk2(s[0 * 65] * sc, s[1 * 65] * sc); o.y = pk2(s[2 * 65] * sc, s[3 * 65] * sc); o.z = pk2(s[4 * 65] * sc, s[5 * 65] * sc); o.w = pk2(s[6 * 65] * sc, s[7 * 65] * sc);
            *(u32x4*)(dst + (size_t)drow * dst_ld + kdst0 + k0 + 8 * c) = o; } }
    LDS_WAIT(); asm volatile("" ::: "memory");
}

__device__ __forceinline__ void zero_rect(bf16* dst, int ld, int r0, int r1, int c0, int c1, int gtid, int nthr) {
    const int nch = (c1 - c0) >> 3, total = (r1 - r0) * nch;
    for (int idx = gtid; idx < total; idx += nthr) { const int r = idx / nch, c = idx % nch; unsigned z = 0u; asm volatile("" : "+v"(z)); *(u32x4*)(dst + (size_t)(r0 + r) * ld + c0 + 8 * c) = (u32x4){z, z, z, z}; }
}

__device__ __forceinline__ void convert_weights(const Args& a, const Ctx& c0, int l) {
    const Ctx c = fresh(c0);
    LAS float* scr = (LAS float*)(c.lds + c.wave * 16640);
    const int gw = c.bid * NWAVES + c.wave, NGW = c.G * NWAVES, gtid = c.bid * (NWAVES * 64) + c.tid, NT = c.G * NWAVES * 64;
    GAS unsigned char* ws = c.ws;
    const int nexp = (l & 1) ? NE : 1;
    constexpr int I_WIN = 37 * 16, I_UQ = 6 * 4, I_UKV = 8 * 2, I_WOI = 16 * 16, I_W1 = 4 * 32, I_W2 = 1 * 4, I_GU = 56 * 16, I_DN = 16 * 56;
    const int n_fixed = I_WIN + I_UQ + I_UKV + I_WOI + 2 * I_W1 + 2 * I_W2;
    const int n_total = n_fixed + nexp * (2 * I_GU + I_DN);
    const float* wg_src = (l & 1) ? argp(I_MW_GATE) + (size_t)(l >> 1) * NE * DM * FF : argp(I_DW_GATE) + (size_t)(l >> 1) * DM * FF;
    const float* wu_src = (l & 1) ? argp(I_MW_UP) + (size_t)(l >> 1) * NE * DM * FF : argp(I_DW_UP) + (size_t)(l >> 1) * DM * FF;
    const float* wd_src = (l & 1) ? argp(I_MW_DOWN) + (size_t)(l >> 1) * NE * DM * FF : argp(I_DW_DOWN) + (size_t)(l >> 1) * DM * FF;
    for (int it = gw; it < n_total; it += NGW) {
        int r = it;
        if (r < I_WIN) { conv_item(argp(I_W_IN) + (size_t)l * DM * DIN, DIN, DIN, argp(I_ATTN_NORM) + l * DM, (bf16*)(ws + WS_WIN), DM, 0, K_WIN, 37, r, scr, c.lane); continue; } r -= I_WIN;
        if (r < I_UQ) { conv_item(argp(I_W_UQ) + (size_t)l * 256 * 384, 384, 384, argp(I_Q_NORM) + l * 256, (bf16*)(ws + WS_WQKV), 384, 0, K_UQ, 6, r, scr, c.lane); continue; } r -= I_UQ;
        if (r < I_UKV) { conv_item(argp(I_W_UKV) + (size_t)l * 128 * 512, 512, 512, argp(I_KV_NORM) + l * 128, (bf16*)(ws + WS_WQKV), 384, 256, K_UKV, 8, r, scr, c.lane); continue; } r -= I_UKV;
        if (r < I_WOI) { conv_item(argp(I_W_O) + (size_t)l * DM * DM, DM, DM, argp(I_GROUP_NORM) + l * DM, (bf16*)(ws + WS_WO), DM, 0, K_ID, 16, r, scr, c.lane); continue; } r -= I_WOI;
        if (r < I_W1) { conv_item(argp(I_W1_K) + (size_t)l * 2048 * 256, 256, 256, nullptr, (bf16*)(ws + WS_W1T), 2048, 0, K_ID, 4, r, scr, c.lane); continue; } r -= I_W1;
        if (r < I_W1) { conv_item(argp(I_W1_V) + (size_t)l * 2048 * 256, 256, 256, nullptr, (bf16*)(ws + WS_W1T) + 256 * 2048, 2048, 0, K_ID, 4, r, scr, c.lane); continue; } r -= I_W1;
        if (r < I_W2) { conv_item(argp(I_W2_K) + (size_t)l * 256 * 64, 64, 64, nullptr, (bf16*)(ws + WS_W2T), 256, 0, K_ID, 1, r, scr, c.lane); continue; } r -= I_W2;
        if (r < I_W2) { conv_item(argp(I_W2_V) + (size_t)l * 256 * 64, 64, 64, nullptr, (bf16*)(ws + WS_W2T) + 64 * 256, 256, 0, K_ID, 1, r, scr, c.lane); continue; } r -= I_W2;
        const int e = r / (2 * I_GU + I_DN); r -= e * (2 * I_GU + I_DN);
        if (r < I_GU) { conv_item(wg_src + (size_t)e * DM * FF, FF, FF, argp(I_FFN_NORM) + l * DM, (bf16*)(ws + WS_WGU) + (size_t)e * 2 * FF * DM, DM, 0, K_GATE, 56, r, scr, c.lane); continue; } r -= I_GU;
        if (r < I_GU) { conv_item(wu_src + (size_t)e * DM * FF, FF, FF, argp(I_FFN_NORM) + l * DM, (bf16*)(ws + WS_WGU) + (size_t)e * 2 * FF * DM, DM, 0, K_UP, 56, r, scr, c.lane); continue; } r -= I_GU;
        conv_item(wd_src + (size_t)e * FF * DM, DM, DM, nullptr, (bf16*)(ws + WS_WD) + (size_t)e * DM * FF, FF, 0, K_ID, 16, r, scr, c.lane);
    }
    zero_rect((bf16*)(ws + WS_WIN), DM, DIN, PP, 0, DM, gtid, NT);
    zero_rect((bf16*)(ws + WS_WQKV), 384, 0, 384, 256, 384, gtid, NT);
    zero_rect((bf16*)(ws + WS_WQKV), 384, 384, 512, 0, 384, gtid, NT);
    zero_rect((bf16*)(ws + WS_WQKV), 384, 512, 1024, 0, 256, gtid, NT);
    { const float* wsrc = argp(I_GMLP_WS) + (size_t)l * 4 * 128 * 128; unsigned* d = (unsigned*)(ws + WS_WGM);
      for (int idx = gtid; idx < 4 * 128 * 64; idx += NT) { const int j = (idx & 63) * 2, i = (idx >> 6) & 127;
          const float v0 = (j <= i) ? wsrc[2 * idx] : 0.f, v1 = (j + 1 <= i) ? wsrc[2 * idx + 1] : 0.f; d[idx] = pk2(v0, v1); } }
    for (int o = gw; o < 512; o += NGW) { const int kv = o >> 8, cc = o & 255; const float* pe = argp(kv ? I_PE_V : I_PE_K) + (size_t)l * 2048; const float* w1 = argp(kv ? I_W1_V : I_W1_K) + (size_t)l * 2048 * 256;
        float sacc = 0.f;
#pragma unroll 8
        for (int i = 0; i < 32; ++i) { const int k = i * 64 + c.lane; sacc += pe[k] * w1[(size_t)k * 256 + cc]; }
        sacc = wave_sum(sacc); if (c.lane == 0) ((float*)(ws + WS_BPE))[o] = sacc; }
    if (l == 0) { const int* pos = (const int*)argp(I_POS); f32x2_t* cs = (f32x2_t*)(ws + WS_CS);
        for (int idx = gtid; idx < T * 16; idx += NT) { const int tk = idx >> 4, i = idx & 15;
            const float inv = __builtin_amdgcn_exp2f(-(float)i * (13.287712379549449f / 16.0f));
            const float ang = (float)pos[tk] * inv; float rev = ang * 0.15915494309189535f; rev -= floorf(rev);
            cs[idx] = (f32x2_t){__builtin_amdgcn_cosf(rev), __builtin_amdgcn_sinf(rev)}; } }
}

template <int MODE>
__device__ __forceinline__ void norm_pass(const Args& a, const Ctx& c0, const float* hsrc, const bf16* add0, const bf16* add1, bool write_h, int l) {
    const Ctx c = fresh(c0);
    const int gw = c.bid * NWAVES + c.wave, NGW = c.G * NWAVES, lane = c.lane;
    float* hout = a.out; bf16* XN = (bf16*)(c.ws + WS_XN); bf16* Hb = (bf16*)(c.ws + WS_H);
    constexpr int R = 4;
    for (int row0 = gw; row0 < T; row0 += R * NGW) {
        f32x4 v[R][4]; u32x2 a0[R][4], a1[R][4];
#pragma unroll
        for (int r = 0; r < R; ++r) { const int row = row0 + r * NGW; const size_t ro = (size_t)(row < T ? row : 0) * DM;
#pragma unroll
            for (int j = 0; j < 4; ++j) { a0[r][j] = (u32x2){0u, 0u}; a1[r][j] = (u32x2){0u, 0u}; } }
        if (hsrc) {
#pragma unroll
            for (int r = 0; r < R; ++r) { const int row = row0 + r * NGW; const size_t ro = (size_t)(row < T ? row : 0) * DM;
#pragma unroll
                for (int j = 0; j < 4; ++j) v[r][j] = *(const f32x4*)(hsrc + ro + 4 * lane + 256 * j); }
        } else {
#pragma unroll
            for (int r = 0; r < R; ++r) { const int row = row0 + r * NGW; const size_t ro = (size_t)(row < T ? row : 0) * DM;
#pragma unroll
                for (int j = 0; j < 4; ++j) { const u32x2 hw = *(const u32x2*)(Hb + ro + 4 * lane + 256 * j); v[r][j] = (f32x4){bflo(hw.x), bfhi(hw.x), bflo(hw.y), bfhi(hw.y)}; } }
        }
        if (add0) {
#pragma unroll
            for (int r = 0; r < R; ++r) { const int row = row0 + r * NGW; const size_t ro = (size_t)(row < T ? row : 0) * DM;
#pragma unroll
                for (int j = 0; j < 4; ++j) a0[r][j] = *(const u32x2*)(add0 + ro + 4 * lane + 256 * j); } }
        if (add1) {
#pragma unroll
            for (int r = 0; r < R; ++r) { const int row = row0 + r * NGW; const size_t ro = (size_t)(row < T ? row : 0) * DM;
#pragma unroll
                for (int j = 0; j < 4; ++j) a1[r][j] = *(const u32x2*)(add1 + ro + 4 * lane + 256 * j); } }
#pragma unroll
        for (int r = 0; r < R; ++r) { const int row = row0 + r * NGW; if (row >= T) break; const size_t ro = (size_t)row * DM;
            float ss = 0.f;
#pragma unroll
            for (int j = 0; j < 4; ++j) { f32x4& x = v[r][j];
                x[0] += bflo(a0[r][j].x) + bflo(a1[r][j].x); x[1] += bfhi(a0[r][j].x) + bfhi(a1[r][j].x); x[2] += bflo(a0[r][j].y) + bflo(a1[r][j].y); x[3] += bfhi(a0[r][j].y) + bfhi(a1[r][j].y);
                ss += (x[0] * x[0] + x[1] * x[1]) + (x[2] * x[2] + x[3] * x[3]); }
            const float rstd = 1.0f / sqrtf(wave_sum(ss) * (1.0f / DM) + EPS);
            if (MODE == 2) {
                const float* g = argp(I_FINAL_NORM);
#pragma unroll
                for (int j = 0; j < 4; ++j) { const f32x4 gv = *(const f32x4*)(g + 4 * lane + 256 * j); *(f32x4*)(hout + ro + 4 * lane + 256 * j) = v[r][j] * rstd * gv; }
            } else {
                if (write_h) {
#pragma unroll
                    for (int j = 0; j < 4; ++j) { u32x2 hw; hw.x = pk2(v[r][j][0], v[r][j][1]); hw.y = pk2(v[r][j][2], v[r][j][3]); *(u32x2*)(Hb + ro + 4 * lane + 256 * j) = hw; }
                }
#pragma unroll
                for (int j = 0; j < 4; ++j) { u32x2 w; w.x = pk2(v[r][j][0] * rstd, v[r][j][1] * rstd); w.y = pk2(v[r][j][2] * rstd, v[r][j][3] * rstd); *(u32x2*)(XN + ro + 4 * lane + 256 * j) = w; }
                if (MODE == 1 && (l & 1)) {
                    const float* g = argp(I_FFN_NORM) + l * DM; const float* wr = argp(I_ROUTER) + (size_t)(l >> 1) * DM * NE;
                    float lg[8];
#pragma unroll
                    for (int e = 0; e < 8; ++e) lg[e] = 0.f;
#pragma unroll
                    for (int j = 0; j < 4; ++j) { const f32x4 gv = *(const f32x4*)(g + 4 * lane + 256 * j);
#pragma unroll
                        for (int i = 0; i < 4; ++i) { const float hn = v[r][j][i] * rstd * gv[i]; const int k = 4 * lane + 256 * j + i;
                            const f32x4 w0 = *(const f32x4*)(wr + (size_t)k * 8), w1 = *(const f32x4*)(wr + (size_t)k * 8 + 4);
                            lg[0] += hn * w0.x; lg[1] += hn * w0.y; lg[2] += hn * w0.z; lg[3] += hn * w0.w; lg[4] += hn * w1.x; lg[5] += hn * w1.y; lg[6] += hn * w1.z; lg[7] += hn * w1.w; } }
#pragma unroll
                    for (int e = 0; e < 8; ++e) lg[e] = wave_sum(lg[e]);
                    int i0 = 0; float l0 = lg[0];
#pragma unroll
                    for (int e = 1; e < 8; ++e) if (lg[e] > l0) { l0 = lg[e]; i0 = e; }
                    int i1 = -1; float l1 = -3.0e38f;
#pragma unroll
                    for (int e = 0; e < 8; ++e) if (e != i0 && lg[e] > l1) { l1 = lg[e]; i1 = e; }
                    const float w0 = 1.0f / (1.0f + __expf(l1 - l0)), w1 = 1.0f - w0;
                    if (lane == 0) {
                        unsigned* cnt = (unsigned*)(c.ws + WS_CTL) + CW_CNT + (l >> 1) * 8 * 64;
                        unsigned* list = (unsigned*)(c.ws + WS_LIST) + (size_t)(l >> 1) * NE * T; float* wl = (float*)(c.ws + WS_WL) + (size_t)(l >> 1) * NE * T;
                        const unsigned p0 = __hip_atomic_fetch_add(cnt + 64 * i0, 1u, __ATOMIC_RELAXED, __HIP_MEMORY_SCOPE_AGENT);
                        list[(size_t)i0 * T + p0] = (unsigned)row * 2u; wl[(size_t)i0 * T + p0] = w0;
                        const unsigned p1 = __hip_atomic_fetch_add(cnt + 64 * i1, 1u, __ATOMIC_RELAXED, __HIP_MEMORY_SCOPE_AGENT);
                        list[(size_t)i1 * T + p1] = (unsigned)row * 2u + 1u; wl[(size_t)i1 * T + p1] = w1;
                    }
                }
            }
        }
    }
}

typedef pg8::Unit Unit;
struct SchedPlain {
    pg8::RectOrder R; unsigned lda2_; const char* B; size_t btile;
    __device__ __forceinline__ bool next(int i, Unit& u) const { u.e = 0; u.aux = 0; u.ne = 0; return R.get(i, u.pm, u.pn); }
    static constexpr bool GATHER = false;
    __device__ __forceinline__ size_t abase(const Unit& u) const { return (size_t)u.pm * 256 * lda2_; }
    __device__ __forceinline__ unsigned lda2() const { return lda2_; }
    __device__ __forceinline__ const char* bbase(const Unit& u) const { return B + (size_t)u.pn * btile; }
};
struct MoeMap {
    int pre1, pre2, pre3, pre4, pre5, pre6, pre7, pre8;
    int c0, c1, c2, c3, c4, c5, c6, c7;
    const unsigned* list; const float* wl;
    __device__ __forceinline__ void locate(int pm, int& e, int& lt, int& ne) const {
        e = 0; lt = pm; ne = c0;
        if (pm >= pre1) { e = 1; lt = pm - pre1; ne = c1; } if (pm >= pre2) { e = 2; lt = pm - pre2; ne = c2; } if (pm >= pre3) { e = 3; lt = pm - pre3; ne = c3; }
        if (pm >= pre4) { e = 4; lt = pm - pre4; ne = c4; } if (pm >= pre5) { e = 5; lt = pm - pre5; ne = c5; } if (pm >= pre6) { e = 6; lt = pm - pre6; ne = c6; }
        if (pm >= pre7) { e = 7; lt = pm - pre7; ne = c7; }
    }
};
__device__ __forceinline__ MoeMap make_moemap(const Ctx& c, int l) {
    MoeMap m;
    if (l & 1) {
        unsigned* cnt = (unsigned*)(c.ws + WS_CTL) + CW_CNT + (l >> 1) * 8 * 64;
        int n[8];
#pragma unroll
        for (int e = 0; e < 8; ++e) n[e] = __builtin_amdgcn_readfirstlane((int)__hip_atomic_load(cnt + 64 * e, __ATOMIC_RELAXED, __HIP_MEMORY_SCOPE_AGENT));
        m.c0 = n[0]; m.c1 = n[1]; m.c2 = n[2]; m.c3 = n[3]; m.c4 = n[4]; m.c5 = n[5]; m.c6 = n[6]; m.c7 = n[7];
        m.pre1 = (n[0] + 255) >> 8; m.pre2 = m.pre1 + ((n[1] + 255) >> 8); m.pre3 = m.pre2 + ((n[2] + 255) >> 8); m.pre4 = m.pre3 + ((n[3] + 255) >> 8);
        m.pre5 = m.pre4 + ((n[4] + 255) >> 8); m.pre6 = m.pre5 + ((n[5] + 255) >> 8); m.pre7 = m.pre6 + ((n[6] + 255) >> 8); m.pre8 = m.pre7 + ((n[7] + 255) >> 8);
        m.list = (const unsigned*)(c.ws + WS_LIST) + (size_t)(l >> 1) * NE * T; m.wl = (const float*)(c.ws + WS_WL) + (size_t)(l >> 1) * NE * T;
    } else {
        m.c0 = T; m.c1 = m.c2 = m.c3 = m.c4 = m.c5 = m.c6 = m.c7 = 0;
        m.pre1 = m.pre2 = m.pre3 = m.pre4 = m.pre5 = m.pre6 = m.pre7 = m.pre8 = T / 256;
        m.list = nullptr; m.wl = nullptr;
    }
    return m;
}
struct SchedGateUp {
    static constexpr bool GATHER = true;
    pg8::RectOrder R; MoeMap M; int t0; const char* B;
    int nd;
    __device__ __forceinline__ bool next(int i, Unit& u) const {
        long L;
        if (nd == 0) L = (long)i * R.G + R.c;
        else if (R.c < nd) { if (i >= 4) return false; L = (long)(i + 3) * R.G + R.c; }
        else { if (i < 7) L = (long)i * R.G + R.c; else if (i == 7) { const int o = R.c - nd; if (o >= 3 * nd) return false; L = (long)(o / nd) * R.G + (o % nd); } else return false; }
        int pm, pn; if (!R.getL(L, pm, pn)) return false; u.pm = t0 + pm; u.pn = pn; M.locate(u.pm, u.e, u.aux, u.ne); return true; }
    __device__ __forceinline__ unsigned arow(const Unit& u, int r) const {
        const int ne = u.ne; int idx = u.aux * 256 + r; idx = idx < ne ? idx : ne - 1;
        const unsigned tok = M.list ? (M.list[(size_t)u.e * T + idx] >> 1) : (unsigned)idx;
        return tok * (unsigned)(DM * 2); }
    __device__ __forceinline__ const char* bbase(const Unit& u) const { return B + ((size_t)u.e * 2 * FF + (size_t)u.pn * 256) * DM * 2; }
};
struct SchedDown {
    pg8::RectOrder R; MoeMap M; int t0; const char* B;
    __device__ __forceinline__ bool next(int i, Unit& u) const { int pm, pn; if (!R.get(i, pm, pn)) return false; u.pm = t0 + pm; u.pn = pn; M.locate(u.pm, u.e, u.aux, u.ne); return true; }
    static constexpr bool GATHER = false;
    __device__ __forceinline__ size_t abase(const Unit& u) const { return (size_t)(u.pm - t0) * 256 * (FF * 2); }
    __device__ __forceinline__ unsigned lda2() const { return (unsigned)(FF * 2); }
    __device__ __forceinline__ const char* bbase(const Unit& u) const { return B + ((size_t)u.e * DM + (size_t)u.pn * 256) * FF * 2; }
};

#define EPI_ARGS const f32x4 (&acc)[2][2][4][2], const Unit& u, int wr, int wc, int fr, int fq
struct EpiInProj {
    static constexpr bool PERM = true;
    bf16* P; float* ssq; float* sskv;
    __device__ __forceinline__ void operator()(EPI_ARGS) const {
#pragma unroll
        for (int ai = 0; ai < 2; ++ai)
#pragma unroll
            for (int m = 0; m < 4; ++m) {
                const int row = u.pm * 256 + ai * 128 + wr * 64 + m * 16 + fr;
                float s0 = 0.f, s1 = 0.f;
#pragma unroll
                for (int bj = 0; bj < 2; ++bj) { const f32x4 v0 = acc[ai][bj][m][0], v1 = acc[ai][bj][m][1];
                    u32x4 w; w.x = pk2(v0[0], v0[1]); w.y = pk2(v0[2], v0[3]); w.z = pk2(v1[0], v1[1]); w.w = pk2(v1[2], v1[3]);
                    *(u32x4*)(P + (size_t)row * PP + u.pn * 256 + bj * 128 + wc * 32 + 8 * fq) = w;
                    const float s = (v0[0] * v0[0] + v0[1] * v0[1]) + (v0[2] * v0[2] + v0[3] * v0[3]) + (v1[0] * v1[0] + v1[1] * v1[1]) + (v1[2] * v1[2] + v1[3] * v1[3]);
                    if (bj == 0) s0 = s; else s1 = s; }
                if (u.pn == 0) { float s = s0 + s1; s += __shfl_xor(s, 16); s += __shfl_xor(s, 32); if (fq == 0) ssq[row * 4 + wc] = s; }
                else if (u.pn == 1) { float s = s0; s += __shfl_xor(s, 16); s += __shfl_xor(s, 32); if (fq == 0) sskv[row * 4 + wc] = s; }
            }
    }
};
struct EpiQkv {
    static constexpr bool PERM = true;
    const float* ssq; const float* sskv; const f32x2_t* cs; bf16 *Qn, *Qr, *Kn, *Vt;
    __device__ __forceinline__ float rstd_of(const float* ss, int row, float invn) const { const f32x4 p = *(const f32x4*)(ss + row * 4); return 1.0f / sqrtf(((p.x + p.y) + (p.z + p.w)) * invn + EPS); }
    __device__ __forceinline__ void operator()(EPI_ARGS) const {
        if (u.pn == 0 || u.pn == 2) {
            bf16* O = u.pn == 0 ? Qn : Kn; const float* ss = u.pn == 0 ? ssq : sskv; const float invn = u.pn == 0 ? (1.0f / 256.0f) : (1.0f / 128.0f);
#pragma unroll
            for (int ai = 0; ai < 2; ++ai)
#pragma unroll
                for (int m = 0; m < 4; ++m) { const int row = u.pm * 256 + ai * 128 + wr * 64 + m * 16 + fr; const float rs = rstd_of(ss, row, invn);
#pragma unroll
                    for (int bj = 0; bj < 2; ++bj) { const f32x4 v0 = acc[ai][bj][m][0] * rs, v1 = acc[ai][bj][m][1] * rs;
                        u32x4 w; w.x = pk2(v0[0], v0[1]); w.y = pk2(v0[2], v0[3]); w.z = pk2(v1[0], v1[1]); w.w = pk2(v1[2], v1[3]);
                        *(u32x4*)(O + (size_t)row * 256 + bj * 128 + wc * 32 + 8 * fq) = w; }
                    asm volatile("" ::: "memory"); }
        } else if (u.pn == 1) {
            const int col = wc * 32 + 8 * fq, i0 = (col & 31) >> 1;
#pragma unroll
            for (int ai = 0; ai < 2; ++ai)
#pragma unroll
                for (int m = 0; m < 4; ++m) { const int row = u.pm * 256 + ai * 128 + wr * 64 + m * 16 + fr; const float rq = rstd_of(ssq, row, 1.0f / 256.0f);
                    const f32x4 ca = *(const f32x4*)(cs + (size_t)row * 16 + i0), cb = *(const f32x4*)(cs + (size_t)row * 16 + i0 + 2);
                    const f32x4 v0 = acc[ai][0][m][0] * rq, v1 = acc[ai][0][m][1] * rq;
                    u32x4 w; w.x = pk2(v0[0] * ca[0] - v0[1] * ca[1], v0[0] * ca[1] + v0[1] * ca[0]); w.y = pk2(v0[2] * ca[2] - v0[3] * ca[3], v0[2] * ca[3] + v0[3] * ca[2]);
                    w.z = pk2(v1[0] * cb[0] - v1[1] * cb[1], v1[0] * cb[1] + v1[1] * cb[0]); w.w = pk2(v1[2] * cb[2] - v1[3] * cb[3], v1[2] * cb[3] + v1[3] * cb[2]);
                    *(u32x4*)(Qr + (size_t)row * 128 + col) = w; asm volatile("" ::: "memory"); }
        } else {
#pragma unroll
            for (int ai = 0; ai < 2; ++ai)
#pragma unroll
                for (int m = 0; m < 4; ++m) { const int row = u.pm * 256 + ai * 128 + wr * 64 + m * 16 + fr; const float rk = rstd_of(sskv, row, 1.0f / 128.0f);
                    const int b = row >> 12, sp = row & 4095;
#pragma unroll
                    for (int bj = 0; bj < 2; ++bj) { const int col = bj * 128 + wc * 32 + 8 * fq; const f32x4 v0 = acc[ai][bj][m][0] * rk, v1 = acc[ai][bj][m][1] * rk;
                        unsigned vo = (unsigned)(((b * 4 + (col >> 6)) * 64 + (col & 63)) * SEQ + sp) * 2u; asm volatile("" : "+v"(vo));
                        char* vb = (char*)Vt + vo;
#pragma unroll
                        for (int i = 0; i < 4; ++i) { *(bf16*)(vb + (size_t)i * SEQ * 2) = (bf16)(pk2(v0[i], 0.f) & 0xffffu); *(bf16*)(vb + (size_t)(4 + i) * SEQ * 2) = (bf16)(pk2(v1[i], 0.f) & 0xffffu); } }
                    asm volatile("" ::: "memory"); }
        }
    }
};
struct EpiBf16Plain {
    static constexpr bool PERM = true;
    bf16* O; int ldc;
    __device__ __forceinline__ void operator()(EPI_ARGS) const {
#pragma unroll
        for (int ai = 0; ai < 2; ++ai)
#pragma unroll
            for (int m = 0; m < 4; ++m) { const int row = u.pm * 256 + ai * 128 + wr * 64 + m * 16 + fr;
#pragma unroll
                for (int bj = 0; bj < 2; ++bj) { const f32x4 v0 = acc[ai][bj][m][0], v1 = acc[ai][bj][m][1];
                    u32x4 w; w.x = pk2(v0[0], v0[1]); w.y = pk2(v0[2], v0[3]); w.z = pk2(v1[0], v1[1]); w.w = pk2(v1[2], v1[3]);
                    *(u32x4*)(O + (size_t)row * ldc + u.pn * 256 + bj * 128 + wc * 32 + 8 * fq) = w; } }
    }
};
__device__ __forceinline__ void residual_rows(EPI_ARGS, bf16* H, int row_tile0) {
#pragma unroll
    for (int ai = 0; ai < 2; ++ai)
#pragma unroll
        for (int m = 0; m < 4; ++m) { const int row = row_tile0 + ai * 128 + wr * 64 + m * 16 + fr;
#pragma unroll
            for (int bj = 0; bj < 2; ++bj) { u32x4* hp = (u32x4*)(H + (size_t)row * DM + u.pn * 256 + bj * 128 + wc * 32 + 8 * fq); const u32x4 hw = *hp;
                const f32x4 v0 = acc[ai][bj][m][0] + (f32x4){bflo(hw.x), bfhi(hw.x), bflo(hw.y), bfhi(hw.y)}, v1 = acc[ai][bj][m][1] + (f32x4){bflo(hw.z), bfhi(hw.z), bflo(hw.w), bfhi(hw.w)};
                u32x4 w; w.x = pk2(v0[0], v0[1]); w.y = pk2(v0[2], v0[3]); w.z = pk2(v1[0], v1[1]); w.w = pk2(v1[2], v1[3]); *hp = w; }
            if (m & 1) asm volatile("" ::: "memory"); }
}
struct EpiResidual {
    static constexpr bool PERM = true;
    bf16* H;
    __device__ __forceinline__ void operator()(EPI_ARGS) const { residual_rows(acc, u, wr, wc, fr, fq, H, u.pm * 256); }
};
struct EpiSwiglu {
    static constexpr bool PERM = true;
    bf16* ACT; int t0;
    __device__ __forceinline__ void operator()(EPI_ARGS) const {
#pragma unroll
        for (int ai = 0; ai < 2; ++ai)
#pragma unroll
            for (int m = 0; m < 4; ++m) { const int row = (u.pm - t0) * 256 + ai * 128 + wr * 64 + m * 16 + fr;
                const f32x4 g0 = acc[ai][0][m][0], g1 = acc[ai][0][m][1], u0 = acc[ai][1][m][0], u1 = acc[ai][1][m][1];
                u32x4 w; w.x = pk2(silu_f(g0[0]) * u0[0], silu_f(g0[1]) * u0[1]); w.y = pk2(silu_f(g0[2]) * u0[2], silu_f(g0[3]) * u0[3]);
                w.z = pk2(silu_f(g1[0]) * u1[0], silu_f(g1[1]) * u1[1]); w.w = pk2(silu_f(g1[2]) * u1[2], silu_f(g1[3]) * u1[3]);
                *(u32x4*)(ACT + (size_t)row * FF + u.pn * 128 + wc * 32 + 8 * fq) = w; }
    }
};
struct EpiDown {
    static constexpr bool PERM = true;
    bf16* O2; MoeMap M; bf16* H;
    __device__ __forceinline__ void operator()(EPI_ARGS) const {
        if (!M.list) { residual_rows(acc, u, wr, wc, fr, fq, H, u.pm * 256); return; }
        const int ne = u.ne;
#pragma unroll
        for (int ai = 0; ai < 2; ++ai)
#pragma unroll
            for (int m = 0; m < 4; ++m) { const int idx = u.aux * 256 + ai * 128 + wr * 64 + m * 16 + fr;
                if (idx < ne) {
                    unsigned ts = (unsigned)idx * 2u; float w8 = 1.0f;
                    if (M.list) { ts = M.list[(size_t)u.e * T + idx]; w8 = M.wl[(size_t)u.e * T + idx]; }
                    bf16* orow = O2 + ((size_t)(ts & 1u) * T + (ts >> 1)) * DM + u.pn * 256 + wc * 32 + 8 * fq;
#pragma unroll
                    for (int bj = 0; bj < 2; ++bj) { const f32x4 v0 = acc[ai][bj][m][0] * w8, v1 = acc[ai][bj][m][1] * w8;
                        u32x4 w; w.x = pk2(v0[0], v0[1]); w.y = pk2(v0[2], v0[3]); w.z = pk2(v1[0], v1[1]); w.w = pk2(v1[2], v1[3]);
                        *(u32x4*)(orow + bj * 128) = w; } } }
    }
};

__device__ __forceinline__ void prep_thin(const Args& a, const Ctx& c0, int l) {
    const Ctx c = fresh(c0);
    const int gw = c.bid * NWAVES + c.wave, NGW = c.G * NWAVES, gtid = c.bid * (NWAVES * 64) + c.tid, NT = c.G * NWAVES * 64, lane = c.lane;
    const bf16* P = (const bf16*)(c.ws + WS_P);
    { const f32x2_t* cs = (const f32x2_t*)(c.ws + WS_CS); unsigned* Kr = (unsigned*)(c.ws + WS_KR);
      for (int idx = gtid; idx < T * 16; idx += NT) { const int tk = idx >> 4, i = idx & 15;
          const unsigned w = *(const unsigned*)(P + (size_t)tk * PP + C_KR + 2 * i); const float x1 = bflo(w), x2 = bfhi(w); const f32x2_t t = cs[idx];
          Kr[idx] = pk2(x1 * t.x - x2 * t.y, x1 * t.y + x2 * t.x); } }
    { LAS bf16* tl = (LAS bf16*)(c.lds + c.wave * 8448);
      for (int it = gw; it < 2 * NB * 64; it += NGW) { const int which = it >> 9, b = (it >> 6) & 7, st = it & 63;
          const bf16* src = P + (size_t)(b * SEQ + st * 64) * PP + (which ? C_NVW : C_NVS);
          bf16* dst = (bf16*)(c.ws + (which ? WS_VTW : WS_VTS)) + (size_t)b * 64 * SEQ + st * 64;
#pragma unroll
          for (int i = 0; i < 8; ++i) { const int tk = i * 8 + (lane >> 3), dc = lane & 7; const u32x4 w = *(const u32x4*)(src + (size_t)tk * PP + 8 * dc);
              LAS unsigned* t4 = (LAS unsigned*)(tl + tk * 66 + 8 * dc); t4[0] = w.x; t4[1] = w.y; t4[2] = w.z; t4[3] = w.w; }
          LDS_WAIT(); asm volatile("" ::: "memory");
#pragma unroll
          for (int tc = 0; tc < 8; ++tc) { unsigned short e[8];
#pragma unroll
              for (int k = 0; k < 8; ++k) e[k] = tl[(8 * tc + k) * 66 + lane];
              u32x4 o; o.x = e[0] | ((unsigned)e[1] << 16); o.y = e[2] | ((unsigned)e[3] << 16); o.z = e[4] | ((unsigned)e[5] << 16); o.w = e[6] | ((unsigned)e[7] << 16);
              *(u32x4*)(dst + (size_t)lane * SEQ + 8 * tc) = o; }
          LDS_WAIT(); asm volatile("" ::: "memory"); } }
    { const float* cw = argp(I_CONV_W) + (size_t)l * 3 * 256; bf16* Y = (bf16*)(c.ws + WS_Y);
      const f32x4 w0 = *(const f32x4*)(cw + 4 * lane), w1 = *(const f32x4*)(cw + 256 + 4 * lane), w2 = *(const f32x4*)(cw + 512 + 4 * lane);
      constexpr int R = 4;
      for (int row0 = gw; row0 < T; row0 += R * NGW) {
          u32x2 cc[R][3], hv[R][3], cb[R];
#pragma unroll
          for (int r = 0; r < R; ++r) { const int row = (row0 + r * NGW) < T ? (row0 + r * NGW) : 0; const int s = row & (SEQ - 1);
#pragma unroll
              for (int k = 0; k < 3; ++k) { const int sp = s - 2 + k; const size_t ro = (size_t)(sp >= 0 ? row - 2 + k : row) * PP;
                  cc[r][k] = *(const u32x2*)(P + ro + C_CC + 4 * lane); hv[r][k] = *(const u32x2*)(P + ro + C_CHV + 4 * lane); }
              cb[r] = *(const u32x2*)(P + (size_t)row * PP + C_CB + 4 * lane); }
#pragma unroll
          for (int r = 0; r < R; ++r) { const int row = row0 + r * NGW; if (row >= T) break; const int s = row & (SEQ - 1);
              f32x4 accv = {0.f, 0.f, 0.f, 0.f};
#pragma unroll
              for (int k = 0; k < 3; ++k) { const f32x4 wk = k == 0 ? w0 : (k == 1 ? w1 : w2); const float on = (s - 2 + k >= 0) ? 1.0f : 0.0f;
                  accv[0] += on * wk[0] * bflo(cc[r][k].x) * bflo(hv[r][k].x); accv[1] += on * wk[1] * bfhi(cc[r][k].x) * bfhi(hv[r][k].x);
                  accv[2] += on * wk[2] * bflo(cc[r][k].y) * bflo(hv[r][k].y); accv[3] += on * wk[3] * bfhi(cc[r][k].y) * bfhi(hv[r][k].y); }
              accv[0] *= bflo(cb[r].x); accv[1] *= bfhi(cb[r].x); accv[2] *= bflo(cb[r].y); accv[3] *= bfhi(cb[r].y);
              const float ss = wave_sum((accv[0] * accv[0] + accv[1] * accv[1]) + (accv[2] * accv[2] + accv[3] * accv[3]));
              const float rstd = 1.0f / sqrtf(ss * (1.0f / 256.0f) + EPS);
              u32x2 o; o.x = pk2(accv[0] * rstd, accv[1] * rstd); o.y = pk2(accv[2] * rstd, accv[3] * rstd);
              *(u32x2*)(Y + (size_t)row * DM + 256 + 4 * lane) = o; } } }
}
__device__ __forceinline__ void mla_groupnorm(const Ctx& c0) {
    const Ctx c = fresh(c0);
    const int gw = c.bid * NWAVES + c.wave, NGW = c.G * NWAVES, lane = c.lane; bf16* Y = (bf16*)(c.ws + WS_Y);
    for (int row = gw; row < T; row += NGW) { u32x2* p = (u32x2*)(Y + (size_t)row * DM + 4 * lane); const u32x2 w = *p;
        const float x0 = bflo(w.x), x1 = bfhi(w.x), x2 = bflo(w.y), x3 = bfhi(w.y);
        const float ss = wave_sum((x0 * x0 + x1 * x1) + (x2 * x2 + x3 * x3)); const float rstd = 1.0f / sqrtf(ss * (1.0f / 256.0f) + EPS);
        u32x2 o; o.x = pk2(x0 * rstd, x1 * rstd); o.y = pk2(x2 * rstd, x3 * rstd); *p = o; }
}

#define MFMA32(a, b, c) __builtin_amdgcn_mfma_f32_32x32x16_bf16((a), (b), (c), 0, 0, 0)
__device__ __forceinline__ int crow(int r, int hi) { return (r & 3) + 8 * (r >> 2) + 4 * hi; }

__device__ __forceinline__ void gmlp_unit(const Args& a, const Ctx& c0, int l, int unit) {
    const Ctx c = fresh(c0);
    const int lane = c.lane, w = c.wave, r32 = lane & 31, hi = lane >> 5; const int tok0 = unit * 128;
    const bf16* P = (const bf16*)(c.ws + WS_P); bf16* Y = (bf16*)(c.ws + WS_Y);
    LAS bf16* vnT = (LAS bf16*)c.lds;
    LAS bf16* ug = (LAS bf16*)(c.lds + 69632);
    LAS float* stg = (LAS float*)c.lds;
    const f32x4 lg = *(const f32x4*)(argp(I_GMLP_LN) + l * 256 + 4 * lane);
    __syncthreads();
    {   u32x2 wv[16], wu[16];
#pragma unroll
        for (int jj = 0; jj < 16; ++jj) { const size_t ro = (size_t)(tok0 + w * 16 + jj) * PP; wv[jj] = *(const u32x2*)(P + ro + C_GV + 4 * lane); wu[jj] = *(const u32x2*)(P + ro + C_GU + 4 * lane); }
#pragma unroll
        for (int jj = 0; jj < 16; ++jj) { const int j = w * 16 + jj;
            float x[4] = {gelu_tanh(bflo(wv[jj].x)), gelu_tanh(bfhi(wv[jj].x)), gelu_tanh(bflo(wv[jj].y)), gelu_tanh(bfhi(wv[jj].y))};
            const float mean = wave_sum((x[0] + x[1]) + (x[2] + x[3])) * (1.0f / 256.0f);
#pragma unroll
            for (int i = 0; i < 4; ++i) x[i] -= mean;
            const float var = wave_sum((x[0] * x[0] + x[1] * x[1]) + (x[2] * x[2] + x[3] * x[3])) * (1.0f / 256.0f); const float rstd = 1.0f / sqrtf(var + EPS);
#pragma unroll
            for (int i = 0; i < 4; ++i) vnT[(4 * lane + i) * 136 + j] = (bf16)(pk2(x[i] * rstd * lg[i], 0.f) & 0xffffu);
            u32x2 gu; gu.x = pk2(gelu_tanh(bflo(wu[jj].x)), gelu_tanh(bfhi(wu[jj].x))); gu.y = pk2(gelu_tanh(bflo(wu[jj].y)), gelu_tanh(bfhi(wu[jj].y)));
            *(LAS u32x2*)(ug + j * 256 + 4 * lane) = gu; } }
    __syncthreads();
    const int g = w >> 1; const bf16* WG = (const bf16*)(c.ws + WS_WGM) + (size_t)g * 128 * 128;
    f32x16 acc[4];
#pragma unroll
    for (int it = 0; it < 4; ++it)
#pragma unroll
        for (int r = 0; r < 16; ++r) acc[it][r] = 0.f;
#pragma unroll
    for (int ks = 0; ks < 8; ++ks) { const bf16x8 bfr = *(const LAS bf16x8*)(vnT + (32 * w + r32) * 136 + 16 * ks + 8 * hi);
#pragma unroll
        for (int it = 0; it < 4; ++it) { const bf16x8 afr = *(const bf16x8*)(WG + (size_t)(32 * it + r32) * 128 + 16 * ks + 8 * hi); acc[it] = MFMA32(afr, bfr, acc[it]); } }
    const float* bs = argp(I_GMLP_BS) + (size_t)l * 4 * 128 + g * 128; const int col = 32 * w + r32;
#pragma unroll
    for (int it = 0; it < 4; ++it)
#pragma unroll
        for (int r = 0; r < 16; ++r) { const int i = 32 * it + crow(r, hi); acc[it][r] = bf2f(ug[i * 256 + col]) * (acc[it][r] + bs[i]); }
    __syncthreads();
#pragma unroll
    for (int it = 0; it < 4; ++it)
#pragma unroll
        for (int r = 0; r < 16; ++r) { const int i = 32 * it + crow(r, hi); stg[i * 260 + col] = acc[it][r]; }
    __syncthreads();
    for (int jj = 0; jj < 16; ++jj) { const int i = w * 16 + jj; const f32x4 v = *(const LAS f32x4*)(stg + i * 260 + 4 * lane);
        const float ss = wave_sum((v[0] * v[0] + v[1] * v[1]) + (v[2] * v[2] + v[3] * v[3])); const float rstd = 1.0f / sqrtf(ss * (1.0f / 256.0f) + EPS);
        u32x2 o; o.x = pk2(v[0] * rstd, v[1] * rstd); o.y = pk2(v[2] * rstd, v[3] * rstd); *(u32x2*)(Y + (size_t)(tok0 + i) * DM + 512 + 4 * lane) = o; }
    __syncthreads();
}

__device__ __forceinline__ void compress_unit(const Ctx& c0, int unit) {
    const Ctx c = fresh(c0);
    const int lane = c.lane, w = c.wave, r32 = lane & 31, hi = lane >> 5; const int b = unit >> 4, kv = (unit >> 3) & 1, grp = unit & 7;
    const int kh = w >> 2, cg = w & 3;
    const bf16* P = (const bf16*)(c.ws + WS_P);
    const bf16* arow = P + (size_t)(b * SEQ + 16 * (32 * grp + r32)) * PP + (kv ? C_NVC : C_NKC) + 8 * hi;
    const bf16* brow = (const bf16*)(c.ws + WS_W1T) + ((size_t)kv * 256 + 64 * cg + r32) * 2048 + 8 * hi;
    f32x16 acc0, acc1;
#pragma unroll
    for (int r = 0; r < 16; ++r) { acc0[r] = 0.f; acc1[r] = 0.f; }
#pragma unroll 4
    for (int k2 = 0; k2 < 64; ++k2) { const int ks = 64 * kh + k2;
        const bf16x8 af = *(const bf16x8*)(arow + (size_t)(ks >> 2) * PP + 16 * (ks & 3));
        const bf16x8 b0 = *(const bf16x8*)(brow + 16 * ks), b1 = *(const bf16x8*)(brow + (size_t)32 * 2048 + 16 * ks);
        acc0 = MFMA32(af, b0, acc0); acc1 = MFMA32(af, b1, acc1); }
    LAS float* red = (LAS float*)c.lds;
    LAS bf16* Hs = (LAS bf16*)(c.lds + 33280);
    __syncthreads();
    if (kh == 1) {
#pragma unroll
        for (int r = 0; r < 16; ++r) { red[crow(r, hi) * 260 + 64 * cg + r32] = acc0[r]; red[crow(r, hi) * 260 + 64 * cg + 32 + r32] = acc1[r]; } }
    __syncthreads();
    if (kh == 0) { const float bp0 = ((const float*)(c.ws + WS_BPE))[kv * 256 + 64 * cg + r32], bp1 = ((const float*)(c.ws + WS_BPE))[kv * 256 + 64 * cg + 32 + r32];
#pragma unroll
        for (int r = 0; r < 16; ++r) { const int i = crow(r, hi);
            Hs[i * 264 + 64 * cg + r32] = (bf16)(pk2(gelu_tanh(acc0[r] + red[i * 260 + 64 * cg + r32] + bp0), 0.f) & 0xffffu);
            Hs[i * 264 + 64 * cg + 32 + r32] = (bf16)(pk2(gelu_tanh(acc1[r] + red[i * 260 + 64 * cg + 32 + r32] + bp1), 0.f) & 0xffffu); } }
    __syncthreads();
    if (w < 2) {
        const bf16* w2 = (const bf16*)(c.ws + WS_W2T) + ((size_t)kv * 64 + 32 * w + r32) * 256 + 8 * hi;
        f32x16 o;
#pragma unroll
        for (int r = 0; r < 16; ++r) o[r] = 0.f;
#pragma unroll
        for (int ks = 0; ks < 16; ++ks) { const bf16x8 af = *(const LAS bf16x8*)(Hs + r32 * 264 + 16 * ks + 8 * hi); const bf16x8 bf_ = *(const bf16x8*)(w2 + 16 * ks); o = MFMA32(af, bf_, o); }
        const int n = 32 * w + r32;
#pragma unroll
        for (int r = 0; r < 16; ++r) { const int ig = 32 * grp + crow(r, hi); const bf16 val = ig < 255 ? (bf16)(pk2(o[r], 0.f) & 0xffffu) : (bf16)0;
            if (kv == 0) ((bf16*)(c.ws + WS_KC))[((size_t)b * 256 + ig) * 64 + n] = val; else ((bf16*)(c.ws + WS_VCT))[((size_t)b * 64 + n) * 256 + ig] = val; }
    }
    __syncthreads();
}

constexpr int NSLOT = 4, SLOT_BYTES = 20480, SL_K = 0, SL_V = 8192, SL_KR = 16384;
constexpr int AT_RING = 0, AT_PSEL = NSLOT * SLOT_BYTES, AT_SELM = AT_PSEL + 64 * 65 * 4, AT_TACC = AT_SELM + 512, AT_END = AT_TACC + 8 * 4096;
static_assert(AT_END <= ARENA_BYTES, "attention LDS");
struct FState { f32x16 o0, o1; float m, l; };
__device__ __forceinline__ void fstate_init(FState& st) {
#pragma unroll
    for (int r = 0; r < 16; ++r) { st.o0[r] = 0.f; st.o1[r] = 0.f; }
    st.m = -1e30f; st.l = 0.f;
}
struct QLds { LAS const unsigned char* ql; __device__ __forceinline__ bf16x8 operator[](int ks) const { return *(const LAS bf16x8*)(ql + ks * 1024); } };
template <int DK, class QF> __device__ __forceinline__ void qk_tile(f32x16& p0, f32x16& p1, const QF& qf, LAS const unsigned char* Sb, int r32, int hi) {
    const f32x16 zero16 = {0.f, 0.f, 0.f, 0.f, 0.f, 0.f, 0.f, 0.f, 0.f, 0.f, 0.f, 0.f, 0.f, 0.f, 0.f, 0.f};
    const int xa = (r32 >> 1) & 7;
#pragma unroll
    for (int ks = 0; ks < 4; ++ks) {
        const int off = r32 * 128 + (((2 * ks + hi) ^ xa) << 4);
        const bf16x8 ka = *(const LAS bf16x8*)(Sb + SL_K + off);
        const bf16x8 kb = *(const LAS bf16x8*)(Sb + SL_K + 4096 + off);
        if (ks == 0) { p0 = MFMA32(ka, qf[0], zero16); p1 = MFMA32(kb, qf[0], zero16); }
        else { p0 = MFMA32(ka, qf[ks], p0); p1 = MFMA32(kb, qf[ks], p1); }
    }
    if (DK == 96) {
        const int xr = (r32 >> 2) & 3;
#pragma unroll
        for (int ks = 0; ks < 2; ++ks) {
            const int off = r32 * 64 + (((2 * ks + hi) ^ xr) << 4);
            const bf16x8 ka = *(const LAS bf16x8*)(Sb + SL_KR + off);
            const bf16x8 kb = *(const LAS bf16x8*)(Sb + SL_KR + 2048 + off);
            p0 = MFMA32(ka, qf[4 + ks], p0); p1 = MFMA32(kb, qf[4 + ks], p1); } }
}
template <class QF> __device__ __forceinline__ void qk_step(f32x16& p0, f32x16& p1, const QF& qf, LAS const unsigned char* Sb, int r32, int hi, int ks) {
    const f32x16 zero16 = {0.f, 0.f, 0.f, 0.f, 0.f, 0.f, 0.f, 0.f, 0.f, 0.f, 0.f, 0.f, 0.f, 0.f, 0.f, 0.f};
    bf16x8 ka, kb;
    if (ks < 4) { const int off = r32 * 128 + (((2 * ks + hi) ^ ((r32 >> 1) & 7)) << 4); ka = *(const LAS bf16x8*)(Sb + SL_K + off); kb = *(const LAS bf16x8*)(Sb + SL_K + 4096 + off); }
    else { const int off = r32 * 64 + (((2 * (ks - 4) + hi) ^ ((r32 >> 2) & 3)) << 4); ka = *(const LAS bf16x8*)(Sb + SL_KR + off); kb = *(const LAS bf16x8*)(Sb + SL_KR + 2048 + off); }
    const bf16x8 q = qf[ks];
    if (ks == 0) { p0 = MFMA32(ka, q, zero16); p1 = MFMA32(kb, q, zero16); } else { p0 = MFMA32(ka, q, p0); p1 = MFMA32(kb, q, p1); }
}
__device__ __forceinline__ void pv_step(f32x16& o0, f32x16& o1, const f32x16& p0, const f32x16& p1, LAS const unsigned char* Sb, int r32, int hi, int s) {
    const int xv = (r32 >> 1) & 7, b = 8 * (s & 1);
    u32x4 pw;
    if (s < 2) { pw.x = pk2(p0[b], p0[b + 1]); pw.y = pk2(p0[b + 2], p0[b + 3]); pw.z = pk2(p0[b + 4], p0[b + 5]); pw.w = pk2(p0[b + 6], p0[b + 7]); }
    else       { pw.x = pk2(p1[b], p1[b + 1]); pw.y = pk2(p1[b + 2], p1[b + 3]); pw.z = pk2(p1[b + 4], p1[b + 5]); pw.w = pk2(p1[b + 6], p1[b + 7]); }
    const bf16x8 pf = __builtin_bit_cast(bf16x8, pw);
#pragma unroll
    for (int db = 0; db < 2; ++db) {
        LAS const unsigned char* vrow = Sb + SL_V + (32 * db + r32) * 128 + 8 * hi;
        const u32x2 lo = *(const LAS u32x2*)(vrow + (((2 * s) ^ xv) << 4)), hh = *(const LAS u32x2*)(vrow + (((2 * s + 1) ^ xv) << 4));
        const u32x4 vv = {lo.x, lo.y, hh.x, hh.y}; const bf16x8 vf = __builtin_bit_cast(bf16x8, vv);
        if (db == 0) o0 = MFMA32(vf, pf, o0); else o1 = MFMA32(vf, pf, o1); }
}
__device__ __forceinline__ void pv_tile(f32x16& o0, f32x16& o1, const f32x16& p0, const f32x16& p1, LAS const unsigned char* Sb, int r32, int hi) {
    const int xv = (r32 >> 1) & 7;
#pragma unroll
    for (int s = 0; s < 4; ++s) {
        const int b = 8 * (s & 1);
        u32x4 pw;
        if (s < 2) { pw.x = pk2(p0[b], p0[b + 1]); pw.y = pk2(p0[b + 2], p0[b + 3]); pw.z = pk2(p0[b + 4], p0[b + 5]); pw.w = pk2(p0[b + 6], p0[b + 7]); }
        else       { pw.x = pk2(p1[b], p1[b + 1]); pw.y = pk2(p1[b + 2], p1[b + 3]); pw.z = pk2(p1[b + 4], p1[b + 5]); pw.w = pk2(p1[b + 6], p1[b + 7]); }
        const bf16x8 pf = __builtin_bit_cast(bf16x8, pw);
#pragma unroll
        for (int db = 0; db < 2; ++db) {
            LAS const unsigned char* vrow = Sb + SL_V + (32 * db + r32) * 128 + 8 * hi;
            const u32x2 lo = *(const LAS u32x2*)(vrow + (((2 * s) ^ xv) << 4)), hh = *(const LAS u32x2*)(vrow + (((2 * s + 1) ^ xv) << 4));
            const u32x4 vv = {lo.x, lo.y, hh.x, hh.y}; const bf16x8 vf = __builtin_bit_cast(bf16x8, vv);
            if (db == 0) o0 = MFMA32(vf, pf, o0); else o1 = MFMA32(vf, pf, o1); }
    }
}
template <bool MASKED> __device__ __forceinline__ void softmax_step(FState& st, f32x16& p0, f32x16& p1, bool lane_on = true) {
    float mx = fmaxf(p0[0], p1[0]);
#pragma unroll
    for (int r = 1; r < 16; ++r) mx = fmaxf(mx, fmaxf(p0[r], p1[r]));
    mx = fmaxf(mx, __shfl_xor(mx, 32));
    if (!MASKED) mx = lane_on ? mx : -1e30f;
    if (__any(mx > st.m)) {
        const float mnew = fmaxf(st.m, mx), alpha = __builtin_amdgcn_exp2f(st.m - mnew); st.m = mnew;
        st.l *= alpha;
#pragma unroll
        for (int r = 0; r < 16; ++r) { st.o0[r] *= alpha; st.o1[r] *= alpha; }
    }
    float rs = 0.f;
    if (MASKED) {
        const float m = st.m;
#pragma unroll
        for (int r = 0; r < 16; ++r) { p0[r] = p0[r] > -1e29f ? __builtin_amdgcn_exp2f(p0[r] - m) : 0.f; p1[r] = p1[r] > -1e29f ? __builtin_amdgcn_exp2f(p1[r] - m) : 0.f; rs += p0[r] + p1[r]; }
    } else {
        const float m = lane_on ? st.m : 1e30f;
#pragma unroll
        for (int r = 0; r < 16; ++r) { p0[r] = __builtin_amdgcn_exp2f(p0[r] - m); p1[r] = __builtin_amdgcn_exp2f(p1[r] - m); rs += p0[r] + p1[r]; }
    }
    st.l += rs;
}
__device__ __forceinline__ float max_xor32(float v) { const auto rr = __builtin_amdgcn_permlane32_swap(__float_as_uint(v), __float_as_uint(v), false, false); return fmaxf(__uint_as_float(rr[0]), __uint_as_float(rr[1])); }
#define SMX_I(P0, P1, AL, MEFF, ON) do { float mx_ = fmaxf(P0[0], P1[0]); \
    _Pragma("unroll") for (int r = 1; r < 16; ++r) mx_ = fmaxf(mx_, fmaxf(P0[r], P1[r])); \
    mx_ = max_xor32(mx_); if (LANEON_) mx_ = (ON) ? mx_ : -1e30f; \
    const float mn_ = fmaxf(st.m, mx_); AL = __builtin_amdgcn_exp2f(st.m - mn_); st.m = mn_; MEFF = LANEON_ ? ((ON) ? mn_ : 1e30f) : mn_; } while (0)
#define SMX_II(P, MEFF, RS) do { _Pragma("unroll") for (int r = 0; r < 16; ++r) { P[r] = __builtin_amdgcn_exp2f(P[r] - MEFF); RS += P[r]; } } while (0)
#define SMX_III(AL, RS) do { st.l = st.l * AL + RS; _Pragma("unroll") for (int r = 0; r < 16; ++r) { st.o0[r] *= AL; st.o1[r] *= AL; } } while (0)
#define SBAR0 __builtin_amdgcn_sched_barrier(0)
#define PAIR_NB(DK, LANEON, ONA, ONB) do { constexpr bool LANEON_ = LANEON; \
    f32x16 a0, a1, b0, b1; float alA, mA, rsA = 0.f, alB, mB, rsB = 0.f; \
    qk_tile<DK>(a0, a1, qf, SbA, r32, hi); SBAR0; \
    qk_step(b0, b1, qf, SbB, r32, hi, 0); qk_step(b0, b1, qf, SbB, r32, hi, 1); SMX_I(a0, a1, alA, mA, (ONA)); SBAR0; \
    qk_step(b0, b1, qf, SbB, r32, hi, 2); qk_step(b0, b1, qf, SbB, r32, hi, 3); SMX_II(a0, mA, rsA); SBAR0; \
    if (DK == 96) { qk_step(b0, b1, qf, SbB, r32, hi, 4); qk_step(b0, b1, qf, SbB, r32, hi, 5); } SMX_II(a1, mA, rsA); SMX_III(alA, rsA); SBAR0; \
    pv_step(st.o0, st.o1, a0, a1, SbA, r32, hi, 0); pv_step(st.o0, st.o1, a0, a1, SbA, r32, hi, 1); SMX_I(b0, b1, alB, mB, (ONB)); SMX_II(b0, mB, rsB); SBAR0; \
    pv_step(st.o0, st.o1, a0, a1, SbA, r32, hi, 2); pv_step(st.o0, st.o1, a0, a1, SbA, r32, hi, 3); SMX_II(b1, mB, rsB); SBAR0; \
    SMX_III(alB, rsB); pv_tile(st.o0, st.o1, b0, b1, SbB, r32, hi); } while (0)
template <int DK> struct DmaLoader {
    const char *k1, *k2, *v; unsigned ks1, ks2, vs;
    unsigned o1, o2, ov;
    unsigned ldsbase, w;
    __device__ __forceinline__ void init(const bf16* k1_, int kp1, const bf16* k2_, int kp2, const bf16* v_, int vp, int lane, int wave, LAS unsigned char* lds) {
        k1 = (const char*)k1_; k2 = (const char*)k2_; v = (const char*)v_; ks1 = 64u * kp1 * 2u; ks2 = 64u * kp2 * 2u; vs = 128u; w = (unsigned)wave;
        ldsbase = (unsigned)(uintptr_t)lds + AT_RING;
        { const int key = 8 * wave + (lane >> 3), cc = (lane & 7) ^ ((key >> 1) & 7); o1 = ((unsigned)key * kp1 + 8u * cc) * 2u; }
        { const int key = 16 * (wave & 3) + (lane >> 2), cc = (lane & 3) ^ ((key >> 2) & 3); o2 = ((unsigned)key * kp2 + 8u * cc) * 2u; }
        { const int d = 8 * wave + (lane >> 3), kc = (lane & 7) ^ ((d >> 1) & 7); ov = ((unsigned)d * vp + 8u * kc) * 2u; }
    }
    __device__ __forceinline__ void issue(int j, int slot) const {
        const unsigned sb = ldsbase + (unsigned)slot * SLOT_BYTES;
        __builtin_amdgcn_global_load_lds((const unsigned*)(k1 + (size_t)j * ks1 + o1), (LAS unsigned*)(uintptr_t)(sb + SL_K + w * 1024u), 16, 0, 0);
        __builtin_amdgcn_global_load_lds((const unsigned*)(v + (size_t)j * vs + ov), (LAS unsigned*)(uintptr_t)(sb + SL_V + w * 1024u), 16, 0, 0);
        if (DK == 96) __builtin_amdgcn_global_load_lds((const unsigned*)(k2 + (size_t)j * ks2 + o2), (LAS unsigned*)(uintptr_t)(sb + SL_KR + (w & 3u) * 1024u), 16, 0, 0);
    }
};
#define ATT_WAITV(n) asm volatile("s_waitcnt vmcnt(" #n ")" ::: "memory")
#define TILE_BEGIN(L, J0, J1, WAITSTMT) { \
    const int _j0 = (J0), _j1 = (J1); \
    __syncthreads(); \
    if (_j0 < _j1) { \
    _Pragma("unroll") for (int _p = 0; _p < 3; ++_p) (L).issue((_j0 + _p) < _j1 ? (_j0 + _p) : (_j1 - 1), _p); \
    for (int j = _j0; j < _j1; ++j) { \
        WAITSTMT; __builtin_amdgcn_s_barrier(); asm volatile("" ::: "memory"); \
        (L).issue((j + 3) < _j1 ? (j + 3) : (_j1 - 1), (j - _j0 + 3) & 3); \
        LAS const unsigned char* Sb = c.lds + AT_RING + ((j - _j0) & 3) * SLOT_BYTES;
#define TILE_END(L) \
    } } \
    ATT_WAITV(0); __builtin_amdgcn_s_barrier(); asm volatile("" ::: "memory"); }

#define TILE2_BEGIN(L, J0, J1) { \
    const int _j0 = (J0), _j1 = (J1), _npair = (_j1 - _j0 + 1) >> 1; \
    __syncthreads(); \
    if (_npair > 0) { \
    (L).issue(_j0, 0); (L).issue((_j0 + 1) < _j1 ? (_j0 + 1) : (_j1 - 1), 1); \
    for (int _i = 0; _i < _npair; ++_i) { \
        const int j = _j0 + 2 * _i; const bool hasB = (j + 1) < _j1; \
        ATT_WAITV(0); __builtin_amdgcn_s_barrier(); asm volatile("" ::: "memory"); \
        { const int _jn = j + 2, _s = ((_i + 1) & 1) * 2; (L).issue(_jn < _j1 ? _jn : (_j1 - 1), _s); (L).issue((_jn + 1) < _j1 ? (_jn + 1) : (_j1 - 1), _s + 1); } \
        LAS const unsigned char* SbA = c.lds + AT_RING + ((_i & 1) * 2) * SLOT_BYTES; LAS const unsigned char* SbB = SbA + SLOT_BYTES;
#define TILE2_END(L) \
    } } \
    ATT_WAITV(0); __builtin_amdgcn_s_barrier(); asm volatile("" ::: "memory"); }

__device__ __forceinline__ void mla_unit(const Ctx& c0, int b, int h, int qb) {
    const Ctx c = fresh(c0);
    const int lane = c.lane, w = c.wave, r32 = lane & 31, hi = lane >> 5;
    const int qpos = 256 * qb + 32 * w + r32; const int row = b * SEQ + qpos;
    const bf16* Qn = (const bf16*)(c.ws + WS_QN); const bf16* Qr = (const bf16*)(c.ws + WS_QR);
    LAS unsigned char* qimg = c.lds + NSLOT * SLOT_BYTES + w * 6144 + lane * 16;
    __syncthreads();
#pragma unroll
    for (int ks = 0; ks < 4; ++ks) *(LAS bf16x8*)(qimg + ks * 1024) = *(const bf16x8*)(Qn + (size_t)row * 256 + h * 64 + 16 * ks + 8 * hi);
#pragma unroll
    for (int ks = 0; ks < 2; ++ks) *(LAS bf16x8*)(qimg + (4 + ks) * 1024) = *(const bf16x8*)(Qr + (size_t)row * 128 + h * 32 + 16 * ks + 8 * hi);
    const QLds qf{qimg};
    DmaLoader<96> L; L.init((const bf16*)(c.ws + WS_KN) + (size_t)b * SEQ * 256 + h * 64, 256, (const bf16*)(c.ws + WS_KR) + (size_t)b * SEQ * 32, 32, (const bf16*)(c.ws + WS_VTM) + (size_t)(b * 4 + h) * 64 * SEQ, SEQ, lane, w, c.lds);
    FState st; fstate_init(st);
    const int wmax = 256 * qb + 32 * w + 31;
#define MLA_SM(P0, P1, JJ) do { if (64 * (JJ) + 63 > 256 * qb + 32 * w) { \
            _Pragma("unroll") for (int r = 0; r < 16; ++r) { const int k0 = 64 * (JJ) + crow(r, hi); if (k0 > qpos) P0[r] = -1e30f; if (k0 + 32 > qpos) P1[r] = -1e30f; } \
            softmax_step<true>(st, P0, P1); } else softmax_step<false>(st, P0, P1); } while (0)
    TILE2_BEGIN(L, 0, 4 * qb)
        PAIR_NB(96, false, true, true);
    TILE2_END(L)
    TILE2_BEGIN(L, 4 * qb, 4 * qb + 4)
        const bool needA = 64 * j <= wmax, needB = hasB && (64 * (j + 1) <= wmax);
        if (needB) {
            f32x16 a0, a1, b0, b1; qk_tile<96>(a0, a1, qf, SbA, r32, hi); __builtin_amdgcn_sched_barrier(0); qk_tile<96>(b0, b1, qf, SbB, r32, hi);
            MLA_SM(a0, a1, j); __builtin_amdgcn_sched_barrier(0); pv_tile(st.o0, st.o1, a0, a1, SbA, r32, hi); __builtin_amdgcn_sched_barrier(0);
            MLA_SM(b0, b1, j + 1); __builtin_amdgcn_sched_barrier(0); pv_tile(st.o0, st.o1, b0, b1, SbB, r32, hi);
        } else if (needA) {
            f32x16 a0, a1; qk_tile<96>(a0, a1, qf, SbA, r32, hi);
            MLA_SM(a0, a1, j); pv_tile(st.o0, st.o1, a0, a1, SbA, r32, hi);
        }
    TILE2_END(L)
#undef MLA_SM
    const float lt = st.l + __shfl_xor(st.l, 32); const float inv = 1.0f / lt;
    int qp2 = qpos; asm volatile("" : "+v"(qp2));
    bf16* Y = (bf16*)(c.ws + WS_Y) + (size_t)(b * SEQ + qp2) * DM + h * 64;
#pragma unroll
    for (int g = 0; g < 4; ++g) {
        u32x2 o; o.x = pk2(st.o0[4 * g] * inv, st.o0[4 * g + 1] * inv); o.y = pk2(st.o0[4 * g + 2] * inv, st.o0[4 * g + 3] * inv); *(u32x2*)(Y + 8 * g + 4 * hi) = o;
        u32x2 o2; o2.x = pk2(st.o1[4 * g] * inv, st.o1[4 * g + 1] * inv); o2.y = pk2(st.o1[4 * g + 2] * inv, st.o1[4 * g + 3] * inv); *(u32x2*)(Y + 32 + 8 * g + 4 * hi) = o2; }
}

__device__ __forceinline__ void nsa_unit(const Ctx& c0, int b, int qt) {
    const Ctx c = fresh(c0);
    const int lane = c.lane, w = c.wave, r32 = lane & 31, hi = lane >> 5;
    const int tl = 8 * w + (r32 & 7), head = r32 >> 3, tok = 64 * qt + tl; const int row = b * SEQ + tok;
    const bf16* P = (const bf16*)(c.ws + WS_P);
    bf16x8 qf[4];
#pragma unroll
    for (int ks = 0; ks < 4; ++ks) qf[ks] = *(const bf16x8*)(P + (size_t)row * PP + C_NQ + head * 64 + 16 * ks + 8 * hi);
#define NSA_GATE(br) ({ int t_ = tok; asm volatile("" : "+v"(t_)); sigmoid_f(bf2f(P[(size_t)(b * SEQ + t_) * PP + C_NG + head * 3 + (br)])); })
    LAS float* psel = (LAS float*)(c.lds + AT_PSEL); LAS unsigned long long* selm = (LAS unsigned long long*)(c.lds + AT_SELM);
    __syncthreads();
    for (int i = c.tid; i < 64 * 65; i += NWAVES * 64) psel[i] = 0.f;
    LAS unsigned* tacc = (LAS unsigned*)(c.lds + AT_TACC) + w * 1024 + lane;
    DmaLoader<64> L; L.init((const bf16*)(c.ws + WS_KC) + (size_t)b * 256 * 64, 64, nullptr, 0, (const bf16*)(c.ws + WS_VCT) + (size_t)b * 64 * 256, 256, lane, w, c.lds);
    const int ntc = (4 * qt + 2) / 64 + 1;
    float cm = -1e30f, cl = 0.f;
    TILE_BEGIN(L, 0, ntc, ATT_WAITV(4))
        f32x16 p0, p1; qk_tile<64>(p0, p1, qf, Sb, r32, hi);
        float mx = -1e30f;
#pragma unroll
        for (int r = 0; r < 16; ++r) { const int c0 = 64 * j + crow(r, hi); if (16 * c0 + 31 > tok) p0[r] = -1e30f; if (16 * (c0 + 32) + 31 > tok) p1[r] = -1e30f; mx = fmaxf(mx, fmaxf(p0[r], p1[r])); }
        mx = fmaxf(mx, __shfl_xor(mx, 32));
        const float mnew = fmaxf(cm, mx); float rs = 0.f;
#pragma unroll
        for (int r = 0; r < 16; ++r) { rs += (p0[r] > -1e29f ? __builtin_amdgcn_exp2f(p0[r] - mnew) : 0.f) + (p1[r] > -1e29f ? __builtin_amdgcn_exp2f(p1[r] - mnew) : 0.f); }
        cl = cl * __builtin_amdgcn_exp2f(cm - mnew) + rs; cm = mnew;
    TILE_END(L)
    cl += __shfl_xor(cl, 32);
    const float cinv = cl > 0.f ? 1.0f / cl : 0.f;
    {
        f32x16 o0, o1;
#pragma unroll
        for (int r = 0; r < 16; ++r) { o0[r] = 0.f; o1[r] = 0.f; }
        TILE_BEGIN(L, 0, ntc, ATT_WAITV(4))
            f32x16 p0, p1; qk_tile<64>(p0, p1, qf, Sb, r32, hi);
#pragma unroll
            for (int r = 0; r < 16; ++r) { const int c0 = 64 * j + crow(r, hi);
                p0[r] = (16 * c0 + 31 <= tok) ? __builtin_amdgcn_exp2f(p0[r] - cm) * cinv : 0.f; p1[r] = (16 * (c0 + 32) + 31 <= tok) ? __builtin_amdgcn_exp2f(p1[r] - cm) * cinv : 0.f; }
#pragma unroll
            for (int half = 0; half < 2; ++half)
#pragma unroll
                for (int g = 0; g < 4; ++g) {
                    float av, bv;
                    if (half == 0) { av = p0[4 * g] + p0[4 * g + 1] + p0[4 * g + 2] + 0.5f * p0[4 * g + 3]; bv = 0.5f * p0[4 * g + 3]; }
                    else           { av = p1[4 * g] + p1[4 * g + 1] + p1[4 * g + 2] + 0.5f * p1[4 * g + 3]; bv = 0.5f * p1[4 * g + 3]; }
                    av += __shfl_xor(av, 8); av += __shfl_xor(av, 16); bv += __shfl_xor(bv, 8); bv += __shfl_xor(bv, 16);
                    if (head == 0) { const int n = 16 * j + 8 * half + 2 * g + hi; (void)__hip_atomic_fetch_add(psel + tl * 65 + n, av, __ATOMIC_RELAXED, __HIP_MEMORY_SCOPE_WORKGROUP); (void)__hip_atomic_fetch_add(psel + tl * 65 + n + 1, bv, __ATOMIC_RELAXED, __HIP_MEMORY_SCOPE_WORKGROUP); }
                }
            pv_tile(o0, o1, p0, p1, Sb, r32, hi);
        TILE_END(L)
        { const float g0 = NSA_GATE(0);
#pragma unroll
        for (int r = 0; r < 16; ++r) tacc[r * 64] = pk2(g0 * o0[r], g0 * o1[r]); }
    }
    __syncthreads();
    for (int tt = 0; tt < 8; ++tt) {
        const int tk = 8 * w + tt; float sc = psel[tk * 65 + lane];
        if (lane > qt) sc = -1.0f; else if (lane == 0 || lane == qt || lane == qt - 1) sc = 1e4f;
        int rank = 0;
        for (int n = 0; n < 64; ++n) { const float so = __builtin_bit_cast(float, __builtin_amdgcn_readlane(__builtin_bit_cast(int, sc), n)); rank += (so > sc || (so == sc && n < lane)) ? 1 : 0; }
        const unsigned long long mk = __ballot(rank < 16);
        if (lane == 0) selm[tk] = mk;
    }
    __syncthreads();
    const unsigned long long smask = selm[tl];
    {
        L.init(P + (size_t)b * SEQ * PP + C_NKS, PP, nullptr, 0, (const bf16*)(c.ws + WS_VTS) + (size_t)b * 64 * SEQ, SEQ, lane, w, c.lds);
        FState st; fstate_init(st);
#define SEL_SM(P0, P1, JJ) do { if ((JJ) == qt) { \
            _Pragma("unroll") for (int r = 0; r < 16; ++r) { const int k0 = 64 * (JJ) + crow(r, hi); if (k0 > tok) P0[r] = -1e30f; if (k0 + 32 > tok) P1[r] = -1e30f; } \
            softmax_step<true>(st, P0, P1);   \
        } else softmax_step<false>(st, P0, P1, (bool)((smask >> (JJ)) & 1ull)); } while (0)
        const int qe = qt & ~1;
        TILE2_BEGIN(L, 0, qe)
            PAIR_NB(64, true, (bool)((smask >> j) & 1ull), (bool)((smask >> (j + 1)) & 1ull));
        TILE2_END(L)
        TILE2_BEGIN(L, qe, qt + 1)
            if (hasB) {
                f32x16 a0, a1, b0, b1; qk_tile<64>(a0, a1, qf, SbA, r32, hi); __builtin_amdgcn_sched_barrier(0); qk_tile<64>(b0, b1, qf, SbB, r32, hi);
                SEL_SM(a0, a1, j); __builtin_amdgcn_sched_barrier(0); pv_tile(st.o0, st.o1, a0, a1, SbA, r32, hi); __builtin_amdgcn_sched_barrier(0);
                SEL_SM(b0, b1, j + 1); __builtin_amdgcn_sched_barrier(0); pv_tile(st.o0, st.o1, b0, b1, SbB, r32, hi);
            } else {
                f32x16 a0, a1; qk_tile<64>(a0, a1, qf, SbA, r32, hi);
                SEL_SM(a0, a1, j); pv_tile(st.o0, st.o1, a0, a1, SbA, r32, hi);
            }
        TILE2_END(L)
#undef SEL_SM
        const float lt = st.l + __shfl_xor(st.l, 32); const float f = lt > 0.f ? NSA_GATE(1) / lt : 0.f;
#pragma unroll
        for (int r = 0; r < 16; ++r) { const unsigned t = tacc[r * 64]; tacc[r * 64] = pk2(bflo(t) + f * st.o0[r], bfhi(t) + f * st.o1[r]); }
    }
    f32x16 t0, t1;
    {
        L.init(P + (size_t)b * SEQ * PP + C_NKW, PP, nullptr, 0, (const bf16*)(c.ws + WS_VTW) + (size_t)b * 64 * SEQ, SEQ, lane, w, c.lds);
        FState st; fstate_init(st);
        TILE_BEGIN(L, (qt >= 8 ? qt - 8 : 0), qt + 1, ATT_WAITV(4))
            f32x16 p0, p1; qk_tile<64>(p0, p1, qf, Sb, r32, hi);
            if (j == qt || j + 8 == qt) {
#pragma unroll
                for (int r = 0; r < 16; ++r) { const int k0 = 64 * j + crow(r, hi); if (k0 > tok || k0 + 512 <= tok) p0[r] = -1e30f; if (k0 + 32 > tok || k0 + 32 + 512 <= tok) p1[r] = -1e30f; }
                softmax_step<true>(st, p0, p1);
            } else softmax_step<false>(st, p0, p1);
            pv_tile(st.o0, st.o1, p0, p1, Sb, r32, hi);
        TILE_END(L)
        const float lt = st.l + __shfl_xor(st.l, 32); const float f = lt > 0.f ? NSA_GATE(2) / lt : 0.f;
#pragma unroll
        for (int r = 0; r < 16; ++r) { const unsigned t = tacc[r * 64]; t0[r] = bflo(t) + f * st.o0[r]; t1[r] = bfhi(t) + f * st.o1[r]; }
    }
    float ss = 0.f;
#pragma unroll
    for (int r = 0; r < 16; ++r) ss += t0[r] * t0[r] + t1[r] * t1[r];
    ss += __shfl_xor(ss, 32); ss += __shfl_xor(ss, 8); ss += __shfl_xor(ss, 16);
    const float rstd = 1.0f / sqrtf(ss * (1.0f / 256.0f) + EPS);
    int tk2 = tok; asm volatile("" : "+v"(tk2));
    bf16* Y = (bf16*)(c.ws + WS_Y) + (size_t)(b * SEQ + tk2) * DM + 768 + head * 64;
#pragma unroll
    for (int g = 0; g < 4; ++g) {
        u32x2 o; o.x = pk2(t0[4 * g] * rstd, t0[4 * g + 1] * rstd); o.y = pk2(t0[4 * g + 2] * rstd, t0[4 * g + 3] * rstd); *(u32x2*)(Y + 8 * g + 4 * hi) = o;
        u32x2 o2; o2.x = pk2(t1[4 * g] * rstd, t1[4 * g + 1] * rstd); o2.y = pk2(t1[4 * g + 2] * rstd, t1[4 * g + 3] * rstd); *(u32x2*)(Y + 32 + 8 * g + 4 * hi) = o2; }
}

#ifndef PHMASK
#define PHMASK 0xFFFF
#endif
#define PHON(k) ((PHMASK >> (k)) & 1)
#ifndef SUBMASK
#define SUBMASK 0xFF
#endif
#define SUBON(k) ((SUBMASK >> (k)) & 1)
#ifndef REPMASK
#define REPMASK 0
#endif
#define NREP(k) (((REPMASK >> (k)) & 1) ? 2 : 1)
constexpr int PH_PER_LAYER = 17, PH_FINAL = DEPTH * PH_PER_LAYER, NPH = PH_FINAL + 1;
__global__ void __launch_bounds__(NWAVES * 64, 2) fwd_kernel(Args a) {
    extern __shared__ __attribute__((aligned(16))) unsigned char lds_raw[];
    Ctx c; c.lds = (LAS unsigned char*)lds_raw; c.ws = (GAS unsigned char*)a.ws; c.tid = threadIdx.x; c.lane = c.tid & 63; c.wave = __builtin_amdgcn_readfirstlane(c.tid >> 6); c.G = gridDim.x; c.bid = blockIdx.x;
    volatile LAS unsigned* MISC = (volatile LAS unsigned*)(c.lds + MISC_OFF);
    if (c.tid < 64) MISC[c.tid] = 0u;
    __syncthreads();
    const int lo = a.ph_lo, hi = a.ph_hi;
    const bool multi = (hi - lo) > 1;
    XcdBarrier bar; bar.bar = (unsigned*)(c.ws + WS_CTL) + CW_BAR; bar.x = 0; bar.st = nullptr;
    if (multi) bar = xcd_barrier_post((unsigned*)(c.ws + WS_CTL) + CW_BAR, MISC + 8);
#define IN(k) (lo <= (k) && (k) < hi)
#define SEAM(k) do { if ((k) + 1 < hi) { xcd_barrier(bar, (unsigned*)(c.ws + WS_CTL) + CW_BAR); if (NREP(15) > 1) xcd_barrier(bar, (unsigned*)(c.ws + WS_CTL) + CW_BAR); } } while (0)
    for (int l = 0; l < DEPTH; ++l) {
        GAS unsigned char* ws = c.ws; asm volatile("" : "+s"(ws));
        const int pb = l * PH_PER_LAYER;
        const bool moe = (l & 1) != 0;
        if (PHON(0) && IN(pb + 0)) {
            for (int rep_ = 0; rep_ < NREP(0); ++rep_) convert_weights(a, c, l);
            const bf16* O2 = (const bf16*)(ws + WS_P);
            { const bool after_moe = l > 0 && ((l - 1) & 1);
              norm_pass<0>(a, c, l == 0 ? argp(I_X) : nullptr, after_moe ? O2 : nullptr, after_moe ? O2 + (size_t)T * DM : nullptr, l == 0 || after_moe, l); }
            if (NREP(10) > 1) { xcd_barrier(bar, (unsigned*)(c.ws + WS_CTL) + CW_BAR); norm_pass<0>(a, c, l == 0 ? argp(I_X) : nullptr, nullptr, nullptr, false, l); }
            SEAM(pb + 0);
        }
        if (PHON(1) && IN(pb + 1)) for (int rep_ = 0; rep_ < NREP(1); ++rep_) {
            SchedPlain S; S.R.init(T / 256, PP / 256, c.G, c.bid); S.lda2_ = DM * 2; S.B = (const char*)(ws + WS_WIN); S.btile = (size_t)256 * DM * 2;
            EpiInProj E{(bf16*)(ws + WS_P), (float*)(ws + WS_SSQ), (float*)(ws + WS_SSKV)};
            pg8::gemm_phase<EpiInProj, SchedPlain>(c.lds, (const char*)(ws + WS_XN), DM, DM, S, E);
            if (rep_ + 1 < NREP(1)) xcd_barrier(bar, (unsigned*)(c.ws + WS_CTL) + CW_BAR); else SEAM(pb + 1);
        }
        if (PHON(2) && IN(pb + 2)) for (int rep_ = 0; rep_ < NREP(2); ++rep_) {
            if (SUBON(0)) for (int r2_ = 0; r2_ < NREP(11); ++r2_) { SchedPlain S; S.R.init(T / 256, 4, c.G, c.bid); S.lda2_ = PP * 2; S.B = (const char*)(ws + WS_WQKV); S.btile = (size_t)256 * 384 * 2;
              EpiQkv E{(const float*)(ws + WS_SSQ), (const float*)(ws + WS_SSKV), (const f32x2_t*)(ws + WS_CS), (bf16*)(ws + WS_QN), (bf16*)(ws + WS_QR), (bf16*)(ws + WS_KN), (bf16*)(ws + WS_VTM)};
              pg8::gemm_phase<EpiQkv, SchedPlain>(c.lds, (const char*)(ws + WS_P), 384, 384, S, E); }
            if (SUBON(1)) for (int r2_ = 0; r2_ < NREP(12); ++r2_) for (int u = c.bid; u < NB * 32; u += c.G) gmlp_unit(a, c, l, u);
            if (SUBON(2)) for (int r2_ = 0; r2_ < NREP(13); ++r2_) for (int u = c.bid; u < 128; u += c.G) compress_unit(c, u);
            __syncthreads();
            if (SUBON(3)) for (int r2_ = 0; r2_ < NREP(14); ++r2_) prep_thin(a, c, l);
            if (rep_ + 1 < NREP(2)) xcd_barrier(bar, (unsigned*)(c.ws + WS_CTL) + CW_BAR); else SEAM(pb + 2);
        }
        if (PHON(3) && IN(pb + 3)) for (int rep_ = 0; rep_ < NREP(3); ++rep_) {
            const int vcu = (c.G % 8 == 0) ? (c.bid % 8) * (c.G / 8) + c.bid / 8 : c.bid;
            if (SUBON(0)) for (int u = vcu; u < 256; u += c.G) for (int rep = 0; rep < 2; ++rep) { const int bh = u >> 3, s = u & 7; mla_unit(c, bh >> 2, bh & 3, rep ? 15 - s : s); }
            if (SUBON(1)) for (int u = vcu; u < 256; u += c.G) for (int rep = 0; rep < 2; ++rep) { const int b = u >> 5, s = u & 31; nsa_unit(c, b, rep ? 63 - s : s); }
            if (rep_ + 1 < NREP(3)) xcd_barrier(bar, (unsigned*)(c.ws + WS_CTL) + CW_BAR); else SEAM(pb + 3);
        }
        if (PHON(4) && IN(pb + 4)) { mla_groupnorm(c); SEAM(pb + 4); }
        if (PHON(5) && IN(pb + 5)) for (int rep_ = 0; rep_ < NREP(5); ++rep_) {
            SchedPlain S; S.R.init(T / 256, 4, c.G, c.bid); S.lda2_ = DM * 2; S.B = (const char*)(ws + WS_WO); S.btile = (size_t)256 * DM * 2;
            EpiResidual E{(bf16*)(ws + WS_H)};
            pg8::gemm_phase<EpiResidual, SchedPlain>(c.lds, (const char*)(ws + WS_Y), DM, DM, S, E);
            if (rep_ + 1 < NREP(5)) xcd_barrier(bar, (unsigned*)(c.ws + WS_CTL) + CW_BAR); else SEAM(pb + 5);
        }
        if (PHON(6) && IN(pb + 6)) {
            norm_pass<1>(a, c, nullptr, nullptr, nullptr, false, l);
            SEAM(pb + 6);
        }
        if (PHON(7) && IN(pb + 7)) {
            const MoeMap M = make_moemap(c, l);
            const int P8 = M.pre8, rem = P8 & 63, NF = P8 >> 6, nsteps = rem > 0 ? 2 * NF + 1 : 2 * NF;
            for (int sidx = 0; sidx < nsteps; ++sidx) {
                int dk = -2, gk = -2; bool mixed = false;
                if (rem > 0) { if (sidx == 0) gk = -1; else if (sidx == 1) { dk = -1; gk = 0; mixed = true; } else if ((sidx & 1) == 0) dk = sidx / 2 - 1; else gk = (sidx - 1) / 2; }
                else { if ((sidx & 1) == 0) gk = sidx / 2; else dk = sidx / 2; }
                if (dk != -2) {
                    const int t0 = dk < 0 ? 0 : rem + 64 * dk, nM = dk < 0 ? rem : 64;
                    SchedDown S; S.R.init(nM, 4, c.G, c.bid); S.M = M; S.t0 = t0; S.B = (const char*)(ws + WS_WD);
                    EpiDown E{(bf16*)(ws + WS_P), M, (bf16*)(ws + WS_H)};
                    pg8::gemm_phase<EpiDown, SchedDown>(c.lds, (const char*)(ws + (dk < 0 ? WS_ACTR : WS_ACT)), FF, FF, S, E);
                }
                if (gk != -2) {
                    const int t0 = gk < 0 ? 0 : rem + 64 * gk, nM = gk < 0 ? rem : 64;
                    SchedGateUp S; S.R.init(nM, 2 * FF / 256, c.G, c.bid); S.M = M; S.t0 = t0; S.B = (const char*)(ws + WS_WGU);
                    S.nd = (mixed && c.G == 256) ? rem * 4 : 0;
                    EpiSwiglu E{(bf16*)(ws + (gk < 0 ? WS_ACTR : WS_ACT)), t0};
                    pg8::gemm_phase<EpiSwiglu, SchedGateUp>(c.lds, (const char*)(ws + WS_XN), DM, DM, S, E);
                }
                xcd_barrier(bar, (unsigned*)(c.ws + WS_CTL) + CW_BAR);
            }
        }
    }
    if (PHON(9) && IN(PH_FINAL)) {
        GAS unsigned char* ws = c.ws;
        const bf16* O2 = (const bf16*)(ws + WS_P);
        norm_pass<2>(a, c, nullptr, O2, O2 + (size_t)T * DM, false, DEPTH - 1);
    }
#undef IN
#undef SEAM
}

#ifndef MK_MULTI_LAUNCH
#define MK_MULTI_LAUNCH 0
#endif
extern "C" void kernel_launch(void* const* d_in, const int* in_sizes, int n_in, void* d_out, int out_size, void* d_ws, size_t ws_size, hipStream_t stream) {
    static int grid = 0;
    if (grid == 0) {
        if (n_in != 29 || out_size != T * DM || ws_size < WS_END) { fprintf(stderr, "kernel_launch: unexpected shapes (n_in %d, out %d, ws %zu < %zu)\n", n_in, out_size, ws_size, (size_t)WS_END); grid = -1; return; }
        int dev = 0, cus = 0, per_cu = 0;
        if (hipGetDevice(&dev) != hipSuccess || hipDeviceGetAttribute(&cus, hipDeviceAttributeMultiprocessorCount, dev) != hipSuccess) { grid = -1; return; }
        if (hipFuncSetAttribute((const void*)fwd_kernel, hipFuncAttributeMaxDynamicSharedMemorySize, LDS_BYTES) != hipSuccess) { fprintf(stderr, "kernel_launch: hipFuncSetAttribute failed\n"); grid = -1; return; }
        if (hipOccupancyMaxActiveBlocksPerMultiprocessor(&per_cu, (const void*)fwd_kernel, NWAVES * 64, LDS_BYTES) != hipSuccess || per_cu < 1) { fprintf(stderr, "kernel_launch: occupancy query says %d\n", per_cu); }
        (void)hipGetLastError();
        grid = cus;
    }
    if (grid < 0) return;
    (void)hipMemsetAsync((char*)d_ws + WS_CTL, 0, CTL_ZERO_BYTES, stream);
    Args a{};
    for (int i = 0; i < 29; ++i) a.in[i] = (const float*)d_in[i];
    a.out = (float*)d_out; a.ws = (unsigned char*)d_ws;
#if MK_MULTI_LAUNCH
    for (int p = 0; p < NPH; ++p) {
        const int l = p / PH_PER_LAYER, q = p % PH_PER_LAYER;
        if (p < PH_FINAL && q >= 7) { const int ch = (q - 7) >> 1; if (ch >= ((l & 1) ? 5 : 2)) continue; }
        a.ph_lo = p; a.ph_hi = p + 1;
        hipLaunchKernelGGL(fwd_kernel, dim3(grid), dim3(NWAVES * 64), LDS_BYTES, stream, a);
    }
#else
    a.ph_lo = 0; a.ph_hi = NPH;
    hipLaunchKernelGGL(fwd_kernel, dim3(grid), dim3(NWAVES * 64), LDS_BYTES, stream, a);
#endif
}
```

```cpp
#include <hip/hip_runtime.h>
#include <cstdio>
#include <cstdint>

#define LAS __attribute__((address_space(3)))
#define GAS __attribute__((address_space(1)))
typedef unsigned short bf16;
typedef short bf16x8 __attribute__((ext_vector_type(8)));
typedef float f32x4 __attribute__((ext_vector_type(4)));
typedef float f32x16 __attribute__((ext_vector_type(16)));
typedef unsigned u32x4 __attribute__((ext_vector_type(4)));
typedef unsigned u32x2 __attribute__((ext_vector_type(2)));
typedef float f32x2_t __attribute__((ext_vector_type(2)));
typedef __bf16 bf16x2_t __attribute__((ext_vector_type(2)));

constexpr int NB = 8, SEQ = 4096, T = NB * SEQ, DM = 1024, DEPTH = 4;
constexpr int DIN = 2348, PP = 2560;
constexpr int FF = 3584, NE = 8;
constexpr float EPS = 1e-6f;
constexpr float LOG2E = 1.4426950408889634f;
constexpr int C_CQ = 0, C_CKV = 256, C_NKC = 384, C_NVC = 448, C_CB = 512, C_CC = 768, C_CHV = 1024, C_GU = 1280, C_GV = 1536,
              C_NQ = 1792, C_NKS = 2048, C_NVS = 2112, C_NKW = 2176, C_NVW = 2240, C_KR = 2304, C_NG = 2336;

constexpr size_t MiB = 1u << 20;
constexpr size_t WS_CTL = 0, CTL_ZERO_BYTES = 1 * MiB;
constexpr size_t WS_CS = 1 * MiB;
constexpr size_t WS_LIST = 5 * MiB;
constexpr size_t WS_WL = 7 * MiB;
constexpr size_t WS_SSQ = 9 * MiB;
constexpr size_t WS_SSKV = WS_SSQ + MiB / 2;
constexpr size_t WS_KC = 10 * MiB;
constexpr size_t WS_VCT = WS_KC + 256 * 1024;
constexpr size_t WS_WQKV = 11 * MiB;
constexpr size_t WS_WGM = WS_WQKV + 768 * 1024;
constexpr size_t WS_W2T = WS_WGM + 128 * 1024;
constexpr size_t WS_BPE = WS_W2T + 64 * 1024;
constexpr size_t WS_W1T = 12 * MiB;
constexpr size_t WS_WIN = 14 * MiB;
constexpr size_t WS_WO = 19 * MiB;
constexpr size_t WS_WGU = 21 * MiB;
constexpr size_t WS_WD = 133 * MiB;
constexpr size_t WS_XN = 189 * MiB;
constexpr size_t WS_P = 253 * MiB;
constexpr size_t WS_QN = 414 * MiB;
constexpr size_t WS_QR = 430 * MiB;
constexpr size_t WS_KN = 438 * MiB;
constexpr size_t WS_KR = 454 * MiB;
constexpr size_t WS_VTM = 456 * MiB;
constexpr size_t WS_VTS = 472 * MiB;
constexpr size_t WS_VTW = 476 * MiB;
constexpr size_t WS_Y = 480 * MiB;
constexpr size_t WS_D1 = 544 * MiB;
constexpr size_t WS_ACT = 608 * MiB;
constexpr size_t WS_H = 720 * MiB;
constexpr size_t WS_ACTR = 784 * MiB;
constexpr size_t WS_END = 800 * MiB;
static_assert(WS_P + (size_t)(T + 64) * PP * 2 <= WS_QN, "P");
static_assert(WS_QN + (size_t)16384 * 3584 * 2 <= WS_ACT, "second ACT buffer overlays [WS_QN, WS_ACT)");
constexpr int CW_BAR = 4096;
constexpr int CW_CNT = 16384;

constexpr int NWAVES = 8;
constexpr int ARENA_BYTES = 143360;
constexpr int MISC_OFF = ARENA_BYTES;
constexpr int LDS_BYTES = 147456;

__device__ __forceinline__ unsigned pk2(float lo, float hi) { f32x2_t v = {lo, hi}; bf16x2_t b = __builtin_convertvector(v, bf16x2_t); return __builtin_bit_cast(unsigned, b); }
__device__ __forceinline__ float bf2f(unsigned short x) { return __uint_as_float(((unsigned)x) << 16); }
__device__ __forceinline__ float bflo(unsigned w) { return __uint_as_float(w << 16); }
__device__ __forceinline__ float bfhi(unsigned w) { return __uint_as_float(w & 0xffff0000u); }
__device__ __forceinline__ float wave_sum(float v) {
#pragma unroll
    for (int o = 1; o < 64; o <<= 1) v += __shfl_xor(v, o);
    return v;
}
__device__ __forceinline__ float gelu_tanh(float x) {
    const float u = 0.7978845608028654f * (x + 0.044715f * x * x * x);
    const float e = __builtin_amdgcn_exp2f(u * (2.0f * LOG2E));
    const float th = 1.0f - 2.0f * __builtin_amdgcn_rcpf(e + 1.0f);
    return 0.5f * x * (1.0f + th);
}
__device__ __forceinline__ float silu_f(float x) { return x * __builtin_amdgcn_rcpf(1.0f + __builtin_amdgcn_exp2f(-x * LOG2E)); }
__device__ __forceinline__ float sigmoid_f(float x) { return __builtin_amdgcn_rcpf(1.0f + __builtin_amdgcn_exp2f(-x * LOG2E)); }
#define LDS_WAIT() asm volatile("s_waitcnt lgkmcnt(0)" ::: "memory")
#define VM_WAIT() asm volatile("s_waitcnt vmcnt(0)" ::: "memory")

namespace pg8 {
constexpr int BM = 256, BK = 64, HALF = 128, HTB = HALF * BK * 2, STAGE_BYTES = 8 * HTB, NXCD = 8, WGM = 8;
__host__ __device__ __forceinline__ int lds_byte(int r, int c) { const int st = (r >> 4) * 2 + (c >> 5), rr = r & 15, cc = c & 31, ob = rr * 64 + cc * 2; return st * 1024 + (ob ^ (((ob >> 9) & 1) << 5)); }
__host__ __device__ __forceinline__ void stage_rc(int b, int& R, int& C) { const int st = b / 1024, sb = b % 1024, swz = sb ^ (((sb >> 9) & 1) << 5); R = (st >> 1) * 16 + swz / 64; C = (st & 1) * 32 + (swz % 64) / 2; }
__host__ __device__ __forceinline__ int perm32(int rho) { const int n = rho >> 4, i = rho & 15; return 8 * (i >> 2) + 4 * n + (i & 3); }

struct Unit { int pm, pn, e, aux, ne; };

struct RectOrder {
    int nM, nN, nwg, G, c;
    __device__ __forceinline__ void init(int nM_, int nN_, int G_, int c_) { nM = nM_; nN = nN_; nwg = nM * nN; G = G_; c = c_; }
    __device__ __forceinline__ bool get(int i, int& pm, int& pn) const { return getL((long)i * G + c, pm, pn); }
    __device__ __forceinline__ bool getL(long L, int& pm, int& pn) const {
        if (L >= nwg) return false;
        int wgid = (int)L; { const int q = nwg / NXCD, r = nwg % NXCD, xcd = wgid % NXCD, off = wgid / NXCD; wgid = (xcd < r ? xcd * (q + 1) : r * (q + 1) + (xcd - r) * q) + off; }
        const int nig = WGM * nN, gid = wgid / nig, fm = gid * WGM, gsz = (nM - fm) < WGM ? (nM - fm) : WGM;
        pm = fm + ((wgid % nig) % gsz); pn = (wgid % nig) / gsz; return true;
    }
};

template <class Epi, class Sched>
__device__ __forceinline__ void gemm_phase(LAS unsigned char* lds, const char* Abase, const int K, const int ldb  , const Sched& S, const Epi& E) {
    int tid = threadIdx.x; asm volatile("" : "+v"(tid));
    const int wid = __builtin_amdgcn_readfirstlane(tid >> 6), lane = tid & 63, wr = wid >> 2, wc = wid & 3, fr = lane & 15, fq = lane >> 4;
    int nt = K / BK; asm volatile("" : "+s"(nt));
    int R0, C0, R1, C1; stage_rc(tid * 16, R0, C0); stage_rc(tid * 16 + 8192, R1, C1);
    unsigned voffB[2];
    { const int Rb0 = Epi::PERM ? ((R0 & ~31) + perm32(R0 & 31)) : R0, Rb1 = Epi::PERM ? ((R1 & ~31) + perm32(R1 & 31)) : R1;
      voffB[0] = (unsigned)(Rb0 * ldb + C0) * 2u; voffB[1] = (unsigned)(Rb1 * ldb + C1) * 2u; }
    const size_t kstep = (size_t)(BK * 2);
    const size_t hstepB = (size_t)HALF * ldb * 2;
    const unsigned ldsw = (unsigned)wid * 1024u;
    const int aoff = lds_byte(wr * 64 + fr, fq * 8), boff = lds_byte(wc * 32 + fr, fq * 8);
#define PG8_SA(b, h) (((b) * 2 + (h)) * HTB)
#define PG8_SB(b, h) ((4 + (b) * 2 + (h)) * HTB)
#define PG8_GL(ubase, voff, dstoff) do { unsigned _o = (voff); asm volatile("" : "+v"(_o)); __builtin_amdgcn_global_load_lds((const unsigned*)((const char*)(ubase) + _o), (LAS unsigned*)(lds + (dstoff)), 16, 0, 0); } while (0)
#define PG8_STAGE_B(bufoff, gbase) do { PG8_GL(gbase, voffB[0], (bufoff) + ldsw); PG8_GL(gbase, voffB[1], (bufoff) + ldsw + 8192); } while (0)
#define PG8_STAGE_A0(bufoff, ub, kb) do { PG8_GL(Abase + ((ub) + (kb)), va00, (bufoff) + ldsw); PG8_GL(Abase + ((ub) + (kb)), va01, (bufoff) + ldsw + 8192); } while (0)
#define PG8_STAGE_A1(bufoff, ub, kb) do { PG8_GL(Abase + ((ub) + (kb) + hstepA), va10, (bufoff) + ldsw); PG8_GL(Abase + ((ub) + (kb) + hstepA), va11, (bufoff) + ldsw + 8192); } while (0)
#define PG8_LDA(dst, b, h) do { _Pragma("unroll") for (int m = 0; m < 4; ++m) _Pragma("unroll") for (int k = 0; k < 2; ++k) dst[m][k] = *(const LAS bf16x8*)(lds + PG8_SA(b, h) + aoff + m * 2048 + k * 1024); } while (0)
#define PG8_LDB(dst, b, h) do { _Pragma("unroll") for (int n = 0; n < 2; ++n) _Pragma("unroll") for (int k = 0; k < 2; ++k) dst[n][k] = *(const LAS bf16x8*)(lds + PG8_SB(b, h) + boff + n * 2048 + k * 1024); } while (0)
#define PG8_MMA(ai, bj, At, Bt) do { __builtin_amdgcn_s_setprio(1); _Pragma("unroll") for (int m = 0; m < 4; ++m) _Pragma("unroll") for (int n = 0; n < 2; ++n) _Pragma("unroll") for (int k = 0; k < 2; ++k) \
        acc[ai][bj][m][n] = __builtin_amdgcn_mfma_f32_16x16x32_bf16(Bt[n][k], At[m][k], acc[ai][bj][m][n], 0, 0, 0); __builtin_amdgcn_s_setprio(0); } while (0)
#define PG8_WAIT_V(n) asm volatile("s_waitcnt vmcnt(" #n ")" ::: "memory")
#define PG8_WAIT_L(n) asm volatile("s_waitcnt lgkmcnt(" #n ")" ::: "memory")
#define PG8_BAR __builtin_amdgcn_s_barrier()
#define PG8_SCHED __builtin_amdgcn_sched_barrier(0)
    Unit cur, nxt; int ui = 0;
    if (!S.next(0, cur)) return;
    f32x4 acc[2][2][4][2];
    float zf = 0.f; asm volatile("" : "+v"(zf));
#pragma unroll
    for (int a = 0; a < 2; ++a)
#pragma unroll
        for (int b = 0; b < 2; ++b)
#pragma unroll
            for (int m = 0; m < 4; ++m)
#pragma unroll
                for (int n = 0; n < 2; ++n) acc[a][b][m][n] = (f32x4){zf, zf, zf, zf};
    bf16x8 At[4][2], B0[2][2], B1[2][2];
    unsigned va00, va01, va10, va11; size_t cAb, hstepA;
    if constexpr (Sched::GATHER) { va00 = S.arow(cur, R0) + C0 * 2; va01 = S.arow(cur, R1) + C1 * 2; va10 = S.arow(cur, HALF + R0) + C0 * 2; va11 = S.arow(cur, HALF + R1) + C1 * 2; cAb = 0; hstepA = 0; }
    else { const unsigned l2 = S.lda2(); va00 = (unsigned)R0 * l2 + C0 * 2; va01 = (unsigned)R1 * l2 + C1 * 2; va10 = va00; va11 = va01; cAb = S.abase(cur); hstepA = (size_t)HALF * l2; }
    const char* cB = S.bbase(cur);
    PG8_STAGE_B(PG8_SB(0, 0), cB); PG8_STAGE_B(PG8_SB(0, 1), cB + hstepB); PG8_STAGE_A0(PG8_SA(0, 0), cAb, 0); PG8_STAGE_A1(PG8_SA(0, 1), cAb, 0);
    if (wr == 1) PG8_BAR;
    PG8_WAIT_V(2); PG8_BAR;
    PG8_STAGE_B(PG8_SB(1, 0), cB + kstep); PG8_STAGE_A0(PG8_SA(1, 0), cAb, kstep); PG8_STAGE_B(PG8_SB(1, 1), cB + hstepB + kstep);
    PG8_WAIT_V(6); PG8_BAR;
    for (;;) {
        const bool has_next = S.next(ui + 1, nxt);
        const char* nB = cB; size_t nAb = cAb;
        if (has_next) { nB = S.bbase(nxt); if constexpr (!Sched::GATHER) nAb = S.abase(nxt); }
        for (int t = 0; t < nt; t += 2) {
            const bool last = (t == nt - 2);
            const size_t k1 = (size_t)(t + 1) * kstep;
            const size_t k2 = last ? 0 : (size_t)(t + 2) * kstep, k3 = k2 + kstep;
            const size_t ab2 = last ? nAb : cAb;
            const char* b2 = last ? nB : cB + k2; const char* b3 = b2 + kstep;
            PG8_LDB(B0, 0, 0); PG8_LDB(B1, 0, 1); PG8_SCHED; PG8_LDA(At, 0, 0); PG8_STAGE_A1(PG8_SA(1, 1), cAb, k1);
            if constexpr (Sched::GATHER) { if (last && has_next) {
                va00 = S.arow(nxt, R0) + C0 * 2; va01 = S.arow(nxt, R1) + C1 * 2; va10 = S.arow(nxt, HALF + R0) + C0 * 2; va11 = S.arow(nxt, HALF + R1) + C1 * 2; } }
            PG8_WAIT_V(8); PG8_WAIT_L(0); PG8_BAR; PG8_MMA(0, 0, At, B0); PG8_MMA(0, 1, At, B1); PG8_BAR; PG8_SCHED;
            PG8_LDA(At, 0, 1); PG8_STAGE_B(PG8_SB(0, 0), b2); PG8_STAGE_B(PG8_SB(0, 1), b2 + hstepB); PG8_STAGE_A0(PG8_SA(0, 0), ab2, k2);
            PG8_WAIT_V(8); PG8_WAIT_L(0); PG8_BAR; PG8_MMA(1, 0, At, B0); PG8_MMA(1, 1, At, B1); PG8_BAR; PG8_SCHED;
            PG8_LDB(B0, 1, 0); PG8_LDB(B1, 1, 1); PG8_SCHED; PG8_LDA(At, 1, 0); PG8_STAGE_A1(PG8_SA(0, 1), ab2, k2);
            PG8_WAIT_V(8); PG8_WAIT_L(0); PG8_BAR; PG8_MMA(0, 0, At, B0); PG8_MMA(0, 1, At, B1); PG8_BAR; PG8_SCHED;
            PG8_LDA(At, 1, 1); PG8_STAGE_B(PG8_SB(1, 0), b3); PG8_STAGE_B(PG8_SB(1, 1), b3 + hstepB); PG8_STAGE_A0(PG8_SA(1, 0), ab2, k3);
            PG8_WAIT_V(8); PG8_WAIT_L(0); PG8_BAR; PG8_MMA(1, 0, At, B0); PG8_MMA(1, 1, At, B1); PG8_BAR; PG8_SCHED;
        }
        if (wr == 0) PG8_BAR;
        E(acc, cur, wr, wc, fr, fq);
        if (!has_next) break;
        zf = 0.f; asm volatile("" : "+v"(zf));
#pragma unroll
        for (int a = 0; a < 2; ++a)
#pragma unroll
            for (int b = 0; b < 2; ++b)
#pragma unroll
                for (int m = 0; m < 4; ++m)
#pragma unroll
                    for (int n = 0; n < 2; ++n) acc[a][b][m][n] = (f32x4){zf, zf, zf, zf};
        cur = nxt; cB = nB; cAb = nAb; ++ui;
        if (wr == 1) PG8_BAR;
    }
    PG8_WAIT_V(0);
    PG8_BAR;
#undef PG8_SA
#undef PG8_SB
#undef PG8_GL
#undef PG8_STAGE_A0
#undef PG8_STAGE_A1
#undef PG8_STAGE_B
#undef PG8_LDA
#undef PG8_LDB
#undef PG8_MMA
#undef PG8_WAIT_V
#undef PG8_WAIT_L
#undef PG8_BAR
#undef PG8_SCHED
}
}

#define XB_TMO      128
#define XB_XCNT(j)  (256  + 64 * (j))
#define XB_XSUB(j)  (1280 + 64 * (j))
#define XB_XGEN(j)  (2304 + 64 * (j))
#define XB_TOP      3328
#define XB_TOPGEN   3392
#define XCD_BAR_WORDS 3456
#define XB_SPIN_CAP (1u << 18)
__device__ __forceinline__ unsigned xb_ld(unsigned* p)              { return __hip_atomic_load(p, __ATOMIC_RELAXED, __HIP_MEMORY_SCOPE_AGENT); }
__device__ __forceinline__ unsigned xb_add(unsigned* p, unsigned v) { return __hip_atomic_fetch_add(p, v, __ATOMIC_RELAXED, __HIP_MEMORY_SCOPE_AGENT); }
__device__ __forceinline__ unsigned xb_xcc_id() { return (unsigned)__builtin_amdgcn_s_getreg((3 << 11) | 20) & 0xFu; }
#define XB_SPIN(cond, bar) do { unsigned _sp = 0; while (cond) { __builtin_amdgcn_s_sleep(1); \
    if ((++_sp & 255u) == 0u) { if (xb_ld(&(bar)[XB_TMO])) break; if (_sp > XB_SPIN_CAP) { atomicAdd(&(bar)[XB_TMO], 1u); break; } } } } while (0)
struct XcdBarrier { unsigned* bar; unsigned x; volatile LAS unsigned* st; };
__device__ __forceinline__ XcdBarrier xcd_barrier_post(unsigned* bar, volatile LAS unsigned* st) {
    XcdBarrier b; b.bar = bar; b.x = xb_xcc_id(); b.st = st;
    if (threadIdx.x == 0) (void)xb_add(&bar[XB_XCNT(b.x)], 1u);
    return b;
}
__device__ __forceinline__ void xcd_barrier_complete(unsigned* bar, unsigned x, unsigned& nloc, unsigned& nx) {
    const unsigned G = gridDim.x * gridDim.y * gridDim.z;
    unsigned sum, cnt, mine, sp = 0u;
    for (;;) {
        sum = 0u; cnt = 0u; mine = 0u;
#pragma unroll
        for (unsigned j = 0; j < 16; ++j) { const unsigned c = xb_ld(&bar[XB_XCNT(j)]); sum += c; cnt += (c > 0u) ? 1u : 0u; mine = (j == x) ? c : mine; }
        if (sum == G) break;
        __builtin_amdgcn_s_sleep(1);
        if ((++sp & 255u) == 0u) { if (xb_ld(&bar[XB_TMO])) break; if (sp > XB_SPIN_CAP) { atomicAdd(&bar[XB_TMO], 1u); break; } }
    }
    nloc = mine > 0u ? mine : 1u; nx = cnt > 0u ? cnt : 1u;
}
__device__ __forceinline__ void xcd_barrier(const XcdBarrier& b, unsigned* bar) {
    asm volatile("s_waitcnt vmcnt(0)" ::: "memory");
    __syncthreads();
    if (threadIdx.x == 0) {
        __builtin_amdgcn_s_waitcnt(0);
        unsigned nloc = b.st[0], nx = b.st[1];
        if (nloc == 0u) { xcd_barrier_complete(bar, b.x, nloc, nx); b.st[0] = nloc; b.st[1] = nx; }
        const unsigned old = xb_add(&bar[XB_XSUB(b.x)], 1u);
        const unsigned gen = old / nloc;
        if (old + 1u == (gen + 1u) * nloc) {
            __builtin_amdgcn_fence(__ATOMIC_RELEASE, "agent");
            asm volatile("s_waitcnt vmcnt(0)" ::: "memory");
            const unsigned og = xb_add(&bar[XB_TOP], 1u);
            const unsigned tg = og / nx;
            if (og + 1u == (tg + 1u) * nx) xb_add(&bar[XB_TOPGEN], 1u);
            else XB_SPIN(xb_ld(&bar[XB_TOPGEN]) == tg, bar);
            __builtin_amdgcn_fence(__ATOMIC_ACQUIRE, "agent");
            xb_add(&bar[XB_XGEN(b.x)], 1u);
            asm volatile("s_waitcnt vmcnt(0)" ::: "memory");
        } else {
            XB_SPIN(xb_ld(&bar[XB_XGEN(b.x)]) == gen, bar);
            __builtin_amdgcn_fence(__ATOMIC_ACQUIRE, "agent");
            asm volatile("s_waitcnt vmcnt(0)" ::: "memory");
        }
    }
    __syncthreads();
}

struct Args { const float* in[29]; float* out; unsigned char* ws; int ph_lo, ph_hi; };
static_assert(sizeof(Args) == 29 * 8 + 8 + 8 + 8, "Args has no padding");
enum { I_X = 0, I_POS, I_ATTN_NORM, I_W_IN, I_Q_NORM, I_W_UQ, I_KV_NORM, I_W_UKV, I_CONV_W, I_GMLP_LN, I_GMLP_WS, I_GMLP_BS,
       I_PE_K, I_W1_K, I_W2_K, I_PE_V, I_W1_V, I_W2_V, I_GROUP_NORM, I_W_O, I_FFN_NORM, I_DW_GATE, I_DW_UP, I_DW_DOWN,
       I_ROUTER, I_MW_GATE, I_MW_UP, I_MW_DOWN, I_FINAL_NORM };

typedef GAS const float* __attribute__((address_space(4))) const volatile* kargtab_t;
__device__ __forceinline__ const float* argp(int i) { kargtab_t p = (kargtab_t)__builtin_amdgcn_kernarg_segment_ptr(); GAS const float* g = p[i]; return (const float*)g; }

struct Ctx {
    LAS unsigned char* lds;
    GAS unsigned char* ws;
    int tid, lane, wave, G, bid;
};
__device__ __forceinline__ Ctx fresh(const Ctx& c0) { Ctx c = c0; asm volatile("" : "+v"(c.tid)); asm volatile("" : "+s"(c.ws)); asm volatile("" : "+s"(c.lds)); c.lane = c.tid & 63; return c; }

enum { K_WIN = 0, K_UQ, K_UKV, K_ID, K_GATE, K_UP };
__device__ __forceinline__ int map_col(int kind, int j, float& scale) {
    scale = 1.0f;
    switch (kind) {
    case K_WIN:
        if (j < 384) return j;
        if (j < 416) { const int i = j - 384; return C_KR + (i < 16 ? 2 * i : 2 * (i - 16) + 1); }
        if (j < 672) return C_CB + (j - 416);
        if (j < 928) return C_CC + (j - 672);
        if (j < 1184) return C_CHV + (j - 928);
        if (j < 1440) return C_GU + (j - 1184);
        if (j < 1696) return C_GV + (j - 1440);
        if (j < 1952) { scale = 0.125f * LOG2E; return C_NQ + (j - 1696); }
        if (j < 2016) return C_NKC + (j - 1952);
        if (j < 2080) return C_NVC + (j - 2016);
        if (j < 2144) return C_NKS + (j - 2080);
        if (j < 2208) return C_NVS + (j - 2144);
        if (j < 2272) return C_NKW + (j - 2208);
        if (j < 2336) return C_NVW + (j - 2272);
        return C_NG + (j - 2336);
    case K_UQ: {
        const int h = j / 96, x = j % 96; scale = 0.10206207261596575f * LOG2E;
        if (x < 64) return h * 64 + x;
        const int i = x - 64; return 256 + h * 32 + (i < 16 ? 2 * i : 2 * (i - 16) + 1); }
    case K_UKV: {
        const int h = j >> 7, x = j & 127;
        return x < 64 ? 512 + h * 64 + x : 768 + h * 64 + (x - 64); }
    case K_GATE: return (j >> 7) * 256 + (j & 127);
    case K_UP:   return (j >> 7) * 256 + 128 + (j & 127);
    default: return j;
    }
}
__device__ __forceinline__ void conv_item(const float* src, int src_ld, int nsrc, const float* gain, bf16* dst, int dst_ld, int kdst0, int kind, int nblk, int item, LAS float* scr, int lane) {
    const int kb = item / nblk, nb = item % nblk, k0 = 64 * kb, j0 = 64 * nb;
    const int jr = j0 + 4 * (lane & 15), kr = lane >> 4;
    const int jc = jr < nsrc ? jr : nsrc - 4;
    f32x4 v[16];
#pragma unroll
    for (int i = 0; i < 16; ++i) v[i] = *(const f32x4*)(src + (size_t)(k0 + 4 * i + kr) * src_ld + jc);
    float gv[16];
    if (gain) {
#pragma unroll
        for (int i = 0; i < 16; ++i) gv[i] = gain[k0 + 4 * i + kr];
    } else {
#pragma unroll
        for (int i = 0; i < 16; ++i) gv[i] = 1.0f;
    }
#pragma unroll
    for (int i = 0; i < 16; ++i) { const int kk = 4 * i + kr; const float g = gv[i]; LAS float* p = scr + kk * 65 + 4 * (lane & 15);
        p[0] = v[i][0] * g; p[1] = v[i][1] * g; p[2] = v[i][2] * g; p[3] = v[i][3] * g; }
    LDS_WAIT(); asm volatile("" ::: "memory");
    const int c = lane & 7;
#pragma unroll
    for (int jj = 0; jj < 8; ++jj) { const int n = (lane >> 3) + 8 * jj; const int j = j0 + n;
        if (j < nsrc) { float sc; const int drow = map_col(kind, j, sc); const LAS float* s = scr + (8 * c) * 65 + n;
            u32x4 o; o.x = pk2(s[0 * 65] * sc, s[1 * 65] * sc); o.y = pk2(s[2 * 65] * sc, s[3 * 65] * sc); o.z = pk2(s[4 * 65] * sc, s[5 * 65] * sc); o.w = pk2(s[6 * 65] * sc, s[7 * 65] * sc);
            *(u32x4*)(dst + (size_t)drow * dst_ld + kdst0 + k0 + 8 * c) = o; } }
    LDS_WAIT(); asm volatile("" ::: "memory");
}

__device__ __forceinline__ void zero_rect(bf16* dst, int ld, int r0, int r1, int c0, int c1, int gtid, int nthr) {
    const int nch = (c1 - c0) >> 3, total = (r1 - r0) * nch;
    for (int idx = gtid; idx < total; idx += nthr) { const int r = idx / nch, c = idx % nch; unsigned z = 0u; asm volatile("" : "+v"(z)); *(u32x4*)(dst + (size_t)(r0 + r) * ld + c0 + 8 * c) = (u32x4){z, z, z, z}; }
}

__device__ __forceinline__ void convert_weights(const Args& a, const Ctx& c0, int l) {
    const Ctx c = fresh(c0);
    LAS float* scr = (LAS float*)(c.lds + c.wave * 16640);
    const int gw = c.bid * NWAVES + c.wave, NGW = c.G * NWAVES, gtid = c.bid * (NWAVES * 64) + c.tid, NT = c.G * NWAVES * 64;
    GAS unsigned char* ws = c.ws;
    const int nexp = (l & 1) ? NE : 1;
    constexpr int I_WIN = 37 * 16, I_UQ = 6 * 4, I_UKV = 8 * 2, I_WOI = 16 * 16, I_W1 = 4 * 32, I_W2 = 1 * 4, I_GU = 56 * 16, I_DN = 16 * 56;
    const int n_fixed = I_WIN + I_UQ + I_UKV + I_WOI + 2 * I_W1 + 2 * I_W2;
    const int n_total = n_fixed + nexp * (2 * I_GU + I_DN);
    const float* wg_src = (l & 1) ? argp(I_MW_GATE) + (size_t)(l >> 1) * NE * DM * FF : argp(I_DW_GATE) + (size_t)(l >> 1) * DM * FF;
    const float* wu_src = (l & 1) ? argp(I_MW_UP) + (size_t)(l >> 1) * NE * DM * FF : argp(I_DW_UP) + (size_t)(l >> 1) * DM * FF;
    const float* wd_src = (l & 1) ? argp(I_MW_DOWN) + (size_t)(l >> 1) * NE * DM * FF : argp(I_DW_DOWN) + (size_t)(l >> 1) * DM * FF;
    for (int it = gw; it < n_total; it += NGW) {
        int r = it;
        if (r < I_WIN) { conv_item(argp(I_W_IN) + (size_t)l * DM * DIN, DIN, DIN, argp(I_ATTN_NORM) + l * DM, (bf16*)(ws + WS_WIN), DM, 0, K_WIN, 37, r, scr, c.lane); continue; } r -= I_WIN;
        if (r < I_UQ) { conv_item(argp(I_W_UQ) + (size_t)l * 256 * 384, 384, 384, argp(I_Q_NORM) + l * 256, (bf16*)(ws + WS_WQKV), 384, 0, K_UQ, 6, r, scr, c.lane); continue; } r -= I_UQ;
        if (r < I_UKV) { conv_item(argp(I_W_UKV) + (size_t)l * 128 * 512, 512, 512, argp(I_KV_NORM) + l * 128, (bf16*)(ws + WS_WQKV), 384, 256, K_UKV, 8, r, scr, c.lane); continue; } r -= I_UKV;
        if (r < I_WOI) { conv_item(argp(I_W_O) + (size_t)l * DM * DM, DM, DM, argp(I_GROUP_NORM) + l * DM, (bf16*)(ws + WS_WO), DM, 0, K_ID, 16, r, scr, c.lane); continue; } r -= I_WOI;
        if (r < I_W1) { conv_item(argp(I_W1_K) + (size_t)l * 2048 * 256, 256, 256, nullptr, (bf16*)(ws + WS_W1T), 2048, 0, K_ID, 4, r, scr, c.lane); continue; } r -= I_W1;
        if (r < I_W1) { conv_item(argp(I_W1_V) + (size_t)l * 2048 * 256, 256, 256, nullptr, (bf16*)(ws + WS_W1T) + 256 * 2048, 2048, 0, K_ID, 4, r, scr, c.lane); continue; } r -= I_W1;
        if (r < I_W2) { conv_item(argp(I_W2_K) + (size_t)l * 256 * 64, 64, 64, nullptr, (bf16*)(ws + WS_W2T), 256, 0, K_ID, 1, r, scr, c.lane); continue; } r -= I_W2;
        if (r < I_W2) { conv_item(argp(I_W2_V) + (size_t)l * 256 * 64, 64, 64, nullptr, (bf16*)(ws + WS_W2T) + 64 * 256, 256, 0, K_ID, 1, r, scr, c.lane); continue; } r -= I_W2;
        const int e = r / (2 * I_GU + I_DN); r -= e * (2 * I_GU + I_DN);
        if (r < I_GU) { conv_item(wg_src + (size_t)e * DM * FF, FF, FF, argp(I_FFN_NORM) + l * DM, (bf16*)(ws + WS_WGU) + (size_t)e * 2 * FF * DM, DM, 0, K_GATE, 56, r, scr, c.lane); continue; } r -= I_GU;
        if (r < I_GU) { conv_item(wu_src + (size_t)e * DM * FF, FF, FF, argp(I_FFN_NORM) + l * DM, (bf16*)(ws + WS_WGU) + (size_t)e * 2 * FF * DM, DM, 0, K_UP, 56, r, scr, c.lane); continue; } r -= I_GU;
        conv_item(wd_src + (size_t)e * FF * DM, DM, DM, nullptr, (bf16*)(ws + WS_WD) + (size_t)e * DM * FF, FF, 0, K_ID, 16, r, scr, c.lane);
    }
    zero_rect((bf16*)(ws + WS_WIN), DM, DIN, PP, 0, DM, gtid, NT);
    zero_rect((bf16*)(ws + WS_WQKV), 384, 0, 384, 256, 384, gtid, NT);
    zero_rect((bf16*)(ws + WS_WQKV), 384, 384, 512, 0, 384, gtid, NT);
    zero_rect((bf16*)(ws + WS_WQKV), 384, 512, 1024, 0, 256, gtid, NT);
    { const float* wsrc = argp(I_GMLP_WS) + (size_t)l * 4 * 128 * 128; unsigned* d = (unsigned*)(ws + WS_WGM);
      for (int idx = gtid; idx < 4 * 128 * 64; idx += NT) { const int j = (idx & 63) * 2, i = (idx >> 6) & 127;
          const float v0 = (j <= i) ? wsrc[2 * idx] : 0.f, v1 = (j + 1 <= i) ? wsrc[2 * idx + 1] : 0.f; d[idx] = pk2(v0, v1); } }
    for (int o = gw; o < 512; o += NGW) { const int kv = o >> 8, cc = o & 255; const float* pe = argp(kv ? I_PE_V : I_PE_K) + (size_t)l * 2048; const float* w1 = argp(kv ? I_W1_V : I_W1_K) + (size_t)l * 2048 * 256;
        float sacc = 0.f;
#pragma unroll 8
        for (int i = 0; i < 32; ++i) { const int k = i * 64 + c.lane; sacc += pe[k] * w1[(size_t)k * 256 + cc]; }
        sacc = wave_sum(sacc); if (c.lane == 0) ((float*)(ws + WS_BPE))[o] = sacc; }
    if (l == 0) { const int* pos = (const int*)argp(I_POS); f32x2_t* cs = (f32x2_t*)(ws + WS_CS);
        for (int idx = gtid; idx < T * 16; idx += NT) { const int tk = idx >> 4, i = idx & 15;
            const float inv = __builtin_amdgcn_exp2f(-(float)i * (13.287712379549449f / 16.0f));
            const float ang = (float)pos[tk] * inv; float rev = ang * 0.15915494309189535f; rev -= floorf(rev);
            cs[idx] = (f32x2_t){__builtin_amdgcn_cosf(rev), __builtin_amdgcn_sinf(rev)}; } }
}

template <int MODE>
__device__ __forceinline__ void norm_pass(const Args& a, const Ctx& c0, const float* hsrc, const bf16* add0, const bf16* add1, bool write_h, int l) {
    const Ctx c = fresh(c0);
    const int gw = c.bid * NWAVES + c.wave, NGW = c.G * NWAVES, lane = c.lane;
    float* hout = a.out; bf16* XN = (bf16*)(c.ws + WS_XN); bf16* Hb = (bf16*)(c.ws + WS_H);
    constexpr int R = 4;
    for (int row0 = gw; row0 < T; row0 += R * NGW) {
        f32x4 v[R][4]; u32x2 a0[R][4], a1[R][4];
#pragma unroll
        for (int r = 0; r < R; ++r) { const int row = row0 + r * NGW; const size_t ro = (size_t)(row < T ? row : 0) * DM;
#pragma unroll
            for (int j = 0; j < 4; ++j) { a0[r][j] = (u32x2){0u, 0u}; a1[r][j] = (u32x2){0u, 0u}; } }
        if (hsrc) {
#pragma unroll
            for (int r = 0; r < R; ++r) { const int row = row0 + r * NGW; const size_t ro = (size_t)(row < T ? row : 0) * DM;
#pragma unroll
                for (int j = 0; j < 4; ++j) v[r][j] = *(const f32x4*)(hsrc + ro + 4 * lane + 256 * j); }
        } else {
#pragma unroll
            for (int r = 0; r < R; ++r) { const int row = row0 + r * NGW; const size_t ro = (size_t)(row < T ? row : 0) * DM;
#pragma unroll
                for (int j = 0; j < 4; ++j) { const u32x2 hw = *(const u32x2*)(Hb + ro + 4 * lane + 256 * j); v[r][j] = (f32x4){bflo(hw.x), bfhi(hw.x), bflo(hw.y), bfhi(hw.y)}; } }
        }
        if (add0) {
#pragma unroll
            for (int r = 0; r < R; ++r) { const int row = row0 + r * NGW; const size_t ro = (size_t)(row < T ? row : 0) * DM;
#pragma unroll
                for (int j = 0; j < 4; ++j) a0[r][j] = *(const u32x2*)(add0 + ro + 4 * lane + 256 * j); } }
        if (add1) {
#pragma unroll
            for (int r = 0; r < R; ++r) { const int row = row0 + r * NGW; const size_t ro = (size_t)(row < T ? row : 0) * DM;
#pragma unroll
                for (int j = 0; j < 4; ++j) a1[r][j] = *(const u32x2*)(add1 + ro + 4 * lane + 256 * j); } }
#pragma unroll
        for (int r = 0; r < R; ++r) { const int row = row0 + r * NGW; if (row >= T) break; const size_t ro = (size_t)row * DM;
            float ss = 0.f;
#pragma unroll
            for (int j = 0; j < 4; ++j) { f32x4& x = v[r][j];
                x[0] += bflo(a0[r][j].x) + bflo(a1[r][j].x); x[1] += bfhi(a0[r][j].x) + bfhi(a1[r][j].x); x[2] += bflo(a0[r][j].y) + bflo(a1[r][j].y); x[3] += bfhi(a0[r][j].y) + bfhi(a1[r][j].y);
                ss += (x[0] * x[0] + x[1] * x[1]) + (x[2] * x[2] + x[3] * x[3]); }
            const float rstd = 1.0f / sqrtf(wave_sum(ss) * (1.0f / DM) + EPS);
            if (MODE == 2) {
                const float* g = argp(I_FINAL_NORM);
#pragma unroll
                for (int j = 0; j < 4; ++j) { const f32x4 gv = *(const f32x4*)(g + 4 * lane + 256 * j); *(f32x4*)(hout + ro + 4 * lane + 256 * j) = v[r][j] * rstd * gv; }
            } else {
                if (write_h) {
#pragma unroll
                    for (int j = 0; j < 4; ++j) { u32x2 hw; hw.x = pk2(v[r][j][0], v[r][j][1]); hw.y = pk2(v[r][j][2], v[r][j][3]); *(u32x2*)(Hb + ro + 4 * lane + 256 * j) = hw; }
                }
#pragma unroll
                for (int j = 0; j < 4; ++j) { u32x2 w; w.x = pk2(v[r][j][0] * rstd, v[r][j][1] * rstd); w.y = pk2(v[r][j][2] * rstd, v[r][j][3] * rstd); *(u32x2*)(XN + ro + 4 * lane + 256 * j) = w; }
                if (MODE == 1 && (l & 1)) {
                    const float* g = argp(I_FFN_NORM) + l * DM; const float* wr = argp(I_ROUTER) + (size_t)(l >> 1) * DM * NE;
                    float lg[8];
#pragma unroll
                    for (int e = 0; e < 8; ++e) lg[e] = 0.f;
#pragma unroll
                    for (int j = 0; j < 4; ++j) { const f32x4 gv = *(const f32x4*)(g + 4 * lane + 256 * j);
#pragma unroll
                        for (int i = 0; i < 4; ++i) { const float hn = v[r][j][i] * rstd * gv[i]; const int k = 4 * lane + 256 * j + i;
                            const f32x4 w0 = *(const f32x4*)(wr + (size_t)k * 8), w1 = *(const f32x4*)(wr + (size_t)k * 8 + 4);
                            lg[0] += hn * w0.x; lg[1] += hn * w0.y; lg[2] += hn * w0.z; lg[3] += hn * w0.w; lg[4] += hn * w1.x; lg[5] += hn * w1.y; lg[6] += hn * w1.z; lg[7] += hn * w1.w; } }
#pragma unroll
                    for (int e = 0; e < 8; ++e) lg[e] = wave_sum(lg[e]);
                    int i0 = 0; float l0 = lg[0];
#pragma unroll
                    for (int e = 1; e < 8; ++e) if (lg[e] > l0) { l0 = lg[e]; i0 = e; }
                    int i1 = -1; float l1 = -3.0e38f;
#pragma unroll
                    for (int e = 0; e < 8; ++e) if (e != i0 && lg[e] > l1) { l1 = lg[e]; i1 = e; }
                    const float w0 = 1.0f / (1.0f + __expf(l1 - l0)), w1 = 1.0f - w0;
                    if (lane == 0) {
                        unsigned* cnt = (unsigned*)(c.ws + WS_CTL) + CW_CNT + (l >> 1) * 8 * 64;
                        unsigned* list = (unsigned*)(c.ws + WS_LIST) + (size_t)(l >> 1) * NE * T; float* wl = (float*)(c.ws + WS_WL) + (size_t)(l >> 1) * NE * T;
                        const unsigned p0 = __hip_atomic_fetch_add(cnt + 64 * i0, 1u, __ATOMIC_RELAXED, __HIP_MEMORY_SCOPE_AGENT);
                        list[(size_t)i0 * T + p0] = (unsigned)row * 2u; wl[(size_t)i0 * T + p0] = w0;
                        const unsigned p1 = __hip_atomic_fetch_add(cnt + 64 * i1, 1u, __ATOMIC_RELAXED, __HIP_MEMORY_SCOPE_AGENT);
                        list[(size_t)i1 * T + p1] = (unsigned)row * 2u + 1u; wl[(size_t)i1 * T + p1] = w1;
                    }
                }
            }
        }
    }
}

typedef pg8::Unit Unit;
struct SchedPlain {
    pg8::RectOrder R; unsigned lda2_; const char* B; size_t btile;
    __device__ __forceinline__ bool next(int i, Unit& u) const { u.e = 0; u.aux = 0; u.ne = 0; return R.get(i, u.pm, u.pn); }
    static constexpr bool GATHER = false;
    __device__ __forceinline__ size_t abase(const Unit& u) const { return (size_t)u.pm * 256 * lda2_; }
    __device__ __forceinline__ unsigned lda2() const { return lda2_; }
    __device__ __forceinline__ const char* bbase(const Unit& u) const { return B + (size_t)u.pn * btile; }
};
struct MoeMap {
    int pre1, pre2, pre3, pre4, pre5, pre6, pre7, pre8;
    int c0, c1, c2, c3, c4, c5, c6, c7;
    const unsigned* list; const float* wl;
    __device__ __forceinline__ void locate(int pm, int& e, int& lt, int& ne) const {
        e = 0; lt = pm; ne = c0;
        if (pm >= pre1) { e = 1; lt = pm - pre1; ne = c1; } if (pm >= pre2) { e = 2; lt = pm - pre2; ne = c2; } if (pm >= pre3) { e = 3; lt = pm - pre3; ne = c3; }
        if (pm >= pre4) { e = 4; lt = pm - pre4; ne = c4; } if (pm >= pre5) { e = 5; lt = pm - pre5; ne = c5; } if (pm >= pre6) { e = 6; lt = pm - pre6; ne = c6; }
        if (pm >= pre7) { e = 7; lt = pm - pre7; ne = c7; }
    }
};
__device__ __forceinline__ MoeMap make_moemap(const Ctx& c, int l) {
    MoeMap m;
    if (l & 1) {
        unsigned* cnt = (unsigned*)(c.ws + WS_CTL) + CW_CNT + (l >> 1) * 8 * 64;
        int n[8];
#pragma unroll
        for (int e = 0; e < 8; ++e) n[e] = __builtin_amdgcn_readfirstlane((int)__hip_atomic_load(cnt + 64 * e, __ATOMIC_RELAXED, __HIP_MEMORY_SCOPE_AGENT));
        m.c0 = n[0]; m.c1 = n[1]; m.c2 = n[2]; m.c3 = n[3]; m.c4 = n[4]; m.c5 = n[5]; m.c6 = n[6]; m.c7 = n[7];
        m.pre1 = (n[0] + 255) >> 8; m.pre2 = m.pre1 + ((n[1] + 255) >> 8); m.pre3 = m.pre2 + ((n[2] + 255) >> 8); m.pre4 = m.pre3 + ((n[3] + 255) >> 8);
        m.pre5 = m.pre4 + ((n[4] + 255) >> 8); m.pre6 = m.pre5 + ((n[5] + 255) >> 8); m.pre7 = m.pre6 + ((n[6] + 255) >> 8); m.pre8 = m.pre7 + ((n[7] + 255) >> 8);
        m.list = (const unsigned*)(c.ws + WS_LIST) + (size_t)(l >> 1) * NE * T; m.wl = (const float*)(c.ws + WS_WL) + (size_t)(l >> 1) * NE * T;
    } else {
        m.c0 = T; m.c1 = m.c2 = m.c3 = m.c4 = m.c5 = m.c6 = m.c7 = 0;
        m.pre1 = m.pre2 = m.pre3 = m.pre4 = m.pre5 = m.pre6 = m.pre7 = m.pre8 = T / 256;
        m.list = nullptr; m.wl = nullptr;
    }
    return m;
}
struct SchedGateUp {
    static constexpr bool GATHER = true;
    pg8::RectOrder R; MoeMap M; int t0; const char* B;
    int nd;
    __device__ __forceinline__ bool next(int i, Unit& u) const {
        long L;
        if (nd == 0) L = (long)i * R.G + R.c;
        else if (R.c < nd) { if (i >= 4) return false; L = (long)(i + 3) * R.G + R.c; }
        else { if (i < 7) L = (long)i * R.G + R.c; else if (i == 7) { const int o = R.c - nd; if (o >= 3 * nd) return false; L = (long)(o / nd) * R.G + (o % nd); } else return false; }
        int pm, pn; if (!R.getL(L, pm, pn)) return false; u.pm = t0 + pm; u.pn = pn; M.locate(u.pm, u.e, u.aux, u.ne); return true; }
    __device__ __forceinline__ unsigned arow(const Unit& u, int r) const {
        const int ne = u.ne; int idx = u.aux * 256 + r; idx = idx < ne ? idx : ne - 1;
        const unsigned tok = M.list ? (M.list[(size_t)u.e * T + idx] >> 1) : (unsigned)idx;
        return tok * (unsigned)(DM * 2); }
    __device__ __forceinline__ const char* bbase(const Unit& u) const { return B + ((size_t)u.e * 2 * FF + (size_t)u.pn * 256) * DM * 2; }
};
struct SchedDown {
    pg8::RectOrder R; MoeMap M; int t0; const char* B;
    __device__ __forceinline__ bool next(int i, Unit& u) const { int pm, pn; if (!R.get(i, pm, pn)) return false; u.pm = t0 + pm; u.pn = pn; M.locate(u.pm, u.e, u.aux, u.ne); return true; }
    static constexpr bool GATHER = false;
    __device__ __forceinline__ size_t abase(const Unit& u) const { return (size_t)(u.pm - t0) * 256 * (FF * 2); }
    __device__ __forceinline__ unsigned lda2() const { return (unsigned)(FF * 2); }
    __device__ __forceinline__ const char* bbase(const Unit& u) const { return B + ((size_t)u.e * DM + (size_t)u.pn * 256) * FF * 2; }
};

#define EPI_ARGS const f32x4 (&acc)[2][2][4][2], const Unit& u, int wr, int wc, int fr, int fq
struct EpiInProj {
    static constexpr bool PERM = true;
    bf16* P; float* ssq; float* sskv;
    __device__ __forceinline__ void operator()(EPI_ARGS) const {
#pragma unroll
        for (int ai = 0; ai < 2; ++ai)
#pragma unroll
            for (int m = 0; m < 4; ++m) {
                const int row = u.pm * 256 + ai * 128 + wr * 64 + m * 16 + fr;
                float s0 = 0.f, s1 = 0.f;
#pragma unroll
                for (int bj = 0; bj < 2; ++bj) { const f32x4 v0 = acc[ai][bj][m][0], v1 = acc[ai][bj][m][1];
                    u32x4 w; w.x = pk2(v0[0], v0[1]); w.y = pk2(v0[2], v0[3]); w.z = pk2(v1[0], v1[1]); w.w = pk2(v1[2], v1[3]);
                    *(u32x4*)(P + (size_t)row * PP + u.pn * 256 + bj * 128 + wc * 32 + 8 * fq) = w;
                    const float s = (v0[0] * v0[0] + v0[1] * v0[1]) + (v0[2] * v0[2] + v0[3] * v0[3]) + (v1[0] * v1[0] + v1[1] * v1[1]) + (v1[2] * v1[2] + v1[3] * v1[3]);
                    if (bj == 0) s0 = s; else s1 = s; }
                if (u.pn == 0) { float s = s0 + s1; s += __shfl_xor(s, 16); s += __shfl_xor(s, 32); if (fq == 0) ssq[row * 4 + wc] = s; }
                else if (u.pn == 1) { float s = s0; s += __shfl_xor(s, 16); s += __shfl_xor(s, 32); if (fq == 0) sskv[row * 4 + wc] = s; }
            }
    }
};
struct EpiQkv {
    static constexpr bool PERM = true;
    const float* ssq; const float* sskv; const f32x2_t* cs; bf16 *Qn, *Qr, *Kn, *Vt;
    __device__ __forceinline__ float rstd_of(const float* ss, int row, float invn) const { const f32x4 p = *(const f32x4*)(ss + row * 4); return 1.0f / sqrtf(((p.x + p.y) + (p.z + p.w)) * invn + EPS); }
    __device__ __forceinline__ void operator()(EPI_ARGS) const {
        if (u.pn == 0 || u.pn == 2) {
            bf16* O = u.pn == 0 ? Qn : Kn; const float* ss = u.pn == 0 ? ssq : sskv; const float invn = u.pn == 0 ? (1.0f / 256.0f) : (1.0f / 128.0f);
#pragma unroll
            for (int ai = 0; ai < 2; ++ai)
#pragma unroll
                for (int m = 0; m < 4; ++m) { const int row = u.pm * 256 + ai * 128 + wr * 64 + m * 16 + fr; const float rs = rstd_of(ss, row, invn);
#pragma unroll
                    for (int bj = 0; bj < 2; ++bj) { const f32x4 v0 = acc[ai][bj][m][0] * rs, v1 = acc[ai][bj][m][1] * rs;
                        u32x4 w; w.x = pk2(v0[0], v0[1]); w.y = pk2(v0[2], v0[3]); w.z = pk2(v1[0], v1[1]); w.w = pk2(v1[2], v1[3]);
                        *(u32x4*)(O + (size_t)row * 256 + bj * 128 + wc * 32 + 8 * fq) = w; }
                    asm volatile("" ::: "memory"); }
        } else if (u.pn == 1) {
            const int col = wc * 32 + 8 * fq, i0 = (col & 31) >> 1;
#pragma unroll
            for (int ai = 0; ai < 2; ++ai)
#pragma unroll
                for (int m = 0; m < 4; ++m) { const int row = u.pm * 256 + ai * 128 + wr * 64 + m * 16 + fr; const float rq = rstd_of(ssq, row, 1.0f / 256.0f);
                    const f32x4 ca = *(const f32x4*)(cs + (size_t)row * 16 + i0), cb = *(const f32x4*)(cs + (size_t)row * 16 + i0 + 2);
                    const f32x4 v0 = acc[ai][0][m][0] * rq, v1 = acc[ai][0][m][1] * rq;
                    u32x4 w; w.x = pk2(v0[0] * ca[0] - v0[1] * ca[1], v0[0] * ca[1] + v0[1] * ca[0]); w.y = pk2(v0[2] * ca[2] - v0[3] * ca[3], v0[2] * ca[3] + v0[3] * ca[2]);
                    w.z = pk2(v1[0] * cb[0] - v1[1] * cb[1], v1[0] * cb[1] + v1[1] * cb[0]); w.w = pk2(v1[2] * cb[2] - v1[3] * cb[3], v1[2] * cb[3] + v1[3] * cb[2]);
                    *(u32x4*)(Qr + (size_t)row * 128 + col) = w; asm volatile("" ::: "memory"); }
        } else {
#pragma unroll
            for (int ai = 0; ai < 2; ++ai)
#pragma unroll
                for (int m = 0; m < 4; ++m) { const int row = u.pm * 256 + ai * 128 + wr * 64 + m * 16 + fr; const float rk = rstd_of(sskv, row, 1.0f / 128.0f);
                    const int b = row >> 12, sp = row & 4095;
#pragma unroll
                    for (int bj = 0; bj < 2; ++bj) { const int col = bj * 128 + wc * 32 + 8 * fq; const f32x4 v0 = acc[ai][bj][m][0] * rk, v1 = acc[ai][bj][m][1] * rk;
                        unsigned vo = (unsigned)(((b * 4 + (col >> 6)) * 64 + (col & 63)) * SEQ + sp) * 2u; asm volatile("" : "+v"(vo));
                        char* vb = (char*)Vt + vo;
#pragma unroll
                        for (int i = 0; i < 4; ++i) { *(bf16*)(vb + (size_t)i * SEQ * 2) = (bf16)(pk2(v0[i], 0.f) & 0xffffu); *(bf16*)(vb + (size_t)(4 + i) * SEQ * 2) = (bf16)(pk2(v1[i], 0.f) & 0xffffu); } }
                    asm volatile("" ::: "memory"); }
        }
    }
};
struct EpiBf16Plain {
    static constexpr bool PERM = true;
    bf16* O; int ldc;
    __device__ __forceinline__ void operator()(EPI_ARGS) const {
#pragma unroll
        for (int ai = 0; ai < 2; ++ai)
#pragma unroll
            for (int m = 0; m < 4; ++m) { const int row = u.pm * 256 + ai * 128 + wr * 64 + m * 16 + fr;
#pragma unroll
                for (int bj = 0; bj < 2; ++bj) { const f32x4 v0 = acc[ai][bj][m][0], v1 = acc[ai][bj][m][1];
                    u32x4 w; w.x = pk2(v0[0], v0[1]); w.y = pk2(v0[2], v0[3]); w.z = pk2(v1[0], v1[1]); w.w = pk2(v1[2], v1[3]);
                    *(u32x4*)(O + (size_t)row * ldc + u.pn * 256 + bj * 128 + wc * 32 + 8 * fq) = w; } }
    }
};
__device__ __forceinline__ void residual_rows(EPI_ARGS, bf16* H, int row_tile0) {
#pragma unroll
    for (int ai = 0; ai < 2; ++ai)
#pragma unroll
        for (int m = 0; m < 4; ++m) { const int row = row_tile0 + ai * 128 + wr * 64 + m * 16 + fr;
#pragma unroll
            for (int bj = 0; bj < 2; ++bj) { u32x4* hp = (u32x4*)(H + (size_t)row * DM + u.pn * 256 + bj * 128 + wc * 32 + 8 * fq); const u32x4 hw = *hp;
                const f32x4 v0 = acc[ai][bj][m][0] + (f32x4){bflo(hw.x), bfhi(hw.x), bflo(hw.y), bfhi(hw.y)}, v1 = acc[ai][bj][m][1] + (f32x4){bflo(hw.z), bfhi(hw.z), bflo(hw.w), bfhi(hw.w)};
                u32x4 w; w.x = pk2(v0[0], v0[1]); w.y = pk2(v0[2], v0[3]); w.z = pk2(v1[0], v1[1]); w.w = pk2(v1[2], v1[3]); *hp = w; }
            if (m & 1) asm volatile("" ::: "memory"); }
}
struct EpiResidual {
    static constexpr bool PERM = true;
    bf16* H;
    __device__ __forceinline__ void operator()(EPI_ARGS) const { residual_rows(acc, u, wr, wc, fr, fq, H, u.pm * 256); }
};
struct EpiSwiglu {
    static constexpr bool PERM = true;
    bf16* ACT; int t0;
    __device__ __forceinline__ void operator()(EPI_ARGS) const {
#pragma unroll
        for (int ai = 0; ai < 2; ++ai)
#pragma unroll
            for (int m = 0; m < 4; ++m) { const int row = (u.pm - t0) * 256 + ai * 128 + wr * 64 + m * 16 + fr;
                const f32x4 g0 = acc[ai][0][m][0], g1 = acc[ai][0][m][1], u0 = acc[ai][1][m][0], u1 = acc[ai][1][m][1];
                u32x4 w; w.x = pk2(silu_f(g0[0]) * u0[0], silu_f(g0[1]) * u0[1]); w.y = pk2(silu_f(g0[2]) * u0[2], silu_f(g0[3]) * u0[3]);
                w.z = pk2(silu_f(g1[0]) * u1[0], silu_f(g1[1]) * u1[1]); w.w = pk2(silu_f(g1[2]) * u1[2], silu_f(g1[3]) * u1[3]);
                *(u32x4*)(ACT + (size_t)row * FF + u.pn * 128 + wc * 32 + 8 * fq) = w; }
    }
};
struct EpiDown {
    static constexpr bool PERM = true;
    bf16* O2; MoeMap M; bf16* H;
    __device__ __forceinline__ void operator()(EPI_ARGS) const {
        if (!M.list) { residual_rows(acc, u, wr, wc, fr, fq, H, u.pm * 256); return; }
        const int ne = u.ne;
#pragma unroll
        for (int ai = 0; ai < 2; ++ai)
#pragma unroll
            for (int m = 0; m < 4; ++m) { const int idx = u.aux * 256 + ai * 128 + wr * 64 + m * 16 + fr;
                if (idx < ne) {
                    unsigned ts = (unsigned)idx * 2u; float w8 = 1.0f;
                    if (M.list) { ts = M.list[(size_t)u.e * T + idx]; w8 = M.wl[(size_t)u.e * T + idx]; }
                    bf16* orow = O2 + ((size_t)(ts & 1u) * T + (ts >> 1)) * DM + u.pn * 256 + wc * 32 + 8 * fq;
#pragma unroll
                    for (int bj = 0; bj < 2; ++bj) { const f32x4 v0 = acc[ai][bj][m][0] * w8, v1 = acc[ai][bj][m][1] * w8;
                        u32x4 w; w.x = pk2(v0[0], v0[1]); w.y = pk2(v0[2], v0[3]); w.z = pk2(v1[0], v1[1]); w.w = pk2(v1[2], v1[3]);
                        *(u32x4*)(orow + bj * 128) = w; } } }
    }
};

__device__ __forceinline__ void prep_thin(const Args& a, const Ctx& c0, int l) {
    const Ctx c = fresh(c0);
    const int gw = c.bid * NWAVES + c.wave, NGW = c.G * NWAVES, gtid = c.bid * (NWAVES * 64) + c.tid, NT = c.G * NWAVES * 64, lane = c.lane;
    const bf16* P = (const bf16*)(c.ws + WS_P);
    { const f32x2_t* cs = (const f32x2_t*)(c.ws + WS_CS); unsigned* Kr = (unsigned*)(c.ws + WS_KR);
      for (int idx = gtid; idx < T * 16; idx += NT) { const int tk = idx >> 4, i = idx & 15;
          const unsigned w = *(const unsigned*)(P + (size_t)tk * PP + C_KR + 2 * i); const float x1 = bflo(w), x2 = bfhi(w); const f32x2_t t = cs[idx];
          Kr[idx] = pk2(x1 * t.x - x2 * t.y, x1 * t.y + x2 * t.x); } }
    { LAS bf16* tl = (LAS bf16*)(c.lds + c.wave * 8448);
      for (int it = gw; it < 2 * NB * 64; it += NGW) { const int which = it >> 9, b = (it >> 6) & 7, st = it & 63;
          const bf16* src = P + (size_t)(b * SEQ + st * 64) * PP + (which ? C_NVW : C_NVS);
          bf16* dst = (bf16*)(c.ws + (which ? WS_VTW : WS_VTS)) + (size_t)b * 64 * SEQ + st * 64;
#pragma unroll
          for (int i = 0; i < 8; ++i) { const int tk = i * 8 + (lane >> 3), dc = lane & 7; const u32x4 w = *(const u32x4*)(src + (size_t)tk * PP + 8 * dc);
              LAS unsigned* t4 = (LAS unsigned*)(tl + tk * 66 + 8 * dc); t4[0] = w.x; t4[1] = w.y; t4[2] = w.z; t4[3] = w.w; }
          LDS_WAIT(); asm volatile("" ::: "memory");
#pragma unroll
          for (int tc = 0; tc < 8; ++tc) { unsigned short e[8];
#pragma unroll
              for (int k = 0; k < 8; ++k) e[k] = tl[(8 * tc + k) * 66 + lane];
              u32x4 o; o.x = e[0] | ((unsigned)e[1] << 16); o.y = e[2] | ((unsigned)e[3] << 16); o.z = e[4] | ((unsigned)e[5] << 16); o.w = e[6] | ((unsigned)e[7] << 16);
              *(u32x4*)(dst + (size_t)lane * SEQ + 8 * tc) = o; }
          LDS_WAIT(); asm volatile("" ::: "memory"); } }
    { const float* cw = argp(I_CONV_W) + (size_t)l * 3 * 256; bf16* Y = (bf16*)(c.ws + WS_Y);
      const f32x4 w0 = *(const f32x4*)(cw + 4 * lane), w1 = *(const f32x4*)(cw + 256 + 4 * lane), w2 = *(const f32x4*)(cw + 512 + 4 * lane);
      constexpr int R = 4;
      for (int row0 = gw; row0 < T; row0 += R * NGW) {
          u32x2 cc[R][3], hv[R][3], cb[R];
#pragma unroll
          for (int r = 0; r < R; ++r) { const int row = (row0 + r * NGW) < T ? (row0 + r * NGW) : 0; const int s = row & (SEQ - 1);
#pragma unroll
              for (int k = 0; k < 3; ++k) { const int sp = s - 2 + k; const size_t ro = (size_t)(sp >= 0 ? row - 2 + k : row) * PP;
                  cc[r][k] = *(const u32x2*)(P + ro + C_CC + 4 * lane); hv[r][k] = *(const u32x2*)(P + ro + C_CHV + 4 * lane); }
              cb[r] = *(const u32x2*)(P + (size_t)row * PP + C_CB + 4 * lane); }
#pragma unroll
          for (int r = 0; r < R; ++r) { const int row = row0 + r * NGW; if (row >= T) break; const int s = row & (SEQ - 1);
              f32x4 accv = {0.f, 0.f, 0.f, 0.f};
#pragma unroll
              for (int k = 0; k < 3; ++k) { const f32x4 wk = k == 0 ? w0 : (k == 1 ? w1 : w2); const float on = (s - 2 + k >= 0) ? 1.0f : 0.0f;
                  accv[0] += on * wk[0] * bflo(cc[r][k].x) * bflo(hv[r][k].x); accv[1] += on * wk[1] * bfhi(cc[r][k].x) * bfhi(hv[r][k].x);
                  accv[2] += on * wk[2] * bflo(cc[r][k].y) * bflo(hv[r][k].y); accv[3] += on * wk[3] * bfhi(cc[r][k].y) * bfhi(hv[r][k].y); }
              accv[0] *= bflo(cb[r].x); accv[1] *= bfhi(cb[r].x); accv[2] *= bflo(cb[r].y); accv[3] *= bfhi(cb[r].y);
              const float ss = wave_sum((accv[0] * accv[0] + accv[1] * accv[1]) + (accv[2] * accv[2] + accv[3] * accv[3]));
              const float rstd = 1.0f / sqrtf(ss * (1.0f / 256.0f) + EPS);
              u32x2 o; o.x = pk2(accv[0] * rstd, accv[1] * rstd); o.y = pk2(accv[2] * rstd, accv[3] * rstd);
              *(u32x2*)(Y + (size_t)row * DM + 256 + 4 * lane) = o; } } }
}
__device__ __forceinline__ void mla_groupnorm(const Ctx& c0) {
    const Ctx c = fresh(c0);
    const int gw = c.bid * NWAVES + c.wave, NGW = c.G * NWAVES, lane = c.lane; bf16* Y = (bf16*)(c.ws + WS_Y);
    for (int row = gw; row < T; row += NGW) { u32x2* p = (u32x2*)(Y + (size_t)row * DM + 4 * lane); const u32x2 w = *p;
        const float x0 = bflo(w.x), x1 = bfhi(w.x), x2 = bflo(w.y), x3 = bfhi(w.y);
        const float ss = wave_sum((x0 * x0 + x1 * x1) + (x2 * x2 + x3 * x3)); const float rstd = 1.0f / sqrtf(ss * (1.0f / 256.0f) + EPS);
        u32x2 o; o.x = pk2(x0 * rstd, x1 * rstd); o.y = pk2(x2 * rstd, x3 * rstd); *p = o; }
}

#define MFMA32(a, b, c) __builtin_amdgcn_mfma_f32_32x32x16_bf16((a), (b), (c), 0, 0, 0)
__device__ __forceinline__ int crow(int r, int hi) { return (r & 3) + 8 * (r >> 2) + 4 * hi; }

__device__ __forceinline__ void gmlp_unit(const Args& a, const Ctx& c0, int l, int unit) {
    const Ctx c = fresh(c0);
    const int lane = c.lane, w = c.wave, r32 = lane & 31, hi = lane >> 5; const int tok0 = unit * 128;
    const bf16* P = (const bf16*)(c.ws + WS_P); bf16* Y = (bf16*)(c.ws + WS_Y);
    LAS bf16* vnT = (LAS bf16*)c.lds;
    LAS bf16* ug = (LAS bf16*)(c.lds + 69632);
    LAS float* stg = (LAS float*)c.lds;
    const f32x4 lg = *(const f32x4*)(argp(I_GMLP_LN) + l * 256 + 4 * lane);
    __syncthreads();
    {   u32x2 wv[16], wu[16];
#pragma unroll
        for (int jj = 0; jj < 16; ++jj) { const size_t ro = (size_t)(tok0 + w * 16 + jj) * PP; wv[jj] = *(const u32x2*)(P + ro + C_GV + 4 * lane); wu[jj] = *(const u32x2*)(P + ro + C_GU + 4 * lane); }
#pragma unroll
        for (int jj = 0; jj < 16; ++jj) { const int j = w * 16 + jj;
            float x[4] = {gelu_tanh(bflo(wv[jj].x)), gelu_tanh(bfhi(wv[jj].x)), gelu_tanh(bflo(wv[jj].y)), gelu_tanh(bfhi(wv[jj].y))};
            const float mean = wave_sum((x[0] + x[1]) + (x[2] + x[3])) * (1.0f / 256.0f);
#pragma unroll
            for (int i = 0; i < 4; ++i) x[i] -= mean;
            const float var = wave_sum((x[0] * x[0] + x[1] * x[1]) + (x[2] * x[2] + x[3] * x[3])) * (1.0f / 256.0f); const float rstd = 1.0f / sqrtf(var + EPS);
#pragma unroll
            for (int i = 0; i < 4; ++i) vnT[(4 * lane + i) * 136 + j] = (bf16)(pk2(x[i] * rstd * lg[i], 0.f) & 0xffffu);
            u32x2 gu; gu.x = pk2(gelu_tanh(bflo(wu[jj].x)), gelu_tanh(bfhi(wu[jj].x))); gu.y = pk2(gelu_tanh(bflo(wu[jj].y)), gelu_tanh(bfhi(wu[jj].y)));
            *(LAS u32x2*)(ug + j * 256 + 4 * lane) = gu; } }
    __syncthreads();
    const int g = w >> 1; const bf16* WG = (const bf16*)(c.ws + WS_WGM) + (size_t)g * 128 * 128;
    f32x16 acc[4];
#pragma unroll
    for (int it = 0; it < 4; ++it)
#pragma unroll
        for (int r = 0; r < 16; ++r) acc[it][r] = 0.f;
#pragma unroll
    for (int ks = 0; ks < 8; ++ks) { const bf16x8 bfr = *(const LAS bf16x8*)(vnT + (32 * w + r32) * 136 + 16 * ks + 8 * hi);
#pragma unroll
        for (int it = 0; it < 4; ++it) { const bf16x8 afr = *(const bf16x8*)(WG + (size_t)(32 * it + r32) * 128 + 16 * ks + 8 * hi); acc[it] = MFMA32(afr, bfr, acc[it]); } }
    const float* bs = argp(I_GMLP_BS) + (size_t)l * 4 * 128 + g * 128; const int col = 32 * w + r32;
#pragma unroll
    for (int it = 0; it < 4; ++it)
#pragma unroll
        for (int r = 0; r < 16; ++r) { const int i = 32 * it + crow(r, hi); acc[it][r] = bf2f(ug[i * 256 + col]) * (acc[it][r] + bs[i]); }
    __syncthreads();
#pragma unroll
    for (int it = 0; it < 4; ++it)
#pragma unroll
        for (int r = 0; r < 16; ++r) { const int i = 32 * it + crow(r, hi); stg[i * 260 + col] = acc[it][r]; }
    __syncthreads();
    for (int jj = 0; jj < 16; ++jj) { const int i = w * 16 + jj; const f32x4 v = *(const LAS f32x4*)(stg + i * 260 + 4 * lane);
        const float ss = wave_sum((v[0] * v[0] + v[1] * v[1]) + (v[2] * v[2] + v[3] * v[3])); const float rstd = 1.0f / sqrtf(ss * (1.0f / 256.0f) + EPS);
        u32x2 o; o.x = pk2(v[0] * rstd, v[1] * rstd); o.y = pk2(v[2] * rstd, v[3] * rstd); *(u32x2*)(Y + (size_t)(tok0 + i) * DM + 512 + 4 * lane) = o; }
    __syncthreads();
}

__device__ __forceinline__ void compress_unit(const Ctx& c0, int unit) {
    const Ctx c = fresh(c0);
    const int lane = c.lane, w = c.wave, r32 = lane & 31, hi = lane >> 5; const int b = unit >> 4, kv = (unit >> 3) & 1, grp = unit & 7;
    const int kh = w >> 2, cg = w & 3;
    const bf16* P = (const bf16*)(c.ws + WS_P);
    const bf16* arow = P + (size_t)(b * SEQ + 16 * (32 * grp + r32)) * PP + (kv ? C_NVC : C_NKC) + 8 * hi;
    const bf16* brow = (const bf16*)(c.ws + WS_W1T) + ((size_t)kv * 256 + 64 * cg + r32) * 2048 + 8 * hi;
    f32x16 acc0, acc1;
#pragma unroll
    for (int r = 0; r < 16; ++r) { acc0[r] = 0.f; acc1[r] = 0.f; }
#pragma unroll 4
    for (int k2 = 0; k2 < 64; ++k2) { const int ks = 64 * kh + k2;
        const bf16x8 af = *(const bf16x8*)(arow + (size_t)(ks >> 2) * PP + 16 * (ks & 3));
        const bf16x8 b0 = *(const bf16x8*)(brow + 16 * ks), b1 = *(const bf16x8*)(brow + (size_t)32 * 2048 + 16 * ks);
        acc0 = MFMA32(af, b0, acc0); acc1 = MFMA32(af, b1, acc1); }
    LAS float* red = (LAS float*)c.lds;
    LAS bf16* Hs = (LAS bf16*)(c.lds + 33280);
    __syncthreads();
    if (kh == 1) {
#pragma unroll
        for (int r = 0; r < 16; ++r) { red[crow(r, hi) * 260 + 64 * cg + r32] = acc0[r]; red[crow(r, hi) * 260 + 64 * cg + 32 + r32] = acc1[r]; } }
    __syncthreads();
    if (kh == 0) { const float bp0 = ((const float*)(c.ws + WS_BPE))[kv * 256 + 64 * cg + r32], bp1 = ((const float*)(c.ws + WS_BPE))[kv * 256 + 64 * cg + 32 + r32];
#pragma unroll
        for (int r = 0; r < 16; ++r) { const int i = crow(r, hi);
            Hs[i * 264 + 64 * cg + r32] = (bf16)(pk2(gelu_tanh(acc0[r] + red[i * 260 + 64 * cg + r32] + bp0), 0.f) & 0xffffu);
            Hs[i * 264 + 64 * cg + 32 + r32] = (bf16)(pk2(gelu_tanh(acc1[r] + red[i * 260 + 64 * cg + 32 + r32] + bp1), 0.f) & 0xffffu); } }
    __syncthreads();
    if (w < 2) {
        const bf16* w2 = (const bf16*)(c.ws + WS_W2T) + ((size_t)kv * 64 + 32 * w + r32) * 256 + 8 * hi;
        f32x16 o;
#pragma unroll
        for (int r = 0; r < 16; ++r) o[r] = 0.f;
#pragma unroll
        for (int ks = 0; ks < 16; ++ks) { const bf16x8 af = *(const LAS bf16x8*)(Hs + r32 * 264 + 16 * ks + 8 * hi); const bf16x8 bf_ = *(const bf16x8*)(w2 + 16 * ks); o = MFMA32(af, bf_, o); }
        const int n = 32 * w + r32;
#pragma unroll
        for (int r = 0; r < 16; ++r) { const int ig = 32 * grp + crow(r, hi); const bf16 val = ig < 255 ? (bf16)(pk2(o[r], 0.f) & 0xffffu) : (bf16)0;
            if (kv == 0) ((bf16*)(c.ws + WS_KC))[((size_t)b * 256 + ig) * 64 + n] = val; else ((bf16*)(c.ws + WS_VCT))[((size_t)b * 64 + n) * 256 + ig] = val; }
    }
    __syncthreads();
}

constexpr int NSLOT = 4, SLOT_BYTES = 20480, SL_K = 0, SL_V = 8192, SL_KR = 16384;
constexpr int AT_RING = 0, AT_PSEL = NSLOT * SLOT_BYTES, AT_SELM = AT_PSEL + 64 * 65 * 4, AT_TACC = AT_SELM + 512, AT_END = AT_TACC + 8 * 4096;
static_assert(AT_END <= ARENA_BYTES, "attention LDS");
struct FState { f32x16 o0, o1; float m, l; };
__device__ __forceinline__ void fstate_init(FState& st) {
#pragma unroll
    for (int r = 0; r < 16; ++r) { st.o0[r] = 0.f; st.o1[r] = 0.f; }
    st.m = -1e30f; st.l = 0.f;
}
struct QLds { LAS const unsigned char* ql; __device__ __forceinline__ bf16x8 operator[](int ks) const { return *(const LAS bf16x8*)(ql + ks * 1024); } };
template <int DK, class QF> __device__ __forceinline__ void qk_tile(f32x16& p0, f32x16& p1, const QF& qf, LAS const unsigned char* Sb, int r32, int hi) {
    const f32x16 zero16 = {0.f, 0.f, 0.f, 0.f, 0.f, 0.f, 0.f, 0.f, 0.f, 0.f, 0.f, 0.f, 0.f, 0.f, 0.f, 0.f};
    const int xa = (r32 >> 1) & 7;
#pragma unroll
    for (int ks = 0; ks < 4; ++ks) {
        const int off = r32 * 128 + (((2 * ks + hi) ^ xa) << 4);
        const bf16x8 ka = *(const LAS bf16x8*)(Sb + SL_K + off);
        const bf16x8 kb = *(const LAS bf16x8*)(Sb + SL_K + 4096 + off);
        if (ks == 0) { p0 = MFMA32(ka, qf[0], zero16); p1 = MFMA32(kb, qf[0], zero16); }
        else { p0 = MFMA32(ka, qf[ks], p0); p1 = MFMA32(kb, qf[ks], p1); }
    }
    if (DK == 96) {
        const int xr = (r32 >> 2) & 3;
#pragma unroll
        for (int ks = 0; ks < 2; ++ks) {
            const int off = r32 * 64 + (((2 * ks + hi) ^ xr) << 4);
            const bf16x8 ka = *(const LAS bf16x8*)(Sb + SL_KR + off);
            const bf16x8 kb = *(const LAS bf16x8*)(Sb + SL_KR + 2048 + off);
            p0 = MFMA32(ka, qf[4 + ks], p0); p1 = MFMA32(kb, qf[4 + ks], p1); } }
}
template <class QF> __device__ __forceinline__ void qk_step(f32x16& p0, f32x16& p1, const QF& qf, LAS const unsigned char* Sb, int r32, int hi, int ks) {
    const f32x16 zero16 = {0.f, 0.f, 0.f, 0.f, 0.f, 0.f, 0.f, 0.f, 0.f, 0.f, 0.f, 0.f, 0.f, 0.f, 0.f, 0.f};
    bf16x8 ka, kb;
    if (ks < 4) { const int off = r32 * 128 + (((2 * ks + hi) ^ ((r32 >> 1) & 7)) << 4); ka = *(const LAS bf16x8*)(Sb + SL_K + off); kb = *(const LAS bf16x8*)(Sb + SL_K + 4096 + off); }
    else { const int off = r32 * 64 + (((2 * (ks - 4) + hi) ^ ((r32 >> 2) & 3)) << 4); ka = *(const LAS bf16x8*)(Sb + SL_KR + off); kb = *(const LAS bf16x8*)(Sb + SL_KR + 2048 + off); }
    const bf16x8 q = qf[ks];
    if (ks == 0) { p0 = MFMA32(ka, q, zero16); p1 = MFMA32(kb, q, zero16); } else { p0 = MFMA32(ka, q, p0); p1 = MFMA32(kb, q, p1); }
}
__device__ __forceinline__ void pv_step(f32x16& o0, f32x16& o1, const f32x16& p0, const f32x16& p1, LAS const unsigned char* Sb, int r32, int hi, int s) {
    const int xv = (r32 >> 1) & 7, b = 8 * (s & 1);
    u32x4 pw;
    if (s < 2) { pw.x = pk2(p0[b], p0[b + 1]); pw.y = pk2(p0[b + 2], p0[b + 3]); pw.z = pk2(p0[b + 4], p0[b + 5]); pw.w = pk2(p0[b + 6], p0[b + 7]); }
    else       { pw.x = pk2(p1[b], p1[b + 1]); pw.y = pk2(p1[b + 2], p1[b + 3]); pw.z = pk2(p1[b + 4], p1[b + 5]); pw.w = pk2(p1[b + 6], p1[b + 7]); }
    const bf16x8 pf = __builtin_bit_cast(bf16x8, pw);
#pragma unroll
    for (int db = 0; db < 2; ++db) {
        LAS const unsigned char* vrow = Sb + SL_V + (32 * db + r32) * 128 + 8 * hi;
        const u32x2 lo = *(const LAS u32x2*)(vrow + (((2 * s) ^ xv) << 4)), hh = *(const LAS u32x2*)(vrow + (((2 * s + 1) ^ xv) << 4));
        const u32x4 vv = {lo.x, lo.y, hh.x, hh.y}; const bf16x8 vf = __builtin_bit_cast(bf16x8, vv);
        if (db == 0) o0 = MFMA32(vf, pf, o0); else o1 = MFMA32(vf, pf, o1); }
}
__device__ __forceinline__ void pv_tile(f32x16& o0, f32x16& o1, const f32x16& p0, const f32x16& p1, LAS const unsigned char* Sb, int r32, int hi) {
    const int xv = (r32 >> 1) & 7;
#pragma unroll
    for (int s = 0; s < 4; ++s) {
        const int b = 8 * (s & 1);
        u32x4 pw;
        if (s < 2) { pw.x = pk2(p0[b], p0[b + 1]); pw.y = pk2(p0[b + 2], p0[b + 3]); pw.z = pk2(p0[b + 4], p0[b + 5]); pw.w = pk2(p0[b + 6], p0[b + 7]); }
        else       { pw.x = pk2(p1[b], p1[b + 1]); pw.y = pk2(p1[b + 2], p1[b + 3]); pw.z = pk2(p1[b + 4], p1[b + 5]); pw.w = pk2(p1[b + 6], p1[b + 7]); }
        const bf16x8 pf = __builtin_bit_cast(bf16x8, pw);
#pragma unroll
        for (int db = 0; db < 2; ++db) {
            LAS const unsigned char* vrow = Sb + SL_V + (32 * db + r32) * 128 + 8 * hi;
            const u32x2 lo = *(const LAS u32x2*)(vrow + (((2 * s) ^ xv) << 4)), hh = *(const LAS u32x2*)(vrow + (((2 * s + 1) ^ xv) << 4));
            const u32x4 vv = {lo.x, lo.y, hh.x, hh.y}; const bf16x8 vf = __builtin_bit_cast(bf16x8, vv);
            if (db == 0) o0 = MFMA32(vf, pf, o0); else o1 = MFMA32(vf, pf, o1); }
    }
}
template <bool MASKED> __device__ __forceinline__ void softmax_step(FState& st, f32x16& p0, f32x16& p1, bool lane_on = true) {
    float mx = fmaxf(p0[0], p1[0]);
#pragma unroll
    for (int r = 1; r < 16; ++r) mx = fmaxf(mx, fmaxf(p0[r], p1[r]));
    mx = fmaxf(mx, __shfl_xor(mx, 32));
    if (!MASKED) mx = lane_on ? mx : -1e30f;
    if (__any(mx > st.m)) {
        const float mnew = fmaxf(st.m, mx), alpha = __builtin_amdgcn_exp2f(st.m - mnew); st.m = mnew;
        st.l *= alpha;
#pragma unroll
        for (int r = 0; r < 16; ++r) { st.o0[r] *= alpha; st.o1[r] *= alpha; }
    }
    float rs = 0.f;
    if (MASKED) {
        const float m = st.m;
#pragma unroll
        for (int r = 0; r < 16; ++r) { p0[r] = p0[r] > -1e29f ? __builtin_amdgcn_exp2f(p0[r] - m) : 0.f; p1[r] = p1[r] > -1e29f ? __builtin_amdgcn_exp2f(p1[r] - m) : 0.f; rs += p0[r] + p1[r]; }
    } else {
        const float m = lane_on ? st.m : 1e30f;
#pragma unroll
        for (int r = 0; r < 16; ++r) { p0[r] = __builtin_amdgcn_exp2f(p0[r] - m); p1[r] = __builtin_amdgcn_exp2f(p1[r] - m); rs += p0[r] + p1[r]; }
    }
    st.l += rs;
}
__device__ __forceinline__ float max_xor32(float v) { const auto rr = __builtin_amdgcn_permlane32_swap(__float_as_uint(v), __float_as_uint(v), false, false); return fmaxf(__uint_as_float(rr[0]), __uint_as_float(rr[1])); }
#define SMX_I(P0, P1, AL, MEFF, ON) do { float mx_ = fmaxf(P0[0], P1[0]); \
    _Pragma("unroll") for (int r = 1; r < 16; ++r) mx_ = fmaxf(mx_, fmaxf(P0[r], P1[r])); \
    mx_ = max_xor32(mx_); if (LANEON_) mx_ = (ON) ? mx_ : -1e30f; \
    const float mn_ = fmaxf(st.m, mx_); AL = __builtin_amdgcn_exp2f(st.m - mn_); st.m = mn_; MEFF = LANEON_ ? ((ON) ? mn_ : 1e30f) : mn_; } while (0)
#define SMX_II(P, MEFF, RS) do { _Pragma("unroll") for (int r = 0; r < 16; ++r) { P[r] = __builtin_amdgcn_exp2f(P[r] - MEFF); RS += P[r]; } } while (0)
#define SMX_III(AL, RS) do { st.l = st.l * AL + RS; _Pragma("unroll") for (int r = 0; r < 16; ++r) { st.o0[r] *= AL; st.o1[r] *= AL; } } while (0)
#define SBAR0 __builtin_amdgcn_sched_barrier(0)
#define PAIR_NB(DK, LANEON, ONA, ONB) do { constexpr bool LANEON_ = LANEON; \
    f32x16 a0, a1, b0, b1; float alA, mA, rsA = 0.f, alB, mB, rsB = 0.f; \
    qk_tile<DK>(a0, a1, qf, SbA, r32, hi); SBAR0; \
    qk_step(b0, b1, qf, SbB, r32, hi, 0); qk_step(b0, b1, qf, SbB, r32, hi, 1); SMX_I(a0, a1, alA, mA, (ONA)); SBAR0; \
    qk_step(b0, b1, qf, SbB, r32, hi, 2); qk_step(b0, b1, qf, SbB, r32, hi, 3); SMX_II(a0, mA, rsA); SBAR0; \
    if (DK == 96) { qk_step(b0, b1, qf, SbB, r32, hi, 4); qk_step(b0, b1, qf, SbB, r32, hi, 5); } SMX_II(a1, mA, rsA); SMX_III(alA, rsA); SBAR0; \
    pv_step(st.o0, st.o1, a0, a1, SbA, r32, hi, 0); pv_step(st.o0, st.o1, a0, a1, SbA, r32, hi, 1); SMX_I(b0, b1, alB, mB, (ONB)); SMX_II(b0, mB, rsB); SBAR0; \
    pv_step(st.o0, st.o1, a0, a1, SbA, r32, hi, 2); pv_step(st.o0, st.o1, a0, a1, SbA, r32, hi, 3); SMX_II(b1, mB, rsB); SBAR0; \
    SMX_III(alB, rsB); pv_tile(st.o0, st.o1, b0, b1, SbB, r32, hi); } while (0)
template <int DK> struct DmaLoader {
    const char *k1, *k2, *v; unsigned ks1, ks2, vs;
    unsigned o1, o2, ov;
    unsigned ldsbase, w;
    __device__ __forceinline__ void init(const bf16* k1_, int kp1, const bf16* k2_, int kp2, const bf16* v_, int vp, int lane, int wave, LAS unsigned char* lds) {
        k1 = (const char*)k1_; k2 = (const char*)k2_; v = (const char*)v_; ks1 = 64u * kp1 * 2u; ks2 = 64u * kp2 * 2u; vs = 128u; w = (unsigned)wave;
        ldsbase = (unsigned)(uintptr_t)lds + AT_RING;
        { const int key = 8 * wave + (lane >> 3), cc = (lane & 7) ^ ((key >> 1) & 7); o1 = ((unsigned)key * kp1 + 8u * cc) * 2u; }
        { const int key = 16 * (wave & 3) + (lane >> 2), cc = (lane & 3) ^ ((key >> 2) & 3); o2 = ((unsigned)key * kp2 + 8u * cc) * 2u; }
        { const int d = 8 * wave + (lane >> 3), kc = (lane & 7) ^ ((d >> 1) & 7); ov = ((unsigned)d * vp + 8u * kc) * 2u; }
    }
    __device__ __forceinline__ void issue(int j, int slot) const {
        const unsigned sb = ldsbase + (unsigned)slot * SLOT_BYTES;
        __builtin_amdgcn_global_load_lds((const unsigned*)(k1 + (size_t)j * ks1 + o1), (LAS unsigned*)(uintptr_t)(sb + SL_K + w * 1024u), 16, 0, 0);
        __builtin_amdgcn_global_load_lds((const unsigned*)(v + (size_t)j * vs + ov), (LAS unsigned*)(uintptr_t)(sb + SL_V + w * 1024u), 16, 0, 0);
        if (DK == 96) __builtin_amdgcn_global_load_lds((const unsigned*)(k2 + (size_t)j * ks2 + o2), (LAS unsigned*)(uintptr_t)(sb + SL_KR + (w & 3u) * 1024u), 16, 0, 0);
    }
};
#define ATT_WAITV(n) asm volatile("s_waitcnt vmcnt(" #n ")" ::: "memory")
#define TILE_BEGIN(L, J0, J1, WAITSTMT) { \
    const int _j0 = (J0), _j1 = (J1); \
    __syncthreads(); \
    if (_j0 < _j1) { \
    _Pragma("unroll") for (int _p = 0; _p < 3; ++_p) (L).issue((_j0 + _p) < _j1 ? (_j0 + _p) : (_j1 - 1), _p); \
    for (int j = _j0; j < _j1; ++j) { \
        WAITSTMT; __builtin_amdgcn_s_barrier(); asm volatile("" ::: "memory"); \
        (L).issue((j + 3) < _j1 ? (j + 3) : (_j1 - 1), (j - _j0 + 3) & 3); \
        LAS const unsigned char* Sb = c.lds + AT_RING + ((j - _j0) & 3) * SLOT_BYTES;
#define TILE_END(L) \
    } } \
    ATT_WAITV(0); __builtin_amdgcn_s_barrier(); asm volatile("" ::: "memory"); }

#define TILE2_BEGIN(L, J0, J1) { \
    const int _j0 = (J0), _j1 = (J1), _npair = (_j1 - _j0 + 1) >> 1; \
    __syncthreads(); \
    if (_npair > 0) { \
    (L).issue(_j0, 0); (L).issue((_j0 + 1) < _j1 ? (_j0 + 1) : (_j1 - 1), 1); \
    for (int _i = 0; _i < _npair; ++_i) { \
        const int j = _j0 + 2 * _i; const bool hasB = (j + 1) < _j1; \
        ATT_WAITV(0); __builtin_amdgcn_s_barrier(); asm volatile("" ::: "memory"); \
        { const int _jn = j + 2, _s = ((_i + 1) & 1) * 2; (L).issue(_jn < _j1 ? _jn : (_j1 - 1), _s); (L).issue((_jn + 1) < _j1 ? (_jn + 1) : (_j1 - 1), _s + 1); } \
        LAS const unsigned char* SbA = c.lds + AT_RING + ((_i & 1) * 2) * SLOT_BYTES; LAS const unsigned char* SbB = SbA + SLOT_BYTES;
#define TILE2_END(L) \
    } } \
    ATT_WAITV(0); __builtin_amdgcn_s_barrier(); asm volatile("" ::: "memory"); }

__device__ __forceinline__ void mla_unit(const Ctx& c0, int b, int h, int qb) {
    const Ctx c = fresh(c0);
    const int lane = c.lane, w = c.wave, r32 = lane & 31, hi = lane >> 5;
    const int qpos = 256 * qb + 32 * w + r32; const int row = b * SEQ + qpos;
    const bf16* Qn = (const bf16*)(c.ws + WS_QN); const bf16* Qr = (const bf16*)(c.ws + WS_QR);
    LAS unsigned char* qimg = c.lds + NSLOT * SLOT_BYTES + w * 6144 + lane * 16;
    __syncthreads();
#pragma unroll
    for (int ks = 0; ks < 4; ++ks) *(LAS bf16x8*)(qimg + ks * 1024) = *(const bf16x8*)(Qn + (size_t)row * 256 + h * 64 + 16 * ks + 8 * hi);
#pragma unroll
    for (int ks = 0; ks < 2; ++ks) *(LAS bf16x8*)(qimg + (4 + ks) * 1024) = *(const bf16x8*)(Qr + (size_t)row * 128 + h * 32 + 16 * ks + 8 * hi);
    const QLds qf{qimg};
    DmaLoader<96> L; L.init((const bf16*)(c.ws + WS_KN) + (size_t)b * SEQ * 256 + h * 64, 256, (const bf16*)(c.ws + WS_KR) + (size_t)b * SEQ * 32, 32, (const bf16*)(c.ws + WS_VTM) + (size_t)(b * 4 + h) * 64 * SEQ, SEQ, lane, w, c.lds);
    FState st; fstate_init(st);
    const int wmax = 256 * qb + 32 * w + 31;
#define MLA_SM(P0, P1, JJ) do { if (64 * (JJ) + 63 > 256 * qb + 32 * w) { \
            _Pragma("unroll") for (int r = 0; r < 16; ++r) { const int k0 = 64 * (JJ) + crow(r, hi); if (k0 > qpos) P0[r] = -1e30f; if (k0 + 32 > qpos) P1[r] = -1e30f; } \
            softmax_step<true>(st, P0, P1); } else softmax_step<false>(st, P0, P1); } while (0)
    TILE2_BEGIN(L, 0, 4 * qb)
        PAIR_NB(96, false, true, true);
    TILE2_END(L)
    TILE2_BEGIN(L, 4 * qb, 4 * qb + 4)
        const bool needA = 64 * j <= wmax, needB = hasB && (64 * (j + 1) <= wmax);
        if (needB) {
            f32x16 a0, a1, b0, b1; qk_tile<96>(a0, a1, qf, SbA, r32, hi); __builtin_amdgcn_sched_barrier(0); qk_tile<96>(b0, b1, qf, SbB, r32, hi);
            MLA_SM(a0, a1, j); __builtin_amdgcn_sched_barrier(0); pv_tile(st.o0, st.o1, a0, a1, SbA, r32, hi); __builtin_amdgcn_sched_barrier(0);
            MLA_SM(b0, b1, j + 1); __builtin_amdgcn_sched_barrier(0); pv_tile(st.o0, st.o1, b0, b1, SbB, r32, hi);
        } else if (needA) {
            f32x16 a0, a1; qk_tile<96>(a0, a1, qf, SbA, r32, hi);
            MLA_SM(a0, a1, j); pv_tile(st.o0, st.o1, a0, a1, SbA, r32, hi);
        }
    TILE2_END(L)
#undef MLA_SM
    const float lt = st.l + __shfl_xor(st.l, 32); const float inv = 1.0f / lt;
    int qp2 = qpos; asm volatile("" : "+v"(qp2));
    bf16* Y = (bf16*)(c.ws + WS_Y) + (size_t)(b * SEQ + qp2) * DM + h * 64;
#pragma unroll
    for (int g = 0; g < 4; ++g) {
        u32x2 o; o.x = pk2(st.o0[4 * g] * inv, st.o0[4 * g + 1] * inv); o.y = pk2(st.o0[4 * g + 2] * inv, st.o0[4 * g + 3] * inv); *(u32x2*)(Y + 8 * g + 4 * hi) = o;
        u32x2 o2; o2.x = pk2(st.o1[4 * g] * inv, st.o1[4 * g + 1] * inv); o2.y = pk2(st.o1[4 * g + 2] * inv, st.o1[4 * g + 3] * inv); *(u32x2*)(Y + 32 + 8 * g + 4 * hi) = o2; }
}

__device__ __forceinline__ void nsa_unit(const Ctx& c0, int b, int qt) {
    const Ctx c = fresh(c0);
    const int lane = c.lane, w = c.wave, r32 = lane & 31, hi = lane >> 5;
    const int tl = 8 * w + (r32 & 7), head = r32 >> 3, tok = 64 * qt + tl; const int row = b * SEQ + tok;
    const bf16* P = (const bf16*)(c.ws + WS_P);
    bf16x8 qf[4];
#pragma unroll
    for (int ks = 0; ks < 4; ++ks) qf[ks] = *(const bf16x8*)(P + (size_t)row * PP + C_NQ + head * 64 + 16 * ks + 8 * hi);
#define NSA_GATE(br) ({ int t_ = tok; asm volatile("" : "+v"(t_)); sigmoid_f(bf2f(P[(size_t)(b * SEQ + t_) * PP + C_NG + head * 3 + (br)])); })
    LAS float* psel = (LAS float*)(c.lds + AT_PSEL); LAS unsigned long long* selm = (LAS unsigned long long*)(c.lds + AT_SELM);
    __syncthreads();
    for (int i = c.tid; i < 64 * 65; i += NWAVES * 64) psel[i] = 0.f;
    LAS unsigned* tacc = (LAS unsigned*)(c.lds + AT_TACC) + w * 1024 + lane;
    DmaLoader<64> L; L.init((const bf16*)(c.ws + WS_KC) + (size_t)b * 256 * 64, 64, nullptr, 0, (const bf16*)(c.ws + WS_VCT) + (size_t)b * 64 * 256, 256, lane, w, c.lds);
    const int ntc = (4 * qt + 2) / 64 + 1;
    float cm = -1e30f, cl = 0.f;
    TILE_BEGIN(L, 0, ntc, ATT_WAITV(4))
        f32x16 p0, p1; qk_tile<64>(p0, p1, qf, Sb, r32, hi);
        float mx = -1e30f;
#pragma unroll
        for (int r = 0; r < 16; ++r) { const int c0 = 64 * j + crow(r, hi); if (16 * c0 + 31 > tok) p0[r] = -1e30f; if (16 * (c0 + 32) + 31 > tok) p1[r] = -1e30f; mx = fmaxf(mx, fmaxf(p0[r], p1[r])); }
        mx = fmaxf(mx, __shfl_xor(mx, 32));
        const float mnew = fmaxf(cm, mx); float rs = 0.f;
#pragma unroll
        for (int r = 0; r < 16; ++r) { rs += (p0[r] > -1e29f ? __builtin_amdgcn_exp2f(p0[r] - mnew) : 0.f) + (p1[r] > -1e29f ? __builtin_amdgcn_exp2f(p1[r] - mnew) : 0.f); }
        cl = cl * __builtin_amdgcn_exp2f(cm - mnew) + rs; cm = mnew;
    TILE_END(L)
    cl += __shfl_xor(cl, 32);
    const float cinv = cl > 0.f ? 1.0f / cl : 0.f;
    {
        f32x16 o0, o1;
#pragma unroll
        for (int r = 0; r < 16; ++r) { o0[r] = 0.f; o1[r] = 0.f; }
        TILE_BEGIN(L, 0, ntc, ATT_WAITV(4))
            f32x16 p0, p1; qk_tile<64>(p0, p1, qf, Sb, r32, hi);
#pragma unroll
            for (int r = 0; r < 16; ++r) { const int c0 = 64 * j + crow(r, hi);
                p0[r] = (16 * c0 + 31 <= tok) ? __builtin_amdgcn_exp2f(p0[r] - cm) * cinv : 0.f; p1[r] = (16 * (c0 + 32) + 31 <= tok) ? __builtin_amdgcn_exp2f(p1[r] - cm) * cinv : 0.f; }
#pragma unroll
            for (int half = 0; half < 2; ++half)
#pragma unroll
                for (int g = 0; g < 4; ++g) {
                    float av, bv;
                    if (half == 0) { av = p0[4 * g] + p0[4 * g + 1] + p0[4 * g + 2] + 0.5f * p0[4 * g + 3]; bv = 0.5f * p0[4 * g + 3]; }
                    else           { av = p1[4 * g] + p1[4 * g + 1] + p1[4 * g + 2] + 0.5f * p1[4 * g + 3]; bv = 0.5f * p1[4 * g + 3]; }
                    av += __shfl_xor(av, 8); av += __shfl_xor(av, 16); bv += __shfl_xor(bv, 8); bv += __shfl_xor(bv, 16);
                    if (head == 0) { const int n = 16 * j + 8 * half + 2 * g + hi; (void)__hip_atomic_fetch_add(psel + tl * 65 + n, av, __ATOMIC_RELAXED, __HIP_MEMORY_SCOPE_WORKGROUP); (void)__hip_atomic_fetch_add(psel + tl * 65 + n + 1, bv, __ATOMIC_RELAXED, __HIP_MEMORY_SCOPE_WORKGROUP); }
                }
            pv_tile(o0, o1, p0, p1, Sb, r32, hi);
        TILE_END(L)
        { const float g0 = NSA_GATE(0);
#pragma unroll
        for (int r = 0; r < 16; ++r) tacc[r * 64] = pk2(g0 * o0[r], g0 * o1[r]); }
    }
    __syncthreads();
    for (int tt = 0; tt < 8; ++tt) {
        const int tk = 8 * w + tt; float sc = psel[tk * 65 + lane];
        if (lane > qt) sc = -1.0f; else if (lane == 0 || lane == qt || lane == qt - 1) sc = 1e4f;
        int rank = 0;
        for (int n = 0; n < 64; ++n) { const float so = __builtin_bit_cast(float, __builtin_amdgcn_readlane(__builtin_bit_cast(int, sc), n)); rank += (so > sc || (so == sc && n < lane)) ? 1 : 0; }
        const unsigned long long mk = __ballot(rank < 16);
        if (lane == 0) selm[tk] = mk;
    }
    __syncthreads();
    const unsigned long long smask = selm[tl];
    {
        L.init(P + (size_t)b * SEQ * PP + C_NKS, PP, nullptr, 0, (const bf16*)(c.ws + WS_VTS) + (size_t)b * 64 * SEQ, SEQ, lane, w, c.lds);
        FState st; fstate_init(st);
#define SEL_SM(P0, P1, JJ) do { if ((JJ) == qt) { \
            _Pragma("unroll") for (int r = 0; r < 16; ++r) { const int k0 = 64 * (JJ) + crow(r, hi); if (k0 > tok) P0[r] = -1e30f; if (k0 + 32 > tok) P1[r] = -1e30f; } \
            softmax_step<true>(st, P0, P1);   \
        } else softmax_step<false>(st, P0, P1, (bool)((smask >> (JJ)) & 1ull)); } while (0)
        const int qe = qt & ~1;
        TILE2_BEGIN(L, 0, qe)
            PAIR_NB(64, true, (bool)((smask >> j) & 1ull), (bool)((smask >> (j + 1)) & 1ull));
        TILE2_END(L)
        TILE2_BEGIN(L, qe, qt + 1)
            if (hasB) {
                f32x16 a0, a1, b0, b1; qk_tile<64>(a0, a1, qf, SbA, r32, hi); __builtin_amdgcn_sched_barrier(0); qk_tile<64>(b0, b1, qf, SbB, r32, hi);
                SEL_SM(a0, a1, j); __builtin_amdgcn_sched_barrier(0); pv_tile(st.o0, st.o1, a0, a1, SbA, r32, hi); __builtin_amdgcn_sched_barrier(0);
                SEL_SM(b0, b1, j + 1); __builtin_amdgcn_sched_barrier(0); pv_tile(st.o0, st.o1, b0, b1, SbB, r32, hi);
            } else {
                f32x16 a0, a1; qk_tile<64>(a0, a1, qf, SbA, r32, hi);
                SEL_SM(a0, a1, j); pv_tile(st.o0, st.o1, a0, a1, SbA, r32, hi);
            }
        TILE2_END(L)
#undef SEL_SM
        const float lt = st.l + __shfl_xor(st.l, 32); const float f = lt > 0.f ? NSA_GATE(1) / lt : 0.f;
#pragma unroll
        for (int r = 0; r < 16; ++r) { const unsigned t = tacc[r * 64]; tacc[r * 64] = pk2(bflo(t) + f * st.o0[r], bfhi(t) + f * st.o1[r]); }
    }
    f32x16 t0, t1;
    {
        L.init(P + (size_t)b * SEQ * PP + C_NKW, PP, nullptr, 0, (const bf16*)(c.ws + WS_VTW) + (size_t)b * 64 * SEQ, SEQ, lane, w, c.lds);
        FState st; fstate_init(st);
        TILE_BEGIN(L, (qt >= 8 ? qt - 8 : 0), qt + 1, ATT_WAITV(4))
            f32x16 p0, p1; qk_tile<64>(p0, p1, qf, Sb, r32, hi);
            if (j == qt || j + 8 == qt) {
#pragma unroll
                for (int r = 0; r < 16; ++r) { const int k0 = 64 * j + crow(r, hi); if (k0 > tok || k0 + 512 <= tok) p0[r] = -1e30f; if (k0 + 32 > tok || k0 + 32 + 512 <= tok) p1[r] = -1e30f; }
                softmax_step<true>(st, p0, p1);
            } else softmax_step<false>(st, p0, p1);
            pv_tile(st.o0, st.o1, p0, p1, Sb, r32, hi);
        TILE_END(L)
        const float lt = st.l + __shfl_xor(st.l, 32); const float f = lt > 0.f ? NSA_GATE(2) / lt : 0.f;
#pragma unroll
        for (int r = 0; r < 16; ++r) { const unsigned t = tacc[r * 64]; t0[r] = bflo(t) + f * st.o0[r]; t1[r] = bfhi(t) + f * st.o1[r]; }
    }
    float ss = 0.f;
#pragma unroll
    for (int r = 0; r < 16; ++r) ss += t0[r] * t0[r] + t1[r] * t1[r];
    ss += __shfl_xor(ss, 32); ss += __shfl_xor(ss, 8); ss += __shfl_xor(ss, 16);
    const float rstd = 1.0f / sqrtf(ss * (1.0f / 256.0f) + EPS);
    int tk2 = tok; asm volatile("" : "+v"(tk2));
    bf16* Y = (bf16*)(c.ws + WS_Y) + (size_t)(b * SEQ + tk2) * DM + 768 + head * 64;
#pragma unroll
    for (int g = 0; g < 4; ++g) {
        u32x2 o; o.x = pk2(t0[4 * g] * rstd, t0[4 * g + 1] * rstd); o.y = pk2(t0[4 * g + 2] * rstd, t0[4 * g + 3] * rstd); *(u32x2*)(Y + 8 * g + 4 * hi) = o;
        u32x2 o2; o2.x = pk2(t1[4 * g] * rstd, t1[4 * g + 1] * rstd); o2.y = pk2(t1[4 * g + 2] * rstd, t1[4 * g + 3] * rstd); *(u32x2*)(Y + 32 + 8 * g + 4 * hi) = o2; }
}

#ifndef PHMASK
#define PHMASK 0xFFFF
#endif
#define PHON(k) ((PHMASK >> (k)) & 1)
#ifndef SUBMASK
#define SUBMASK 0xFF
#endif
#define SUBON(k) ((SUBMASK >> (k)) & 1)
#ifndef REPMASK
#define REPMASK 0
#endif
#define NREP(k) (((REPMASK >> (k)) & 1) ? 2 : 1)
constexpr int PH_PER_LAYER = 17, PH_FINAL = DEPTH * PH_PER_LAYER, NPH = PH_FINAL + 1;
__global__ void __launch_bounds__(NWAVES * 64, 2) fwd_kernel(Args a) {
    extern __shared__ __attribute__((aligned(16))) unsigned char lds_raw[];
    Ctx c; c.lds = (LAS unsigned char*)lds_raw; c.ws = (GAS unsigned char*)a.ws; c.tid = threadIdx.x; c.lane = c.tid & 63; c.wave = __builtin_amdgcn_readfirstlane(c.tid >> 6); c.G = gridDim.x; c.bid = blockIdx.x;
    volatile LAS unsigned* MISC = (volatile LAS unsigned*)(c.lds + MISC_OFF);
    if (c.tid < 64) MISC[c.tid] = 0u;
    __syncthreads();
    const int lo = a.ph_lo, hi = a.ph_hi;
    const bool multi = (hi - lo) > 1;
    XcdBarrier bar; bar.bar = (unsigned*)(c.ws + WS_CTL) + CW_BAR; bar.x = 0; bar.st = nullptr;
    if (multi) bar = xcd_barrier_post((unsigned*)(c.ws + WS_CTL) + CW_BAR, MISC + 8);
#define IN(k) (lo <= (k) && (k) < hi)
#define SEAM(k) do { if ((k) + 1 < hi) { xcd_barrier(bar, (unsigned*)(c.ws + WS_CTL) + CW_BAR); if (NREP(15) > 1) xcd_barrier(bar, (unsigned*)(c.ws + WS_CTL) + CW_BAR); } } while (0)
    for (int l = 0; l < DEPTH; ++l) {
        GAS unsigned char* ws = c.ws; asm volatile("" : "+s"(ws));
        const int pb = l * PH_PER_LAYER;
        const bool moe = (l & 1) != 0;
        if (PHON(0) && IN(pb + 0)) {
            for (int rep_ = 0; rep_ < NREP(0); ++rep_) convert_weights(a, c, l);
            const bf16* O2 = (const bf16*)(ws + WS_P);
            { const bool after_moe = l > 0 && ((l - 1) & 1);
              norm_pass<0>(a, c, l == 0 ? argp(I_X) : nullptr, after_moe ? O2 : nullptr, after_moe ? O2 + (size_t)T * DM : nullptr, l == 0 || after_moe, l); }
            if (NREP(10) > 1) { xcd_barrier(bar, (unsigned*)(c.ws + WS_CTL) + CW_BAR); norm_pass<0>(a, c, l == 0 ? argp(I_X) : nullptr, nullptr, nullptr, false, l); }
            SEAM(pb + 0);
        }
        if (PHON(1) && IN(pb + 1)) for (int rep_ = 0; rep_ < NREP(1); ++rep_) {
            SchedPlain S; S.R.init(T / 256, PP / 256, c.G, c.bid); S.lda2_ = DM * 2; S.B = (const char*)(ws + WS_WIN); S.btile = (size_t)256 * DM * 2;
            EpiInProj E{(bf16*)(ws + WS_P), (float*)(ws + WS_SSQ), (float*)(ws + WS_SSKV)};
            pg8::gemm_phase<EpiInProj, SchedPlain>(c.lds, (const char*)(ws + WS_XN), DM, DM, S, E);
            if (rep_ + 1 < NREP(1)) xcd_barrier(bar, (unsigned*)(c.ws + WS_CTL) + CW_BAR); else SEAM(pb + 1);
        }
        if (PHON(2) && IN(pb + 2)) for (int rep_ = 0; rep_ < NREP(2); ++rep_) {
            if (SUBON(0)) for (int r2_ = 0; r2_ < NREP(11); ++r2_) { SchedPlain S; S.R.init(T / 256, 4, c.G, c.bid); S.lda2_ = PP * 2; S.B = (const char*)(ws + WS_WQKV); S.btile = (size_t)256 * 384 * 2;
              EpiQkv E{(const float*)(ws + WS_SSQ), (const float*)(ws + WS_SSKV), (const f32x2_t*)(ws + WS_CS), (bf16*)(ws + WS_QN), (bf16*)(ws + WS_QR), (bf16*)(ws + WS_KN), (bf16*)(ws + WS_VTM)};
              pg8::gemm_phase<EpiQkv, SchedPlain>(c.lds, (const char*)(ws + WS_P), 384, 384, S, E); }
            if (SUBON(1)) for (int r2_ = 0; r2_ < NREP(12); ++r2_) for (int u = c.bid; u < NB * 32; u += c.G) gmlp_unit(a, c, l, u);
            if (SUBON(2)) for (int r2_ = 0; r2_ < NREP(13); ++r2_) for (int u = c.bid; u < 128; u += c.G) compress_unit(c, u);
            __syncthreads();
            if (SUBON(3)) for (int r2_ = 0; r2_ < NREP(14); ++r2_) prep_thin(a, c, l);
            if (rep_ + 1 < NREP(2)) xcd_barrier(bar, (unsigned*)(c.ws + WS_CTL) + CW_BAR); else SEAM(pb + 2);
        }
        if (PHON(3) && IN(pb + 3)) for (int rep_ = 0; rep_ < NREP(3); ++rep_) {
            const int vcu = (c.G % 8 == 0) ? (c.bid % 8) * (c.G / 8) + c.bid / 8 : c.bid;
            if (SUBON(0)) for (int u = vcu; u < 256; u += c.G) for (int rep = 0; rep < 2; ++rep) { const int bh = u >> 3, s = u & 7; mla_unit(c, bh >> 2, bh & 3, rep ? 15 - s : s); }
            if (SUBON(1)) for (int u = vcu; u < 256; u += c.G) for (int rep = 0; rep < 2; ++rep) { const int b = u >> 5, s = u & 31; nsa_unit(c, b, rep ? 63 - s : s); }
            if (rep_ + 1 < NREP(3)) xcd_barrier(bar, (unsigned*)(c.ws + WS_CTL) + CW_BAR); else SEAM(pb + 3);
        }
        if (PHON(4) && IN(pb + 4)) { mla_groupnorm(c); SEAM(pb + 4); }
        if (PHON(5) && IN(pb + 5)) for (int rep_ = 0; rep_ < NREP(5); ++rep_) {
            SchedPlain S; S.R.init(T / 256, 4, c.G, c.bid); S.lda2_ = DM * 2; S.B = (const char*)(ws + WS_WO); S.btile = (size_t)256 * DM * 2;
            EpiResidual E{(bf16*)(ws + WS_H)};
            pg8::gemm_phase<EpiResidual, SchedPlain>(c.lds, (const char*)(ws + WS_Y), DM, DM, S, E);
            if (rep_ + 1 < NREP(5)) xcd_barrier(bar, (unsigned*)(c.ws + WS_CTL) + CW_BAR); else SEAM(pb + 5);
        }
        if (PHON(6) && IN(pb + 6)) {
            norm_pass<1>(a, c, nullptr, nullptr, nullptr, false, l);
            SEAM(pb + 6);
        }
        if (PHON(7) && IN(pb + 7)) {
            const MoeMap M = make_moemap(c, l);
            const int P8 = M.pre8, rem = P8 & 63, NF = P8 >> 6, hasR = rem > 0 ? 1 : 0, nch = NF + hasR;
            for (int sidx = 0; sidx <= nch; ++sidx) {
                if (sidx >= 1) {
                    const int ci = sidx - 1; const bool isR = hasR && ci == 0; const int k = ci - hasR;
                    const int t0 = isR ? 0 : rem + 64 * k, nM = isR ? rem : 64;
                    SchedDown S; S.R.init(nM, 4, c.G, c.bid); S.M = M; S.t0 = t0; S.B = (const char*)(ws + WS_WD);
                    EpiDown E{(bf16*)(ws + WS_P), M, (bf16*)(ws + WS_H)};
                    pg8::gemm_phase<EpiDown, SchedDown>(c.lds, (const char*)(ws + (isR ? WS_ACTR : ((k & 1) ? WS_QN : WS_ACT))), FF, FF, S, E);
                }
                if (sidx < nch) {
                    const int ci = sidx; const bool isR = hasR && ci == 0; const int k = ci - hasR;
                    const int t0 = isR ? 0 : rem + 64 * k, nM = isR ? rem : 64;
                    SchedGateUp S; S.R.init(nM, 2 * FF / 256, c.G, c.bid); S.M = M; S.t0 = t0; S.B = (const char*)(ws + WS_WGU);
                    S.nd = (hasR && sidx == 1 && c.G == 256) ? rem * 4 : 0;
                    EpiSwiglu E{(bf16*)(ws + (isR ? WS_ACTR : ((k & 1) ? WS_QN : WS_ACT))), t0};
                    pg8::gemm_phase<EpiSwiglu, SchedGateUp>(c.lds, (const char*)(ws + WS_XN), DM, DM, S, E);
                }
                xcd_barrier(bar, (unsigned*)(c.ws + WS_CTL) + CW_BAR);
            }
        }
    }
    if (PHON(9) && IN(PH_FINAL)) {
        GAS unsigned char* ws = c.ws;
        const bf16* O2 = (const bf16*)(ws + WS_P);
        norm_pass<2>(a, c, nullptr, O2, O2 + (size_t)T * DM, false, DEPTH - 1);
    }
#undef IN
#undef SEAM
}

#ifndef MK_MULTI_LAUNCH
#define MK_MULTI_LAUNCH 0
#endif
extern "C" void kernel_launch(void* const* d_in, const int* in_sizes, int n_in, void* d_out, int out_size, void* d_ws, size_t ws_size, hipStream_t stream) {
    static int grid = 0;
    if (grid == 0) {
        if (n_in != 29 || out_size != T * DM || ws_size < WS_END) { fprintf(stderr, "kernel_launch: unexpected shapes (n_in %d, out %d, ws %zu < %zu)\n", n_in, out_size, ws_size, (size_t)WS_END); grid = -1; return; }
        int dev = 0, cus = 0, per_cu = 0;
        if (hipGetDevice(&dev) != hipSuccess || hipDeviceGetAttribute(&cus, hipDeviceAttributeMultiprocessorCount, dev) != hipSuccess) { grid = -1; return; }
        if (hipFuncSetAttribute((const void*)fwd_kernel, hipFuncAttributeMaxDynamicSharedMemorySize, LDS_BYTES) != hipSuccess) { fprintf(stderr, "kernel_launch: hipFuncSetAttribute failed\n"); grid = -1; return; }
        if (hipOccupancyMaxActiveBlocksPerMultiprocessor(&per_cu, (const void*)fwd_kernel, NWAVES * 64, LDS_BYTES) != hipSuccess || per_cu < 1) { fprintf(stderr, "kernel_launch: occupancy query says %d\n", per_cu); }
        (void)hipGetLastError();
        grid = cus;
    }
    if (grid < 0) return;
    (void)hipMemsetAsync((char*)d_ws + WS_CTL, 0, CTL_ZERO_BYTES, stream);
    Args a{};
    for (int i = 0; i < 29; ++i) a.in[i] = (const float*)d_in[i];
    a.out = (float*)d_out; a.ws = (unsigned char*)d_ws;
#if MK_MULTI_LAUNCH
    for (int p = 0; p < NPH; ++p) {
        const int l = p / PH_PER_LAYER, q = p % PH_PER_LAYER;
        if (p < PH_FINAL && q >= 7) { const int ch = (q - 7) >> 1; if (ch >= ((l & 1) ? 5 : 2)) continue; }
        a.ph_lo = p; a.ph_hi = p + 1;
        hipLaunchKernelGGL(fwd_kernel, dim3(grid), dim3(NWAVES * 64), LDS_BYTES, stream, a);
    }
#else
    a.ph_lo = 0; a.ph_hi = NPH;
    hipLaunchKernelGGL(fwd_kernel, dim3(grid), dim3(NWAVES * 64), LDS_BYTES, stream, a);
#endif
}
```

```cpp
#include <hip/hip_runtime.h>
#include <cstdio>
#include <cstdint>

#define LAS __attribute__((address_space(3)))
#define GAS __attribute__((address_space(1)))
typedef unsigned short bf16;
typedef short bf16x8 __attribute__((ext_vector_type(8)));
typedef float f32x4 __attribute__((ext_vector_type(4)));
typedef float f32x16 __attribute__((ext_vector_type(16)));
typedef unsigned u32x4 __attribute__((ext_vector_type(4)));
typedef unsigned u32x2 __attribute__((ext_vector_type(2)));
typedef float f32x2_t __attribute__((ext_vector_type(2)));
typedef __bf16 bf16x2_t __attribute__((ext_vector_type(2)));
typedef int v8i_t __attribute__((ext_vector_type(8)));

constexpr int NB = 8, SEQ = 4096, T = NB * SEQ, DM = 1024, DEPTH = 4;
constexpr int DIN = 2348, PP = 2560;
constexpr int FF = 3584, NE = 8;
constexpr float EPS = 1e-6f;
constexpr float LOG2E = 1.4426950408889634f;
constexpr int C_CQ = 0, C_CKV = 256, C_NKC = 384, C_NVC = 448, C_CB = 512, C_CC = 768, C_CHV = 1024, C_GU = 1280, C_GV = 1536,
              C_NQ = 1792, C_NKS = 2048, C_NVS = 2112, C_NKW = 2176, C_NVW = 2240, C_KR = 2304, C_NG = 2336;

constexpr size_t MiB = 1u << 20;
constexpr size_t WS_CTL = 0, CTL_ZERO_BYTES = 1 * MiB;
constexpr size_t WS_CS = 1 * MiB;
constexpr size_t WS_LIST = 5 * MiB;
constexpr size_t WS_WL = 7 * MiB;
constexpr size_t WS_SSQ = 9 * MiB;
constexpr size_t WS_SSKV = WS_SSQ + MiB / 2;
constexpr size_t WS_KC = 10 * MiB;
constexpr size_t WS_VCT = WS_KC + 256 * 1024;
constexpr size_t WS_WQKV = 11 * MiB;
constexpr size_t WS_WGM = WS_WQKV + 768 * 1024;
constexpr size_t WS_W2T = WS_WGM + 128 * 1024;
constexpr size_t WS_BPE = WS_W2T + 64 * 1024;
constexpr size_t WS_W1T = 12 * MiB;
constexpr size_t WS_WIN = 14 * MiB;
constexpr size_t WS_WO = 19 * MiB;
constexpr size_t WS_WGU = 21 * MiB;
constexpr size_t WS_WD = 133 * MiB;
constexpr size_t WS_XN = 189 * MiB;
constexpr size_t WS_P = 253 * MiB;
constexpr size_t WS_QN = 414 * MiB;
constexpr size_t WS_QR = 430 * MiB;
constexpr size_t WS_KN = 438 * MiB;
constexpr size_t WS_KR = 454 * MiB;
constexpr size_t WS_VTM = 456 * MiB;
constexpr size_t WS_VTS = 472 * MiB;
constexpr size_t WS_VTW = 476 * MiB;
constexpr size_t WS_Y = 480 * MiB;
constexpr size_t WS_D1 = 544 * MiB;
constexpr size_t WS_ACT = 608 * MiB;
constexpr size_t WS_H = 720 * MiB;
constexpr size_t WS_ACTR = 784 * MiB;
constexpr size_t WS_END = 800 * MiB;
static_assert(WS_P + (size_t)(T + 64) * PP * 2 <= WS_QN, "P");
static_assert(WS_QN + (size_t)16384 * 3584 * 2 <= WS_ACT, "second ACT buffer overlays [WS_QN, WS_ACT)");
constexpr int CW_BAR = 4096;
constexpr int CW_CNT = 16384;

constexpr int NWAVES = 8;
constexpr int ARENA_BYTES = 143360;
constexpr int MISC_OFF = ARENA_BYTES;
constexpr int LDS_BYTES = 147456;

__device__ __forceinline__ unsigned pk2(float lo, float hi) { f32x2_t v = {lo, hi}; bf16x2_t b = __builtin_convertvector(v, bf16x2_t); return __builtin_bit_cast(unsigned, b); }
__device__ __forceinline__ float bf2f(unsigned short x) { return __uint_as_float(((unsigned)x) << 16); }
__device__ __forceinline__ float bflo(unsigned w) { return __uint_as_float(w << 16); }
__device__ __forceinline__ float bfhi(unsigned w) { return __uint_as_float(w & 0xffff0000u); }
__device__ __forceinline__ float wave_sum(float v) {
#pragma unroll
    for (int o = 1; o < 64; o <<= 1) v += __shfl_xor(v, o);
    return v;
}
__device__ __forceinline__ float gelu_tanh(float x) {
    const float u = 0.7978845608028654f * (x + 0.044715f * x * x * x);
    const float e = __builtin_amdgcn_exp2f(u * (2.0f * LOG2E));
    const float th = 1.0f - 2.0f * __builtin_amdgcn_rcpf(e + 1.0f);
    return 0.5f * x * (1.0f + th);
}
__device__ __forceinline__ float silu_f(float x) { return x * __builtin_amdgcn_rcpf(1.0f + __builtin_amdgcn_exp2f(-x * LOG2E)); }
__device__ __forceinline__ float sigmoid_f(float x) { return __builtin_amdgcn_rcpf(1.0f + __builtin_amdgcn_exp2f(-x * LOG2E)); }
__device__ __forceinline__ unsigned pk4f8(float a, float b, float c, float d) { int p = __builtin_amdgcn_cvt_pk_fp8_f32(a, b, 0, false); p = __builtin_amdgcn_cvt_pk_fp8_f32(c, d, p, true); return (unsigned)p; }
constexpr float WSC = 64.0f;
#define LDS_WAIT() asm volatile("s_waitcnt lgkmcnt(0)" ::: "memory")
#define VM_WAIT() asm volatile("s_waitcnt vmcnt(0)" ::: "memory")

namespace pg8 {
constexpr int BM = 256, BK = 64, HALF = 128, HTB = HALF * BK * 2, STAGE_BYTES = 8 * HTB, NXCD = 8, WGM = 8;
__host__ __device__ __forceinline__ int lds_byte(int r, int c) { const int st = (r >> 4) * 2 + (c >> 5), rr = r & 15, cc = c & 31, ob = rr * 64 + cc * 2; return st * 1024 + (ob ^ (((ob >> 9) & 1) << 5)); }
__host__ __device__ __forceinline__ void stage_rc(int b, int& R, int& C) { const int st = b / 1024, sb = b % 1024, swz = sb ^ (((sb >> 9) & 1) << 5); R = (st >> 1) * 16 + swz / 64; C = (st & 1) * 32 + (swz % 64) / 2; }
__host__ __device__ __forceinline__ int perm32(int rho) { const int n = rho >> 4, i = rho & 15; return 8 * (i >> 2) + 4 * n + (i & 3); }

struct Unit { int pm, pn, e, aux, ne; };

struct RectOrder {
    int nM, nN, nwg, G, c;
    __device__ __forceinline__ void init(int nM_, int nN_, int G_, int c_) { nM = nM_; nN = nN_; nwg = nM * nN; G = G_; c = c_; }
    __device__ __forceinline__ bool get(int i, int& pm, int& pn) const { return getL((long)i * G + c, pm, pn); }
    __device__ __forceinline__ bool getL(long L, int& pm, int& pn) const {
        if (L >= nwg) return false;
        int wgid = (int)L; { const int q = nwg / NXCD, r = nwg % NXCD, xcd = wgid % NXCD, off = wgid / NXCD; wgid = (xcd < r ? xcd * (q + 1) : r * (q + 1) + (xcd - r) * q) + off; }
        const int nig = WGM * nN, gid = wgid / nig, fm = gid * WGM, gsz = (nM - fm) < WGM ? (nM - fm) : WGM;
        pm = fm + ((wgid % nig) % gsz); pn = (wgid % nig) / gsz; return true;
    }
};

template <class Epi, class Sched>
__device__ __forceinline__ void gemm_phase(LAS unsigned char* lds, const char* Abase, const int K, const int ldb  , const Sched& S, const Epi& E) {
    int tid = threadIdx.x; asm volatile("" : "+v"(tid));
    const int wid = __builtin_amdgcn_readfirstlane(tid >> 6), lane = tid & 63, wr = wid >> 2, wc = wid & 3, fr = lane & 15, fq = lane >> 4;
    constexpr int ES = Epi::FP8 ? 1 : 2;
    int nt = K * ES / 128; asm volatile("" : "+s"(nt));
    int R0, C0, R1, C1; stage_rc(tid * 16, R0, C0); stage_rc(tid * 16 + 8192, R1, C1);
    unsigned voffB[2];
    { const int Rb0 = Epi::PERM ? ((R0 & ~31) + perm32(R0 & 31)) : R0, Rb1 = Epi::PERM ? ((R1 & ~31) + perm32(R1 & 31)) : R1;
      voffB[0] = (unsigned)(Rb0 * ldb * ES + C0 * 2); voffB[1] = (unsigned)(Rb1 * ldb * ES + C1 * 2); }
    const size_t kstep = (size_t)(BK * 2);
    const size_t hstepB = (size_t)HALF * ldb * ES;
    const unsigned ldsw = (unsigned)wid * 1024u;
    const int aoff = lds_byte(wr * 64 + fr, fq * 8), boff = lds_byte(wc * 32 + fr, fq * 8);
    const int aoff8a = lds_byte(wr * 64 + fr, fq * 16), aoff8b = lds_byte(wr * 64 + fr, fq * 16 + 8), boff8a = lds_byte(wc * 32 + fr, fq * 16), boff8b = lds_byte(wc * 32 + fr, fq * 16 + 8);
#define PG8_SA(b, h) (((b) * 2 + (h)) * HTB)
#define PG8_SB(b, h) ((4 + (b) * 2 + (h)) * HTB)
#define PG8_GL(ubase, voff, dstoff) do { unsigned _o = (voff); asm volatile("" : "+v"(_o)); __builtin_amdgcn_global_load_lds((const unsigned*)((const char*)(ubase) + _o), (LAS unsigned*)(lds + (dstoff)), 16, 0, 0); } while (0)
#define PG8_STAGE_B(bufoff, gbase) do { PG8_GL(gbase, voffB[0], (bufoff) + ldsw); PG8_GL(gbase, voffB[1], (bufoff) + ldsw + 8192); } while (0)
#define PG8_STAGE_A0(bufoff, ub, kb) do { PG8_GL(Abase + ((ub) + (kb)), va00, (bufoff) + ldsw); PG8_GL(Abase + ((ub) + (kb)), va01, (bufoff) + ldsw + 8192); } while (0)
#define PG8_STAGE_A1(bufoff, ub, kb) do { PG8_GL(Abase + ((ub) + (kb) + hstepA), va10, (bufoff) + ldsw); PG8_GL(Abase + ((ub) + (kb) + hstepA), va11, (bufoff) + ldsw + 8192); } while (0)
#define PG8_LDA(dst, b, h) do { if constexpr (Epi::FP8) { _Pragma("unroll") for (int m = 0; m < 4; ++m) { const u32x4 x_ = *(const LAS u32x4*)(lds + PG8_SA(b, h) + aoff8a + m * 2048), y_ = *(const LAS u32x4*)(lds + PG8_SA(b, h) + aoff8b + m * 2048); \
            dst##8[m] = (v8i_t){(int)x_.x, (int)x_.y, (int)x_.z, (int)x_.w, (int)y_.x, (int)y_.y, (int)y_.z, (int)y_.w}; } } \
        else { _Pragma("unroll") for (int m = 0; m < 4; ++m) _Pragma("unroll") for (int k = 0; k < 2; ++k) dst[m][k] = *(const LAS bf16x8*)(lds + PG8_SA(b, h) + aoff + m * 2048 + k * 1024); } } while (0)
#define PG8_LDB(dst, b, h) do { if constexpr (Epi::FP8) { _Pragma("unroll") for (int n = 0; n < 2; ++n) { const u32x4 x_ = *(const LAS u32x4*)(lds + PG8_SB(b, h) + boff8a + n * 2048), y_ = *(const LAS u32x4*)(lds + PG8_SB(b, h) + boff8b + n * 2048); \
            dst##8[n] = (v8i_t){(int)x_.x, (int)x_.y, (int)x_.z, (int)x_.w, (int)y_.x, (int)y_.y, (int)y_.z, (int)y_.w}; } } \
        else { _Pragma("unroll") for (int n = 0; n < 2; ++n) _Pragma("unroll") for (int k = 0; k < 2; ++k) dst[n][k] = *(const LAS bf16x8*)(lds + PG8_SB(b, h) + boff + n * 2048 + k * 1024); } } while (0)
#define PG8_MMA(ai, bj, At, Bt) do { __builtin_amdgcn_s_setprio(1); if constexpr (Epi::FP8) { _Pragma("unroll") for (int m = 0; m < 4; ++m) _Pragma("unroll") for (int n = 0; n < 2; ++n) \
            acc[ai][bj][m][n] = __builtin_amdgcn_mfma_scale_f32_16x16x128_f8f6f4(Bt##8[n], At##8[m], acc[ai][bj][m][n], 0, 0, 0, 0x7f7f7f7f, 0, 0x7f7f7f7f); } \
        else { _Pragma("unroll") for (int m = 0; m < 4; ++m) _Pragma("unroll") for (int n = 0; n < 2; ++n) _Pragma("unroll") for (int k = 0; k < 2; ++k) \
            acc[ai][bj][m][n] = __builtin_amdgcn_mfma_f32_16x16x32_bf16(Bt[n][k], At[m][k], acc[ai][bj][m][n], 0, 0, 0); } __builtin_amdgcn_s_setprio(0); } while (0)
#define PG8_WAIT_V(n) asm volatile("s_waitcnt vmcnt(" #n ")" ::: "memory")
#define PG8_WAIT_L(n) asm volatile("s_waitcnt lgkmcnt(" #n ")" ::: "memory")
#define PG8_BAR __builtin_amdgcn_s_barrier()
#define PG8_SCHED __builtin_amdgcn_sched_barrier(0)
    Unit cur, nxt; int ui = 0;
    if (!S.next(0, cur)) return;
    f32x4 acc[2][2][4][2];
    float zf = 0.f; asm volatile("" : "+v"(zf));
#pragma unroll
    for (int a = 0; a < 2; ++a)
#pragma unroll
        for (int b = 0; b < 2; ++b)
#pragma unroll
            for (int m = 0; m < 4; ++m)
#pragma unroll
                for (int n = 0; n < 2; ++n) acc[a][b][m][n] = (f32x4){zf, zf, zf, zf};
    bf16x8 At[4][2], B0[2][2], B1[2][2]; v8i_t At8[4], B08[2], B18[2];
    unsigned va00, va01, va10, va11; size_t cAb, hstepA;
    if constexpr (Sched::GATHER) { va00 = S.arow(cur, R0) + C0 * 2; va01 = S.arow(cur, R1) + C1 * 2; va10 = S.arow(cur, HALF + R0) + C0 * 2; va11 = S.arow(cur, HALF + R1) + C1 * 2; cAb = 0; hstepA = 0; }
    else { const unsigned l2 = S.lda2(); va00 = (unsigned)R0 * l2 + C0 * 2; va01 = (unsigned)R1 * l2 + C1 * 2; va10 = va00; va11 = va01; cAb = S.abase(cur); hstepA = (size_t)HALF * l2; }
    const char* cB = S.bbase(cur);
    PG8_STAGE_B(PG8_SB(0, 0), cB); PG8_STAGE_B(PG8_SB(0, 1), cB + hstepB); PG8_STAGE_A0(PG8_SA(0, 0), cAb, 0); PG8_STAGE_A1(PG8_SA(0, 1), cAb, 0);
    if (wr == 1) PG8_BAR;
    PG8_WAIT_V(2); PG8_BAR;
    PG8_STAGE_B(PG8_SB(1, 0), cB + kstep); PG8_STAGE_A0(PG8_SA(1, 0), cAb, kstep); PG8_STAGE_B(PG8_SB(1, 1), cB + hstepB + kstep);
    PG8_WAIT_V(6); PG8_BAR;
    for (;;) {
        const bool has_next = S.next(ui + 1, nxt);
        const char* nB = cB; size_t nAb = cAb;
        if (has_next) { nB = S.bbase(nxt); if constexpr (!Sched::GATHER) nAb = S.abase(nxt); }
        for (int t = 0; t < nt; t += 2) {
            const bool last = (t == nt - 2);
            const size_t k1 = (size_t)(t + 1) * kstep;
            const size_t k2 = last ? 0 : (size_t)(t + 2) * kstep, k3 = k2 + kstep;
            const size_t ab2 = last ? nAb : cAb;
            const char* b2 = last ? nB : cB + k2; const char* b3 = b2 + kstep;
            PG8_LDB(B0, 0, 0); PG8_LDB(B1, 0, 1); PG8_SCHED; PG8_LDA(At, 0, 0); PG8_STAGE_A1(PG8_SA(1, 1), cAb, k1);
            if constexpr (Sched::GATHER) { if (last && has_next) {
                va00 = S.arow(nxt, R0) + C0 * 2; va01 = S.arow(nxt, R1) + C1 * 2; va10 = S.arow(nxt, HALF + R0) + C0 * 2; va11 = S.arow(nxt, HALF + R1) + C1 * 2; } }
            PG8_WAIT_V(8); PG8_WAIT_L(0); PG8_BAR; PG8_MMA(0, 0, At, B0); PG8_MMA(0, 1, At, B1); PG8_BAR; PG8_SCHED;
            PG8_LDA(At, 0, 1); PG8_STAGE_B(PG8_SB(0, 0), b2); PG8_STAGE_B(PG8_SB(0, 1), b2 + hstepB); PG8_STAGE_A0(PG8_SA(0, 0), ab2, k2);
            PG8_WAIT_V(8); PG8_WAIT_L(0); PG8_BAR; PG8_MMA(1, 0, At, B0); PG8_MMA(1, 1, At, B1); PG8_BAR; PG8_SCHED;
            PG8_LDB(B0, 1, 0); PG8_LDB(B1, 1, 1); PG8_SCHED; PG8_LDA(At, 1, 0); PG8_STAGE_A1(PG8_SA(0, 1), ab2, k2);
            PG8_WAIT_V(8); PG8_WAIT_L(0); PG8_BAR; PG8_MMA(0, 0, At, B0); PG8_MMA(0, 1, At, B1); PG8_BAR; PG8_SCHED;
            PG8_LDA(At, 1, 1); PG8_STAGE_B(PG8_SB(1, 0), b3); PG8_STAGE_B(PG8_SB(1, 1), b3 + hstepB); PG8_STAGE_A0(PG8_SA(1, 0), ab2, k3);
            PG8_WAIT_V(8); PG8_WAIT_L(0); PG8_BAR; PG8_MMA(1, 0, At, B0); PG8_MMA(1, 1, At, B1); PG8_BAR; PG8_SCHED;
        }
        if (wr == 0) PG8_BAR;
        E(acc, cur, wr, wc, fr, fq);
        if (!has_next) break;
        zf = 0.f; asm volatile("" : "+v"(zf));
#pragma unroll
        for (int a = 0; a < 2; ++a)
#pragma unroll
            for (int b = 0; b < 2; ++b)
#pragma unroll
                for (int m = 0; m < 4; ++m)
#pragma unroll
                    for (int n = 0; n < 2; ++n) acc[a][b][m][n] = (f32x4){zf, zf, zf, zf};
        cur = nxt; cB = nB; cAb = nAb; ++ui;
        if (wr == 1) PG8_BAR;
    }
    PG8_WAIT_V(0);
    PG8_BAR;
#undef PG8_SA
#undef PG8_SB
#undef PG8_GL
#undef PG8_STAGE_A0
#undef PG8_STAGE_A1
#undef PG8_STAGE_B
#undef PG8_LDA
#undef PG8_LDB
#undef PG8_MMA
#undef PG8_WAIT_V
#undef PG8_WAIT_L
#undef PG8_BAR
#undef PG8_SCHED
}
}

#define XB_TMO      128
#define XB_XCNT(j)  (256  + 64 * (j))
#define XB_XSUB(j)  (1280 + 64 * (j))
#define XB_XGEN(j)  (2304 + 64 * (j))
#define XB_TOP      3328
#define XB_TOPGEN   3392
#define XCD_BAR_WORDS 3456
#define XB_SPIN_CAP (1u << 18)
__device__ __forceinline__ unsigned xb_ld(unsigned* p)              { return __hip_atomic_load(p, __ATOMIC_RELAXED, __HIP_MEMORY_SCOPE_AGENT); }
__device__ __forceinline__ unsigned xb_add(unsigned* p, unsigned v) { return __hip_atomic_fetch_add(p, v, __ATOMIC_RELAXED, __HIP_MEMORY_SCOPE_AGENT); }
__device__ __forceinline__ unsigned xb_xcc_id() { return (unsigned)__builtin_amdgcn_s_getreg((3 << 11) | 20) & 0xFu; }
#define XB_SPIN(cond, bar) do { unsigned _sp = 0; while (cond) { __builtin_amdgcn_s_sleep(1); \
    if ((++_sp & 255u) == 0u) { if (xb_ld(&(bar)[XB_TMO])) break; if (_sp > XB_SPIN_CAP) { atomicAdd(&(bar)[XB_TMO], 1u); break; } } } } while (0)
struct XcdBarrier { unsigned* bar; unsigned x; volatile LAS unsigned* st; };
__device__ __forceinline__ XcdBarrier xcd_barrier_post(unsigned* bar, volatile LAS unsigned* st) {
    XcdBarrier b; b.bar = bar; b.x = xb_xcc_id(); b.st = st;
    if (threadIdx.x == 0) (void)xb_add(&bar[XB_XCNT(b.x)], 1u);
    return b;
}
__device__ __forceinline__ void xcd_barrier_complete(unsigned* bar, unsigned x, unsigned& nloc, unsigned& nx) {
    const unsigned G = gridDim.x * gridDim.y * gridDim.z;
    unsigned sum, cnt, mine, sp = 0u;
    for (;;) {
        sum = 0u; cnt = 0u; mine = 0u;
#pragma unroll
        for (unsigned j = 0; j < 16; ++j) { const unsigned c = xb_ld(&bar[XB_XCNT(j)]); sum += c; cnt += (c > 0u) ? 1u : 0u; mine = (j == x) ? c : mine; }
        if (sum == G) break;
        __builtin_amdgcn_s_sleep(1);
        if ((++sp & 255u) == 0u) { if (xb_ld(&bar[XB_TMO])) break; if (sp > XB_SPIN_CAP) { atomicAdd(&bar[XB_TMO], 1u); break; } }
    }
    nloc = mine > 0u ? mine : 1u; nx = cnt > 0u ? cnt : 1u;
}
__device__ __forceinline__ void xcd_barrier(const XcdBarrier& b, unsigned* bar) {
    asm volatile("s_waitcnt vmcnt(0)" ::: "memory");
    __syncthreads();
    if (threadIdx.x == 0) {
        __builtin_amdgcn_s_waitcnt(0);
        unsigned nloc = b.st[0], nx = b.st[1];
        if (nloc == 0u) { xcd_barrier_complete(bar, b.x, nloc, nx); b.st[0] = nloc; b.st[1] = nx; }
        const unsigned old = xb_add(&bar[XB_XSUB(b.x)], 1u);
        const unsigned gen = old / nloc;
        if (old + 1u == (gen + 1u) * nloc) {
            __builtin_amdgcn_fence(__ATOMIC_RELEASE, "agent");
            asm volatile("s_waitcnt vmcnt(0)" ::: "memory");
            const unsigned og = xb_add(&bar[XB_TOP], 1u);
            const unsigned tg = og / nx;
            if (og + 1u == (tg + 1u) * nx) xb_add(&bar[XB_TOPGEN], 1u);
            else XB_SPIN(xb_ld(&bar[XB_TOPGEN]) == tg, bar);
            __builtin_amdgcn_fence(__ATOMIC_ACQUIRE, "agent");
            xb_add(&bar[XB_XGEN(b.x)], 1u);
            asm volatile("s_waitcnt vmcnt(0)" ::: "memory");
        } else {
            XB_SPIN(xb_ld(&bar[XB_XGEN(b.x)]) == gen, bar);
            __builtin_amdgcn_fence(__ATOMIC_ACQUIRE, "agent");
            asm volatile("s_waitcnt vmcnt(0)" ::: "memory");
        }
    }
    __syncthreads();
}

struct Args { const float* in[29]; float* out; unsigned char* ws; int ph_lo, ph_hi; };
static_assert(sizeof(Args) == 29 * 8 + 8 + 8 + 8, "Args has no padding");
enum { I_X = 0, I_POS, I_ATTN_NORM, I_W_IN, I_Q_NORM, I_W_UQ, I_KV_NORM, I_W_UKV, I_CONV_W, I_GMLP_LN, I_GMLP_WS, I_GMLP_BS,
       I_PE_K, I_W1_K, I_W2_K, I_PE_V, I_W1_V, I_W2_V, I_GROUP_NORM, I_W_O, I_FFN_NORM, I_DW_GATE, I_DW_UP, I_DW_DOWN,
       I_ROUTER, I_MW_GATE, I_MW_UP, I_MW_DOWN, I_FINAL_NORM };

typedef GAS const float* __attribute__((address_space(4))) const volatile* kargtab_t;
__device__ __forceinline__ const float* argp(int i) { kargtab_t p = (kargtab_t)__builtin_amdgcn_kernarg_segment_ptr(); GAS const float* g = p[i]; return (const float*)g; }

struct Ctx {
    LAS unsigned char* lds;
    GAS unsigned char* ws;
    int tid, lane, wave, G, bid;
};
__device__ __forceinline__ Ctx fresh(const Ctx& c0) { Ctx c = c0; asm volatile("" : "+v"(c.tid)); asm volatile("" : "+s"(c.ws)); asm volatile("" : "+s"(c.lds)); c.lane = c.tid & 63; return c; }

enum { K_WIN = 0, K_UQ, K_UKV, K_ID, K_GATE, K_UP };
__device__ __forceinline__ int map_col(int kind, int j, float& scale) {
    scale = 1.0f;
    switch (kind) {
    case K_WIN:
        if (j < 384) return j;
        if (j < 416) { const int i = j - 384; return C_KR + (i < 16 ? 2 * i : 2 * (i - 16) + 1); }
        if (j < 672) return C_CB + (j - 416);
        if (j < 928) return C_CC + (j - 672);
        if (j < 1184) return C_CHV + (j - 928);
        if (j < 1440) return C_GU + (j - 1184);
        if (j < 1696) return C_GV + (j - 1440);
        if (j < 1952) { scale = 0.125f * LOG2E; return C_NQ + (j - 1696); }
        if (j < 2016) return C_NKC + (j - 1952);
        if (j < 2080) return C_NVC + (j - 2016);
        if (j < 2144) return C_NKS + (j - 2080);
        if (j < 2208) return C_NVS + (j - 2144);
        if (j < 2272) return C_NKW + (j - 2208);
        if (j < 2336) return C_NVW + (j - 2272);
        return C_NG + (j - 2336);
    case K_UQ: {
        const int h = j / 96, x = j % 96; scale = 0.10206207261596575f * LOG2E;
        if (x < 64) return h * 64 + x;
        const int i = x - 64; return 256 + h * 32 + (i < 16 ? 2 * i : 2 * (i - 16) + 1); }
    case K_UKV: {
        const int h = j >> 7, x = j & 127;
        return x < 64 ? 512 + h * 64 + x : 768 + h * 64 + (x - 64); }
    case K_GATE: return (j >> 7) * 256 + (j & 127);
    case K_UP:   return (j >> 7) * 256 + 128 + (j & 127);
    default: return j;
    }
}
__device__ __forceinline__ void conv_item(const float* src, int src_ld, int nsrc, const float* gain, bf16* dst, int dst_ld, int kdst0, int kind, int nblk, int item, LAS float* scr, int lane, bool f8 = false) {
    const int kb = item / nblk, nb = item % nblk, k0 = 64 * kb, j0 = 64 * nb;
    const int jr = j0 + 4 * (lane & 15), kr = lane >> 4;
    const int jc = jr < nsrc ? jr : nsrc - 4;
    f32x4 v[16];
#pragma unroll
    for (int i = 0; i < 16; ++i) v[i] = *(const f32x4*)(src + (size_t)(k0 + 4 * i + kr) * src_ld + jc);
    float gv[16];
    if (gain) {
#pragma unroll
        for (int i = 0; i < 16; ++i) gv[i] = gain[k0 + 4 * i + kr];
    } else {
#pragma unroll
        for (int i = 0; i < 16; ++i) gv[i] = 1.0f;
    }
#pragma unroll
    for (int i = 0; i < 16; ++i) { const int kk = 4 * i + kr; const float g = gv[i]; LAS float* p = scr + kk * 65 + 4 * (lane & 15);
        p[0] = v[i][0] * g; p[1] = v[i][1] * g; p[2] = v[i][2] * g; p[3] = v[i][3] * g; }
    LDS_WAIT(); asm volatile("" ::: "memory");
    const int c = lane & 7;
#pragma unroll
    for (int jj = 0; jj < 8; ++jj) { const int n = (lane >> 3) + 8 * jj; const int j = j0 + n;
        if (j < nsrc) { float sc; const int drow = map_col(kind, j, sc); const LAS float* s = scr + (8 * c) * 65 + n;
            if (f8) { sc *= WSC; u32x2 o8; o8.x = pk4f8(s[0 * 65] * sc, s[1 * 65] * sc, s[2 * 65] * sc, s[3 * 65] * sc); o8.y = pk4f8(s[4 * 65] * sc, s[5 * 65] * sc, s[6 * 65] * sc, s[7 * 65] * sc);
                *(u32x2*)((unsigned char*)dst + (size_t)drow * dst_ld + kdst0 + k0 + 8 * c) = o8; continue; }
            u32x4 o; o.x = pk2(s[0 * 65] * sc, s[1 * 65] * sc); o.y = pk2(s[2 * 65] * sc, s[3 * 65] * sc); o.z = pk2(s[4 * 65] * sc, s[5 * 65] * sc); o.w = pk2(s[6 * 65] * sc, s[7 * 65] * sc);
            *(u32x4*)(dst + (size_t)drow * dst_ld + kdst0 + k0 + 8 * c) = o; } }
    LDS_WAIT(); asm volatile("" ::: "memory");
}

__device__ __forceinline__ void zero_rect(bf16* dst, int ld, int r0, int r1, int c0, int c1, int gtid, int nthr) {
    const int nch = (c1 - c0) >> 3, total = (r1 - r0) * nch;
    for (int idx = gtid; idx < total; idx += nthr) { const int r = idx / nch, c = idx % nch; unsigned z = 0u; asm volatile("" : "+v"(z)); *(u32x4*)(dst + (size_t)(r0 + r) * ld + c0 + 8 * c) = (u32x4){z, z, z, z}; }
}

__device__ __forceinline__ void convert_weights(const Args& a, const Ctx& c0, int l) {
    const Ctx c = fresh(c0);
    LAS float* scr = (LAS float*)(c.lds + c.wave * 16640);
    const int gw = c.bid * NWAVES + c.wave, NGW = c.G * NWAVES, gtid = c.bid * (NWAVES * 64) + c.tid, NT = c.G * NWAVES * 64;
    GAS unsigned char* ws = c.ws;
    const int nexp = (l & 1) ? NE : 1;
    constexpr int I_WIN = 37 * 16, I_UQ = 6 * 4, I_UKV = 8 * 2, I_WOI = 16 * 16, I_W1 = 4 * 32, I_W2 = 1 * 4, I_GU = 56 * 16, I_DN = 16 * 56;
    const int n_fixed = I_WIN + I_UQ + I_UKV + I_WOI + 2 * I_W1 + 2 * I_W2;
    const int n_total = n_fixed + nexp * (2 * I_GU + I_DN);
    const float* wg_src = (l & 1) ? argp(I_MW_GATE) + (size_t)(l >> 1) * NE * DM * FF : argp(I_DW_GATE) + (size_t)(l >> 1) * DM * FF;
    const float* wu_src = (l & 1) ? argp(I_MW_UP) + (size_t)(l >> 1) * NE * DM * FF : argp(I_DW_UP) + (size_t)(l >> 1) * DM * FF;
    const float* wd_src = (l & 1) ? argp(I_MW_DOWN) + (size_t)(l >> 1) * NE * DM * FF : argp(I_DW_DOWN) + (size_t)(l >> 1) * DM * FF;
    for (int it = gw; it < n_total; it += NGW) {
        int r = it;
        if (r < I_WIN) { conv_item(argp(I_W_IN) + (size_t)l * DM * DIN, DIN, DIN, argp(I_ATTN_NORM) + l * DM, (bf16*)(ws + WS_WIN), DM, 0, K_WIN, 37, r, scr, c.lane); continue; } r -= I_WIN;
        if (r < I_UQ) { conv_item(argp(I_W_UQ) + (size_t)l * 256 * 384, 384, 384, argp(I_Q_NORM) + l * 256, (bf16*)(ws + WS_WQKV), 384, 0, K_UQ, 6, r, scr, c.lane); continue; } r -= I_UQ;
        if (r < I_UKV) { conv_item(argp(I_W_UKV) + (size_t)l * 128 * 512, 512, 512, argp(I_KV_NORM) + l * 128, (bf16*)(ws + WS_WQKV), 384, 256, K_UKV, 8, r, scr, c.lane); continue; } r -= I_UKV;
        if (r < I_WOI) { conv_item(argp(I_W_O) + (size_t)l * DM * DM, DM, DM, argp(I_GROUP_NORM) + l * DM, (bf16*)(ws + WS_WO), DM, 0, K_ID, 16, r, scr, c.lane); continue; } r -= I_WOI;
        if (r < I_W1) { conv_item(argp(I_W1_K) + (size_t)l * 2048 * 256, 256, 256, nullptr, (bf16*)(ws + WS_W1T), 2048, 0, K_ID, 4, r, scr, c.lane); continue; } r -= I_W1;
        if (r < I_W1) { conv_item(argp(I_W1_V) + (size_t)l * 2048 * 256, 256, 256, nullptr, (bf16*)(ws + WS_W1T) + 256 * 2048, 2048, 0, K_ID, 4, r, scr, c.lane); continue; } r -= I_W1;
        if (r < I_W2) { conv_item(argp(I_W2_K) + (size_t)l * 256 * 64, 64, 64, nullptr, (bf16*)(ws + WS_W2T), 256, 0, K_ID, 1, r, scr, c.lane); continue; } r -= I_W2;
        if (r < I_W2) { conv_item(argp(I_W2_V) + (size_t)l * 256 * 64, 64, 64, nullptr, (bf16*)(ws + WS_W2T) + 64 * 256, 256, 0, K_ID, 1, r, scr, c.lane); continue; } r -= I_W2;
        const int e = r / (2 * I_GU + I_DN); r -= e * (2 * I_GU + I_DN);
        if (r < I_GU) { conv_item(wg_src + (size_t)e * DM * FF, FF, FF, argp(I_FFN_NORM) + l * DM, (bf16*)(ws + WS_WGU + (size_t)e * 2 * FF * DM), DM, 0, K_GATE, 56, r, scr, c.lane, true); continue; } r -= I_GU;
        if (r < I_GU) { conv_item(wu_src + (size_t)e * DM * FF, FF, FF, argp(I_FFN_NORM) + l * DM, (bf16*)(ws + WS_WGU + (size_t)e * 2 * FF * DM), DM, 0, K_UP, 56, r, scr, c.lane, true); continue; } r -= I_GU;
        conv_item(wd_src + (size_t)e * FF * DM, DM, DM, nullptr, (bf16*)(ws + WS_WD + (size_t)e * DM * FF), FF, 0, K_ID, 16, r, scr, c.lane, true);
    }
    zero_rect((bf16*)(ws + WS_WIN), DM, DIN, PP, 0, DM, gtid, NT);
    zero_rect((bf16*)(ws + WS_WQKV), 384, 0, 384, 256, 384, gtid, NT);
    zero_rect((bf16*)(ws + WS_WQKV), 384, 384, 512, 0, 384, gtid, NT);
    zero_rect((bf16*)(ws + WS_WQKV), 384, 512, 1024, 0, 256, gtid, NT);
    { const float* wsrc = argp(I_GMLP_WS) + (size_t)l * 4 * 128 * 128; unsigned* d = (unsigned*)(ws + WS_WGM);
      for (int idx = gtid; idx < 4 * 128 * 64; idx += NT) { const int j = (idx & 63) * 2, i = (idx >> 6) & 127;
          const float v0 = (j <= i) ? wsrc[2 * idx] : 0.f, v1 = (j + 1 <= i) ? wsrc[2 * idx + 1] : 0.f; d[idx] = pk2(v0, v1); } }
    for (int o = gw; o < 512; o += NGW) { const int kv = o >> 8, cc = o & 255; const float* pe = argp(kv ? I_PE_V : I_PE_K) + (size_t)l * 2048; const float* w1 = argp(kv ? I_W1_V : I_W1_K) + (size_t)l * 2048 * 256;
        float sacc = 0.f;
#pragma unroll 8
        for (int i = 0; i < 32; ++i) { const int k = i * 64 + c.lane; sacc += pe[k] * w1[(size_t)k * 256 + cc]; }
        sacc = wave_sum(sacc); if (c.lane == 0) ((float*)(ws + WS_BPE))[o] = sacc; }
    if (l == 0) { const int* pos = (const int*)argp(I_POS); f32x2_t* cs = (f32x2_t*)(ws + WS_CS);
        for (int idx = gtid; idx < T * 16; idx += NT) { const int tk = idx >> 4, i = idx & 15;
            const float inv = __builtin_amdgcn_exp2f(-(float)i * (13.287712379549449f / 16.0f));
            const float ang = (float)pos[tk] * inv; float rev = ang * 0.15915494309189535f; rev -= floorf(rev);
            cs[idx] = (f32x2_t){__builtin_amdgcn_cosf(rev), __builtin_amdgcn_sinf(rev)}; } }
}

template <int MODE>
__device__ __forceinline__ void norm_pass(const Args& a, const Ctx& c0, const float* hsrc, const bf16* add0, const bf16* add1, bool write_h, int l) {
    const Ctx c = fresh(c0);
    const int gw = c.bid * NWAVES + c.wave, NGW = c.G * NWAVES, lane = c.lane;
    float* hout = a.out; bf16* XN = (bf16*)(c.ws + WS_XN); bf16* Hb = (bf16*)(c.ws + WS_H);
    constexpr int R = 4;
    for (int row0 = gw; row0 < T; row0 += R * NGW) {
        f32x4 v[R][4]; u32x2 a0[R][4], a1[R][4];
#pragma unroll
        for (int r = 0; r < R; ++r) { const int row = row0 + r * NGW; const size_t ro = (size_t)(row < T ? row : 0) * DM;
#pragma unroll
            for (int j = 0; j < 4; ++j) { a0[r][j] = (u32x2){0u, 0u}; a1[r][j] = (u32x2){0u, 0u}; } }
        if (hsrc) {
#pragma unroll
            for (int r = 0; r < R; ++r) { const int row = row0 + r * NGW; const size_t ro = (size_t)(row < T ? row : 0) * DM;
#pragma unroll
                for (int j = 0; j < 4; ++j) v[r][j] = *(const f32x4*)(hsrc + ro + 4 * lane + 256 * j); }
        } else {
#pragma unroll
            for (int r = 0; r < R; ++r) { const int row = row0 + r * NGW; const size_t ro = (size_t)(row < T ? row : 0) * DM;
#pragma unroll
                for (int j = 0; j < 4; ++j) { const u32x2 hw = *(const u32x2*)(Hb + ro + 4 * lane + 256 * j); v[r][j] = (f32x4){bflo(hw.x), bfhi(hw.x), bflo(hw.y), bfhi(hw.y)}; } }
        }
        if (add0) {
#pragma unroll
            for (int r = 0; r < R; ++r) { const int row = row0 + r * NGW; const size_t ro = (size_t)(row < T ? row : 0) * DM;
#pragma unroll
                for (int j = 0; j < 4; ++j) a0[r][j] = *(const u32x2*)(add0 + ro + 4 * lane + 256 * j); } }
        if (add1) {
#pragma unroll
            for (int r = 0; r < R; ++r) { const int row = row0 + r * NGW; const size_t ro = (size_t)(row < T ? row : 0) * DM;
#pragma unroll
                for (int j = 0; j < 4; ++j) a1[r][j] = *(const u32x2*)(add1 + ro + 4 * lane + 256 * j); } }
#pragma unroll
        for (int r = 0; r < R; ++r) { const int row = row0 + r * NGW; if (row >= T) break; const size_t ro = (size_t)row * DM;
            float ss = 0.f;
#pragma unroll
            for (int j = 0; j < 4; ++j) { f32x4& x = v[r][j];
                x[0] += bflo(a0[r][j].x) + bflo(a1[r][j].x); x[1] += bfhi(a0[r][j].x) + bfhi(a1[r][j].x); x[2] += bflo(a0[r][j].y) + bflo(a1[r][j].y); x[3] += bfhi(a0[r][j].y) + bfhi(a1[r][j].y);
                ss += (x[0] * x[0] + x[1] * x[1]) + (x[2] * x[2] + x[3] * x[3]); }
            const float rstd = 1.0f / sqrtf(wave_sum(ss) * (1.0f / DM) + EPS);
            if (MODE == 2) {
                const float* g = argp(I_FINAL_NORM);
#pragma unroll
                for (int j = 0; j < 4; ++j) { const f32x4 gv = *(const f32x4*)(g + 4 * lane + 256 * j); *(f32x4*)(hout + ro + 4 * lane + 256 * j) = v[r][j] * rstd * gv; }
            } else {
                if (write_h) {
#pragma unroll
                    for (int j = 0; j < 4; ++j) { u32x2 hw; hw.x = pk2(v[r][j][0], v[r][j][1]); hw.y = pk2(v[r][j][2], v[r][j][3]); *(u32x2*)(Hb + ro + 4 * lane + 256 * j) = hw; }
                }
#pragma unroll
                for (int j = 0; j < 4; ++j) {
                    if (MODE == 1) *(unsigned*)((unsigned char*)(c.ws + WS_D1) + ro + 4 * lane + 256 * j) = pk4f8(v[r][j][0] * rstd, v[r][j][1] * rstd, v[r][j][2] * rstd, v[r][j][3] * rstd);
                    else { u32x2 w; w.x = pk2(v[r][j][0] * rstd, v[r][j][1] * rstd); w.y = pk2(v[r][j][2] * rstd, v[r][j][3] * rstd); *(u32x2*)(XN + ro + 4 * lane + 256 * j) = w; } }
                if (MODE == 1 && (l & 1)) {
                    const float* g = argp(I_FFN_NORM) + l * DM; const float* wr = argp(I_ROUTER) + (size_t)(l >> 1) * DM * NE;
                    float lg[8];
#pragma unroll
                    for (int e = 0; e < 8; ++e) lg[e] = 0.f;
#pragma unroll
                    for (int j = 0; j < 4; ++j) { const f32x4 gv = *(const f32x4*)(g + 4 * lane + 256 * j);
#pragma unroll
                        for (int i = 0; i < 4; ++i) { const float hn = v[r][j][i] * rstd * gv[i]; const int k = 4 * lane + 256 * j + i;
                            const f32x4 w0 = *(const f32x4*)(wr + (size_t)k * 8), w1 = *(const f32x4*)(wr + (size_t)k * 8 + 4);
                            lg[0] += hn * w0.x; lg[1] += hn * w0.y; lg[2] += hn * w0.z; lg[3] += hn * w0.w; lg[4] += hn * w1.x; lg[5] += hn * w1.y; lg[6] += hn * w1.z; lg[7] += hn * w1.w; } }
#pragma unroll
                    for (int e = 0; e < 8; ++e) lg[e] = wave_sum(lg[e]);
                    int i0 = 0; float l0 = lg[0];
#pragma unroll
                    for (int e = 1; e < 8; ++e) if (lg[e] > l0) { l0 = lg[e]; i0 = e; }
                    int i1 = -1; float l1 = -3.0e38f;
#pragma unroll
                    for (int e = 0; e < 8; ++e) if (e != i0 && lg[e] > l1) { l1 = lg[e]; i1 = e; }
                    const float w0 = 1.0f / (1.0f + __expf(l1 - l0)), w1 = 1.0f - w0;
                    if (lane == 0) {
                        unsigned* cnt = (unsigned*)(c.ws + WS_CTL) + CW_CNT + (l >> 1) * 8 * 64;
                        unsigned* list = (unsigned*)(c.ws + WS_LIST) + (size_t)(l >> 1) * NE * T; float* wl = (float*)(c.ws + WS_WL) + (size_t)(l >> 1) * NE * T;
                        const unsigned p0 = __hip_atomic_fetch_add(cnt + 64 * i0, 1u, __ATOMIC_RELAXED, __HIP_MEMORY_SCOPE_AGENT);
                        list[(size_t)i0 * T + p0] = (unsigned)row * 2u; wl[(size_t)i0 * T + p0] = w0;
                        const unsigned p1 = __hip_atomic_fetch_add(cnt + 64 * i1, 1u, __ATOMIC_RELAXED, __HIP_MEMORY_SCOPE_AGENT);
                        list[(size_t)i1 * T + p1] = (unsigned)row * 2u + 1u; wl[(size_t)i1 * T + p1] = w1;
                    }
                }
            }
        }
    }
}

typedef pg8::Unit Unit;
struct SchedPlain {
    pg8::RectOrder R; unsigned lda2_; const char* B; size_t btile;
    __device__ __forceinline__ bool next(int i, Unit& u) const { u.e = 0; u.aux = 0; u.ne = 0; return R.get(i, u.pm, u.pn); }
    static constexpr bool GATHER = false;
    __device__ __forceinline__ size_t abase(const Unit& u) const { return (size_t)u.pm * 256 * lda2_; }
    __device__ __forceinline__ unsigned lda2() const { return lda2_; }
    __device__ __forceinline__ const char* bbase(const Unit& u) const { return B + (size_t)u.pn * btile; }
};
struct MoeMap {
    int pre1, pre2, pre3, pre4, pre5, pre6, pre7, pre8;
    int c0, c1, c2, c3, c4, c5, c6, c7;
    const unsigned* list; const float* wl;
    __device__ __forceinline__ void locate(int pm, int& e, int& lt, int& ne) const {
        e = 0; lt = pm; ne = c0;
        if (pm >= pre1) { e = 1; lt = pm - pre1; ne = c1; } if (pm >= pre2) { e = 2; lt = pm - pre2; ne = c2; } if (pm >= pre3) { e = 3; lt = pm - pre3; ne = c3; }
        if (pm >= pre4) { e = 4; lt = pm - pre4; ne = c4; } if (pm >= pre5) { e = 5; lt = pm - pre5; ne = c5; } if (pm >= pre6) { e = 6; lt = pm - pre6; ne = c6; }
        if (pm >= pre7) { e = 7; lt = pm - pre7; ne = c7; }
    }
};
__device__ __forceinline__ MoeMap make_moemap(const Ctx& c, int l) {
    MoeMap m;
    if (l & 1) {
        unsigned* cnt = (unsigned*)(c.ws + WS_CTL) + CW_CNT + (l >> 1) * 8 * 64;
        int n[8];
#pragma unroll
        for (int e = 0; e < 8; ++e) n[e] = __builtin_amdgcn_readfirstlane((int)__hip_atomic_load(cnt + 64 * e, __ATOMIC_RELAXED, __HIP_MEMORY_SCOPE_AGENT));
        m.c0 = n[0]; m.c1 = n[1]; m.c2 = n[2]; m.c3 = n[3]; m.c4 = n[4]; m.c5 = n[5]; m.c6 = n[6]; m.c7 = n[7];
        m.pre1 = (n[0] + 255) >> 8; m.pre2 = m.pre1 + ((n[1] + 255) >> 8); m.pre3 = m.pre2 + ((n[2] + 255) >> 8); m.pre4 = m.pre3 + ((n[3] + 255) >> 8);
        m.pre5 = m.pre4 + ((n[4] + 255) >> 8); m.pre6 = m.pre5 + ((n[5] + 255) >> 8); m.pre7 = m.pre6 + ((n[6] + 255) >> 8); m.pre8 = m.pre7 + ((n[7] + 255) >> 8);
        m.list = (const unsigned*)(c.ws + WS_LIST) + (size_t)(l >> 1) * NE * T; m.wl = (const float*)(c.ws + WS_WL) + (size_t)(l >> 1) * NE * T;
    } else {
        m.c0 = T; m.c1 = m.c2 = m.c3 = m.c4 = m.c5 = m.c6 = m.c7 = 0;
        m.pre1 = m.pre2 = m.pre3 = m.pre4 = m.pre5 = m.pre6 = m.pre7 = m.pre8 = T / 256;
        m.list = nullptr; m.wl = nullptr;
    }
    return m;
}
struct SchedGateUp {
    static constexpr bool GATHER = true;
    pg8::RectOrder R; MoeMap M; int t0; const char* B;
    int nd;
    __device__ __forceinline__ bool next(int i, Unit& u) const {
        long L;
        if (nd == 0) L = (long)i * R.G + R.c;
        else if (R.c < nd) { if (i >= 4) return false; L = (long)(i + 3) * R.G + R.c; }
        else { if (i < 7) L = (long)i * R.G + R.c; else if (i == 7) { const int o = R.c - nd; if (o >= 3 * nd) return false; L = (long)(o / nd) * R.G + (o % nd); } else return false; }
        int pm, pn; if (!R.getL(L, pm, pn)) return false; u.pm = t0 + pm; u.pn = pn; M.locate(u.pm, u.e, u.aux, u.ne); return true; }
    __device__ __forceinline__ unsigned arow(const Unit& u, int r) const {
        const int ne = u.ne; int idx = u.aux * 256 + r; idx = idx < ne ? idx : ne - 1;
        const unsigned tok = M.list ? (M.list[(size_t)u.e * T + idx] >> 1) : (unsigned)idx;
        return tok * (unsigned)DM; }
    __device__ __forceinline__ const char* bbase(const Unit& u) const { return B + ((size_t)u.e * 2 * FF + (size_t)u.pn * 256) * DM; }
};
struct SchedDown {
    pg8::RectOrder R; MoeMap M; int t0; const char* B;
    __device__ __forceinline__ bool next(int i, Unit& u) const { int pm, pn; if (!R.get(i, pm, pn)) return false; u.pm = t0 + pm; u.pn = pn; M.locate(u.pm, u.e, u.aux, u.ne); return true; }
    static constexpr bool GATHER = false;
    __device__ __forceinline__ size_t abase(const Unit& u) const { return (size_t)(u.pm - t0) * 256 * FF; }
    __device__ __forceinline__ unsigned lda2() const { return (unsigned)FF; }
    __device__ __forceinline__ const char* bbase(const Unit& u) const { return B + ((size_t)u.e * DM + (size_t)u.pn * 256) * FF; }
};

#define EPI_ARGS const f32x4 (&acc)[2][2][4][2], const Unit& u, int wr, int wc, int fr, int fq
struct EpiInProj {
    static constexpr bool PERM = true, FP8 = false;
    bf16* P; float* ssq; float* sskv;
    __device__ __forceinline__ void operator()(EPI_ARGS) const {
#pragma unroll
        for (int ai = 0; ai < 2; ++ai)
#pragma unroll
            for (int m = 0; m < 4; ++m) {
                const int row = u.pm * 256 + ai * 128 + wr * 64 + m * 16 + fr;
                float s0 = 0.f, s1 = 0.f;
#pragma unroll
                for (int bj = 0; bj < 2; ++bj) { const f32x4 v0 = acc[ai][bj][m][0], v1 = acc[ai][bj][m][1];
                    u32x4 w; w.x = pk2(v0[0], v0[1]); w.y = pk2(v0[2], v0[3]); w.z = pk2(v1[0], v1[1]); w.w = pk2(v1[2], v1[3]);
                    *(u32x4*)(P + (size_t)row * PP + u.pn * 256 + bj * 128 + wc * 32 + 8 * fq) = w;
                    const float s = (v0[0] * v0[0] + v0[1] * v0[1]) + (v0[2] * v0[2] + v0[3] * v0[3]) + (v1[0] * v1[0] + v1[1] * v1[1]) + (v1[2] * v1[2] + v1[3] * v1[3]);
                    if (bj == 0) s0 = s; else s1 = s; }
                if (u.pn == 0) { float s = s0 + s1; s += __shfl_xor(s, 16); s += __shfl_xor(s, 32); if (fq == 0) ssq[row * 4 + wc] = s; }
                else if (u.pn == 1) { float s = s0; s += __shfl_xor(s, 16); s += __shfl_xor(s, 32); if (fq == 0) sskv[row * 4 + wc] = s; }
            }
    }
};
struct EpiQkv {
    static constexpr bool PERM = true, FP8 = false;
    const float* ssq; const float* sskv; const f32x2_t* cs; bf16 *Qn, *Qr, *Kn, *Vt;
    __device__ __forceinline__ float rstd_of(const float* ss, int row, float invn) const { const f32x4 p = *(const f32x4*)(ss + row * 4); return 1.0f / sqrtf(((p.x + p.y) + (p.z + p.w)) * invn + EPS); }
    __device__ __forceinline__ void operator()(EPI_ARGS) const {
        if (u.pn == 0 || u.pn == 2) {
            bf16* O = u.pn == 0 ? Qn : Kn; const float* ss = u.pn == 0 ? ssq : sskv; const float invn = u.pn == 0 ? (1.0f / 256.0f) : (1.0f / 128.0f);
#pragma unroll
            for (int ai = 0; ai < 2; ++ai)
#pragma unroll
                for (int m = 0; m < 4; ++m) { const int row = u.pm * 256 + ai * 128 + wr * 64 + m * 16 + fr; const float rs = rstd_of(ss, row, invn);
#pragma unroll
                    for (int bj = 0; bj < 2; ++bj) { const f32x4 v0 = acc[ai][bj][m][0] * rs, v1 = acc[ai][bj][m][1] * rs;
                        u32x4 w; w.x = pk2(v0[0], v0[1]); w.y = pk2(v0[2], v0[3]); w.z = pk2(v1[0], v1[1]); w.w = pk2(v1[2], v1[3]);
                        *(u32x4*)(O + (size_t)row * 256 + bj * 128 + wc * 32 + 8 * fq) = w; }
                    asm volatile("" ::: "memory"); }
        } else if (u.pn == 1) {
            const int col = wc * 32 + 8 * fq, i0 = (col & 31) >> 1;
#pragma unroll
            for (int ai = 0; ai < 2; ++ai)
#pragma unroll
                for (int m = 0; m < 4; ++m) { const int row = u.pm * 256 + ai * 128 + wr * 64 + m * 16 + fr; const float rq = rstd_of(ssq, row, 1.0f / 256.0f);
                    const f32x4 ca = *(const f32x4*)(cs + (size_t)row * 16 + i0), cb = *(const f32x4*)(cs + (size_t)row * 16 + i0 + 2);
                    const f32x4 v0 = acc[ai][0][m][0] * rq, v1 = acc[ai][0][m][1] * rq;
                    u32x4 w; w.x = pk2(v0[0] * ca[0] - v0[1] * ca[1], v0[0] * ca[1] + v0[1] * ca[0]); w.y = pk2(v0[2] * ca[2] - v0[3] * ca[3], v0[2] * ca[3] + v0[3] * ca[2]);
                    w.z = pk2(v1[0] * cb[0] - v1[1] * cb[1], v1[0] * cb[1] + v1[1] * cb[0]); w.w = pk2(v1[2] * cb[2] - v1[3] * cb[3], v1[2] * cb[3] + v1[3] * cb[2]);
                    *(u32x4*)(Qr + (size_t)row * 128 + col) = w; asm volatile("" ::: "memory"); }
        } else {
#pragma unroll
            for (int ai = 0; ai < 2; ++ai)
#pragma unroll
                for (int m = 0; m < 4; ++m) { const int row = u.pm * 256 + ai * 128 + wr * 64 + m * 16 + fr; const float rk = rstd_of(sskv, row, 1.0f / 128.0f);
                    const int b = row >> 12, sp = row & 4095;
#pragma unroll
                    for (int bj = 0; bj < 2; ++bj) { const int col = bj * 128 + wc * 32 + 8 * fq; const f32x4 v0 = acc[ai][bj][m][0] * rk, v1 = acc[ai][bj][m][1] * rk;
                        unsigned vo = (unsigned)(((b * 4 + (col >> 6)) * 64 + (col & 63)) * SEQ + sp) * 2u; asm volatile("" : "+v"(vo));
                        char* vb = (char*)Vt + vo;
#pragma unroll
                        for (int i = 0; i < 4; ++i) { *(bf16*)(vb + (size_t)i * SEQ * 2) = (bf16)(pk2(v0[i], 0.f) & 0xffffu); *(bf16*)(vb + (size_t)(4 + i) * SEQ * 2) = (bf16)(pk2(v1[i], 0.f) & 0xffffu); } }
                    asm volatile("" ::: "memory"); }
        }
    }
};
struct EpiBf16Plain {
    static constexpr bool PERM = true, FP8 = false;
    bf16* O; int ldc;
    __device__ __forceinline__ void operator()(EPI_ARGS) const {
#pragma unroll
        for (int ai = 0; ai < 2; ++ai)
#pragma unroll
            for (int m = 0; m < 4; ++m) { const int row = u.pm * 256 + ai * 128 + wr * 64 + m * 16 + fr;
#pragma unroll
                for (int bj = 0; bj < 2; ++bj) { const f32x4 v0 = acc[ai][bj][m][0], v1 = acc[ai][bj][m][1];
                    u32x4 w; w.x = pk2(v0[0], v0[1]); w.y = pk2(v0[2], v0[3]); w.z = pk2(v1[0], v1[1]); w.w = pk2(v1[2], v1[3]);
                    *(u32x4*)(O + (size_t)row * ldc + u.pn * 256 + bj * 128 + wc * 32 + 8 * fq) = w; } }
    }
};
__device__ __forceinline__ void residual_rows(EPI_ARGS, bf16* H, int row_tile0, float sc) {
#pragma unroll
    for (int ai = 0; ai < 2; ++ai)
#pragma unroll
        for (int m = 0; m < 4; ++m) { const int row = row_tile0 + ai * 128 + wr * 64 + m * 16 + fr;
#pragma unroll
            for (int bj = 0; bj < 2; ++bj) { u32x4* hp = (u32x4*)(H + (size_t)row * DM + u.pn * 256 + bj * 128 + wc * 32 + 8 * fq); const u32x4 hw = *hp;
                const f32x4 v0 = acc[ai][bj][m][0] * sc + (f32x4){bflo(hw.x), bfhi(hw.x), bflo(hw.y), bfhi(hw.y)}, v1 = acc[ai][bj][m][1] * sc + (f32x4){bflo(hw.z), bfhi(hw.z), bflo(hw.w), bfhi(hw.w)};
                u32x4 w; w.x = pk2(v0[0], v0[1]); w.y = pk2(v0[2], v0[3]); w.z = pk2(v1[0], v1[1]); w.w = pk2(v1[2], v1[3]); *hp = w; }
            if (m & 1) asm volatile("" ::: "memory"); }
}
struct EpiResidual {
    static constexpr bool PERM = true, FP8 = false;
    bf16* H;
    __device__ __forceinline__ void operator()(EPI_ARGS) const { residual_rows(acc, u, wr, wc, fr, fq, H, u.pm * 256, 1.0f); }
};
struct EpiSwiglu {
    static constexpr bool PERM = true, FP8 = true;
    unsigned char* ACT; int t0;
    __device__ __forceinline__ void operator()(EPI_ARGS) const {
        constexpr float IS = 1.0f / WSC;
#pragma unroll
        for (int ai = 0; ai < 2; ++ai)
#pragma unroll
            for (int m = 0; m < 4; ++m) { const int row = (u.pm - t0) * 256 + ai * 128 + wr * 64 + m * 16 + fr;
                const f32x4 g0 = acc[ai][0][m][0] * IS, g1 = acc[ai][0][m][1] * IS, u0 = acc[ai][1][m][0] * IS, u1 = acc[ai][1][m][1] * IS;
                u32x2 w; w.x = pk4f8(silu_f(g0[0]) * u0[0], silu_f(g0[1]) * u0[1], silu_f(g0[2]) * u0[2], silu_f(g0[3]) * u0[3]);
                w.y = pk4f8(silu_f(g1[0]) * u1[0], silu_f(g1[1]) * u1[1], silu_f(g1[2]) * u1[2], silu_f(g1[3]) * u1[3]);
                *(u32x2*)(ACT + (size_t)row * FF + u.pn * 128 + wc * 32 + 8 * fq) = w; }
    }
};
struct EpiDown {
    static constexpr bool PERM = true, FP8 = true;
    bf16* O2; MoeMap M; bf16* H;
    __device__ __forceinline__ void operator()(EPI_ARGS) const {
        if (!M.list) { residual_rows(acc, u, wr, wc, fr, fq, H, u.pm * 256, 1.0f / WSC); return; }
        const int ne = u.ne;
#pragma unroll
        for (int ai = 0; ai < 2; ++ai)
#pragma unroll
            for (int m = 0; m < 4; ++m) { const int idx = u.aux * 256 + ai * 128 + wr * 64 + m * 16 + fr;
                if (idx < ne) {
                    unsigned ts = (unsigned)idx * 2u; float w8 = 1.0f / WSC;
                    if (M.list) { ts = M.list[(size_t)u.e * T + idx]; w8 = M.wl[(size_t)u.e * T + idx] * (1.0f / WSC); }
                    bf16* orow = O2 + ((size_t)(ts & 1u) * T + (ts >> 1)) * DM + u.pn * 256 + wc * 32 + 8 * fq;
#pragma unroll
                    for (int bj = 0; bj < 2; ++bj) { const f32x4 v0 = acc[ai][bj][m][0] * w8, v1 = acc[ai][bj][m][1] * w8;
                        u32x4 w; w.x = pk2(v0[0], v0[1]); w.y = pk2(v0[2], v0[3]); w.z = pk2(v1[0], v1[1]); w.w = pk2(v1[2], v1[3]);
                        *(u32x4*)(orow + bj * 128) = w; } } }
    }
};

__device__ __forceinline__ void prep_thin(const Args& a, const Ctx& c0, int l) {
    const Ctx c = fresh(c0);
    const int gw = c.bid * NWAVES + c.wave, NGW = c.G * NWAVES, gtid = c.bid * (NWAVES * 64) + c.tid, NT = c.G * NWAVES * 64, lane = c.lane;
    const bf16* P = (const bf16*)(c.ws + WS_P);
    { const f32x2_t* cs = (const f32x2_t*)(c.ws + WS_CS); unsigned* Kr = (unsigned*)(c.ws + WS_KR);
      for (int idx = gtid; idx < T * 16; idx += NT) { const int tk = idx >> 4, i = idx & 15;
          const unsigned w = *(const unsigned*)(P + (size_t)tk * PP + C_KR + 2 * i); const float x1 = bflo(w), x2 = bfhi(w); const f32x2_t t = cs[idx];
          Kr[idx] = pk2(x1 * t.x - x2 * t.y, x1 * t.y + x2 * t.x); } }
    { LAS bf16* tl = (LAS bf16*)(c.lds + c.wave * 8448);
      for (int it = gw; it < 2 * NB * 64; it += NGW) { const int which = it >> 9, b = (it >> 6) & 7, st = it & 63;
          const bf16* src = P + (size_t)(b * SEQ + st * 64) * PP + (which ? C_NVW : C_NVS);
          bf16* dst = (bf16*)(c.ws + (which ? WS_VTW : WS_VTS)) + (size_t)b * 64 * SEQ + st * 64;
#pragma unroll
          for (int i = 0; i < 8; ++i) { const int tk = i * 8 + (lane >> 3), dc = lane & 7; const u32x4 w = *(const u32x4*)(src + (size_t)tk * PP + 8 * dc);
              LAS unsigned* t4 = (LAS unsigned*)(tl + tk * 66 + 8 * dc); t4[0] = w.x; t4[1] = w.y; t4[2] = w.z; t4[3] = w.w; }
          LDS_WAIT(); asm volatile("" ::: "memory");
#pragma unroll
          for (int tc = 0; tc < 8; ++tc) { unsigned short e[8];
#pragma unroll
              for (int k = 0; k < 8; ++k) e[k] = tl[(8 * tc + k) * 66 + lane];
              u32x4 o; o.x = e[0] | ((unsigned)e[1] << 16); o.y = e[2] | ((unsigned)e[3] << 16); o.z = e[4] | ((unsigned)e[5] << 16); o.w = e[6] | ((unsigned)e[7] << 16);
              *(u32x4*)(dst + (size_t)lane * SEQ + 8 * tc) = o; }
          LDS_WAIT(); asm volatile("" ::: "memory"); } }
    { const float* cw = argp(I_CONV_W) + (size_t)l * 3 * 256; bf16* Y = (bf16*)(c.ws + WS_Y);
      const f32x4 w0 = *(const f32x4*)(cw + 4 * lane), w1 = *(const f32x4*)(cw + 256 + 4 * lane), w2 = *(const f32x4*)(cw + 512 + 4 * lane);
      constexpr int R = 4;
      for (int row0 = gw; row0 < T; row0 += R * NGW) {
          u32x2 cc[R][3], hv[R][3], cb[R];
#pragma unroll
          for (int r = 0; r < R; ++r) { const int row = (row0 + r * NGW) < T ? (row0 + r * NGW) : 0; const int s = row & (SEQ - 1);
#pragma unroll
              for (int k = 0; k < 3; ++k) { const int sp = s - 2 + k; const size_t ro = (size_t)(sp >= 0 ? row - 2 + k : row) * PP;
                  cc[r][k] = *(const u32x2*)(P + ro + C_CC + 4 * lane); hv[r][k] = *(const u32x2*)(P + ro + C_CHV + 4 * lane); }
              cb[r] = *(const u32x2*)(P + (size_t)row * PP + C_CB + 4 * lane); }
#pragma unroll
          for (int r = 0; r < R; ++r) { const int row = row0 + r * NGW; if (row >= T) break; const int s = row & (SEQ - 1);
              f32x4 accv = {0.f, 0.f, 0.f, 0.f};
#pragma unroll
              for (int k = 0; k < 3; ++k) { const f32x4 wk = k == 0 ? w0 : (k == 1 ? w1 : w2); const float on = (s - 2 + k >= 0) ? 1.0f : 0.0f;
                  accv[0] += on * wk[0] * bflo(cc[r][k].x) * bflo(hv[r][k].x); accv[1] += on * wk[1] * bfhi(cc[r][k].x) * bfhi(hv[r][k].x);
                  accv[2] += on * wk[2] * bflo(cc[r][k].y) * bflo(hv[r][k].y); accv[3] += on * wk[3] * bfhi(cc[r][k].y) * bfhi(hv[r][k].y); }
              accv[0] *= bflo(cb[r].x); accv[1] *= bfhi(cb[r].x); accv[2] *= bflo(cb[r].y); accv[3] *= bfhi(cb[r].y);
              const float ss = wave_sum((accv[0] * accv[0] + accv[1] * accv[1]) + (accv[2] * accv[2] + accv[3] * accv[3]));
              const float rstd = 1.0f / sqrtf(ss * (1.0f / 256.0f) + EPS);
              u32x2 o; o.x = pk2(accv[0] * rstd, accv[1] * rstd); o.y = pk2(accv[2] * rstd, accv[3] * rstd);
              *(u32x2*)(Y + (size_t)row * DM + 256 + 4 * lane) = o; } } }
}
__device__ __forceinline__ void mla_groupnorm(const Ctx& c0) {
    const Ctx c = fresh(c0);
    const int gw = c.bid * NWAVES + c.wave, NGW = c.G * NWAVES, lane = c.lane; bf16* Y = (bf16*)(c.ws + WS_Y);
    for (int row = gw; row < T; row += NGW) { u32x2* p = (u32x2*)(Y + (size_t)row * DM + 4 * lane); const u32x2 w = *p;
        const float x0 = bflo(w.x), x1 = bfhi(w.x), x2 = bflo(w.y), x3 = bfhi(w.y);
        const float ss = wave_sum((x0 * x0 + x1 * x1) + (x2 * x2 + x3 * x3)); const float rstd = 1.0f / sqrtf(ss * (1.0f / 256.0f) + EPS);
        u32x2 o; o.x = pk2(x0 * rstd, x1 * rstd); o.y = pk2(x2 * rstd, x3 * rstd); *p = o; }
}

#define MFMA32(a, b, c) __builtin_amdgcn_mfma_f32_32x32x16_bf16((a), (b), (c), 0, 0, 0)
__device__ __forceinline__ int crow(int r, int hi) { return (r & 3) + 8 * (r >> 2) + 4 * hi; }

__device__ __forceinline__ void gmlp_unit(const Args& a, const Ctx& c0, int l, int unit) {
    const Ctx c = fresh(c0);
    const int lane = c.lane, w = c.wave, r32 = lane & 31, hi = lane >> 5; const int tok0 = unit * 128;
    const bf16* P = (const bf16*)(c.ws + WS_P); bf16* Y = (bf16*)(c.ws + WS_Y);
    LAS bf16* vnT = (LAS bf16*)c.lds;
    LAS bf16* ug = (LAS bf16*)(c.lds + 69632);
    LAS float* stg = (LAS float*)c.lds;
    const f32x4 lg = *(const f32x4*)(argp(I_GMLP_LN) + l * 256 + 4 * lane);
    __syncthreads();
    {   u32x2 wv[16], wu[16];
#pragma unroll
        for (int jj = 0; jj < 16; ++jj) { const size_t ro = (size_t)(tok0 + w * 16 + jj) * PP; wv[jj] = *(const u32x2*)(P + ro + C_GV + 4 * lane); wu[jj] = *(const u32x2*)(P + ro + C_GU + 4 * lane); }
#pragma unroll
        for (int jj = 0; jj < 16; ++jj) { const int j = w * 16 + jj;
            float x[4] = {gelu_tanh(bflo(wv[jj].x)), gelu_tanh(bfhi(wv[jj].x)), gelu_tanh(bflo(wv[jj].y)), gelu_tanh(bfhi(wv[jj].y))};
            const float mean = wave_sum((x[0] + x[1]) + (x[2] + x[3])) * (1.0f / 256.0f);
#pragma unroll
            for (int i = 0; i < 4; ++i) x[i] -= mean;
            const float var = wave_sum((x[0] * x[0] + x[1] * x[1]) + (x[2] * x[2] + x[3] * x[3])) * (1.0f / 256.0f); const float rstd = 1.0f / sqrtf(var + EPS);
#pragma unroll
            for (int i = 0; i < 4; ++i) vnT[(4 * lane + i) * 136 + j] = (bf16)(pk2(x[i] * rstd * lg[i], 0.f) & 0xffffu);
            u32x2 gu; gu.x = pk2(gelu_tanh(bflo(wu[jj].x)), gelu_tanh(bfhi(wu[jj].x))); gu.y = pk2(gelu_tanh(bflo(wu[jj].y)), gelu_tanh(bfhi(wu[jj].y)));
            *(LAS u32x2*)(ug + j * 256 + 4 * lane) = gu; } }
    __syncthreads();
    const int g = w >> 1; const bf16* WG = (const bf16*)(c.ws + WS_WGM) + (size_t)g * 128 * 128;
    f32x16 acc[4];
#pragma unroll
    for (int it = 0; it < 4; ++it)
#pragma unroll
        for (int r = 0; r < 16; ++r) acc[it][r] = 0.f;
#pragma unroll
    for (int ks = 0; ks < 8; ++ks) { const bf16x8 bfr = *(const LAS bf16x8*)(vnT + (32 * w + r32) * 136 + 16 * ks + 8 * hi);
#pragma unroll
        for (int it = 0; it < 4; ++it) { const bf16x8 afr = *(const bf16x8*)(WG + (size_t)(32 * it + r32) * 128 + 16 * ks + 8 * hi); acc[it] = MFMA32(afr, bfr, acc[it]); } }
    const float* bs = argp(I_GMLP_BS) + (size_t)l * 4 * 128 + g * 128; const int col = 32 * w + r32;
#pragma unroll
    for (int it = 0; it < 4; ++it)
#pragma unroll
        for (int r = 0; r < 16; ++r) { const int i = 32 * it + crow(r, hi); acc[it][r] = bf2f(ug[i * 256 + col]) * (acc[it][r] + bs[i]); }
    __syncthreads();
#pragma unroll
    for (int it = 0; it < 4; ++it)
#pragma unroll
        for (int r = 0; r < 16; ++r) { const int i = 32 * it + crow(r, hi); stg[i * 260 + col] = acc[it][r]; }
    __syncthreads();
    for (int jj = 0; jj < 16; ++jj) { const int i = w * 16 + jj; const f32x4 v = *(const LAS f32x4*)(stg + i * 260 + 4 * lane);
        const float ss = wave_sum((v[0] * v[0] + v[1] * v[1]) + (v[2] * v[2] + v[3] * v[3])); const float rstd = 1.0f / sqrtf(ss * (1.0f / 256.0f) + EPS);
        u32x2 o; o.x = pk2(v[0] * rstd, v[1] * rstd); o.y = pk2(v[2] * rstd, v[3] * rstd); *(u32x2*)(Y + (size_t)(tok0 + i) * DM + 512 + 4 * lane) = o; }
    __syncthreads();
}

__device__ __forceinline__ void compress_unit(const Ctx& c0, int unit) {
    const Ctx c = fresh(c0);
    const int lane = c.lane, w = c.wave, r32 = lane & 31, hi = lane >> 5; const int b = unit >> 4, kv = (unit >> 3) & 1, grp = unit & 7;
    const int kh = w >> 2, cg = w & 3;
    const bf16* P = (const bf16*)(c.ws + WS_P);
    const bf16* arow = P + (size_t)(b * SEQ + 16 * (32 * grp + r32)) * PP + (kv ? C_NVC : C_NKC) + 8 * hi;
    const bf16* brow = (const bf16*)(c.ws + WS_W1T) + ((size_t)kv * 256 + 64 * cg + r32) * 2048 + 8 * hi;
    f32x16 acc0, acc1;
#pragma unroll
    for (int r = 0; r < 16; ++r) { acc0[r] = 0.f; acc1[r] = 0.f; }
#pragma unroll 4
    for (int k2 = 0; k2 < 64; ++k2) { const int ks = 64 * kh + k2;
        const bf16x8 af = *(const bf16x8*)(arow + (size_t)(ks >> 2) * PP + 16 * (ks & 3));
        const bf16x8 b0 = *(const bf16x8*)(brow + 16 * ks), b1 = *(const bf16x8*)(brow + (size_t)32 * 2048 + 16 * ks);
        acc0 = MFMA32(af, b0, acc0); acc1 = MFMA32(af, b1, acc1); }
    LAS float* red = (LAS float*)c.lds;
    LAS bf16* Hs = (LAS bf16*)(c.lds + 33280);
    __syncthreads();
    if (kh == 1) {
#pragma unroll
        for (int r = 0; r < 16; ++r) { red[crow(r, hi) * 260 + 64 * cg + r32] = acc0[r]; red[crow(r, hi) * 260 + 64 * cg + 32 + r32] = acc1[r]; } }
    __syncthreads();
    if (kh == 0) { const float bp0 = ((const float*)(c.ws + WS_BPE))[kv * 256 + 64 * cg + r32], bp1 = ((const float*)(c.ws + WS_BPE))[kv * 256 + 64 * cg + 32 + r32];
#pragma unroll
        for (int r = 0; r < 16; ++r) { const int i = crow(r, hi);
            Hs[i * 264 + 64 * cg + r32] = (bf16)(pk2(gelu_tanh(acc0[r] + red[i * 260 + 64 * cg + r32] + bp0), 0.f) & 0xffffu);
            Hs[i * 264 + 64 * cg + 32 + r32] = (bf16)(pk2(gelu_tanh(acc1[r] + red[i * 260 + 64 * cg + 32 + r32] + bp1), 0.f) & 0xffffu); } }
    __syncthreads();
    if (w < 2) {
        const bf16* w2 = (const bf16*)(c.ws + WS_W2T) + ((size_t)kv * 64 + 32 * w + r32) * 256 + 8 * hi;
        f32x16 o;
#pragma unroll
        for (int r = 0; r < 16; ++r) o[r] = 0.f;
#pragma unroll
        for (int ks = 0; ks < 16; ++ks) { const bf16x8 af = *(const LAS bf16x8*)(Hs + r32 * 264 + 16 * ks + 8 * hi); const bf16x8 bf_ = *(const bf16x8*)(w2 + 16 * ks); o = MFMA32(af, bf_, o); }
        const int n = 32 * w + r32;
#pragma unroll
        for (int r = 0; r < 16; ++r) { const int ig = 32 * grp + crow(r, hi); const bf16 val = ig < 255 ? (bf16)(pk2(o[r], 0.f) & 0xffffu) : (bf16)0;
            if (kv == 0) ((bf16*)(c.ws + WS_KC))[((size_t)b * 256 + ig) * 64 + n] = val; else ((bf16*)(c.ws + WS_VCT))[((size_t)b * 64 + n) * 256 + ig] = val; }
    }
    __syncthreads();
}

constexpr int NSLOT = 4, SLOT_BYTES = 20480, SL_K = 0, SL_V = 8192, SL_KR = 16384;
constexpr int AT_RING = 0, AT_PSEL = NSLOT * SLOT_BYTES, AT_SELM = AT_PSEL + 64 * 65 * 4, AT_TACC = AT_SELM + 512, AT_END = AT_TACC + 8 * 4096;
static_assert(AT_END <= ARENA_BYTES, "attention LDS");
struct FState { f32x16 o0, o1; float m, l; };
__device__ __forceinline__ void fstate_init(FState& st) {
#pragma unroll
    for (int r = 0; r < 16; ++r) { st.o0[r] = 0.f; st.o1[r] = 0.f; }
    st.m = -1e30f; st.l = 0.f;
}
struct QLds { LAS const unsigned char* ql; __device__ __forceinline__ bf16x8 operator[](int ks) const { return *(const LAS bf16x8*)(ql + ks * 1024); } };
template <int DK, class QF> __device__ __forceinline__ void qk_tile(f32x16& p0, f32x16& p1, const QF& qf, LAS const unsigned char* Sb, int r32, int hi) {
    const f32x16 zero16 = {0.f, 0.f, 0.f, 0.f, 0.f, 0.f, 0.f, 0.f, 0.f, 0.f, 0.f, 0.f, 0.f, 0.f, 0.f, 0.f};
    const int xa = (r32 >> 1) & 7;
#pragma unroll
    for (int ks = 0; ks < 4; ++ks) {
        const int off = r32 * 128 + (((2 * ks + hi) ^ xa) << 4);
        const bf16x8 ka = *(const LAS bf16x8*)(Sb + SL_K + off);
        const bf16x8 kb = *(const LAS bf16x8*)(Sb + SL_K + 4096 + off);
        if (ks == 0) { p0 = MFMA32(ka, qf[0], zero16); p1 = MFMA32(kb, qf[0], zero16); }
        else { p0 = MFMA32(ka, qf[ks], p0); p1 = MFMA32(kb, qf[ks], p1); }
    }
    if (DK == 96) {
        const int xr = (r32 >> 2) & 3;
#pragma unroll
        for (int ks = 0; ks < 2; ++ks) {
            const int off = r32 * 64 + (((2 * ks + hi) ^ xr) << 4);
            const bf16x8 ka = *(const LAS bf16x8*)(Sb + SL_KR + off);
            const bf16x8 kb = *(const LAS bf16x8*)(Sb + SL_KR + 2048 + off);
            p0 = MFMA32(ka, qf[4 + ks], p0); p1 = MFMA32(kb, qf[4 + ks], p1); } }
}
template <class QF> __device__ __forceinline__ void qk_step(f32x16& p0, f32x16& p1, const QF& qf, LAS const unsigned char* Sb, int r32, int hi, int ks) {
    const f32x16 zero16 = {0.f, 0.f, 0.f, 0.f, 0.f, 0.f, 0.f, 0.f, 0.f, 0.f, 0.f, 0.f, 0.f, 0.f, 0.f, 0.f};
    bf16x8 ka, kb;
    if (ks < 4) { const int off = r32 * 128 + (((2 * ks + hi) ^ ((r32 >> 1) & 7)) << 4); ka = *(const LAS bf16x8*)(Sb + SL_K + off); kb = *(const LAS bf16x8*)(Sb + SL_K + 4096 + off); }
    else { const int off = r32 * 64 + (((2 * (ks - 4) + hi) ^ ((r32 >> 2) & 3)) << 4); ka = *(const LAS bf16x8*)(Sb + SL_KR + off); kb = *(const LAS bf16x8*)(Sb + SL_KR + 2048 + off); }
    const bf16x8 q = qf[ks];
    if (ks == 0) { p0 = MFMA32(ka, q, zero16); p1 = MFMA32(kb, q, zero16); } else { p0 = MFMA32(ka, q, p0); p1 = MFMA32(kb, q, p1); }
}
__device__ __forceinline__ void pv_step(f32x16& o0, f32x16& o1, const f32x16& p0, const f32x16& p1, LAS const unsigned char* Sb, int r32, int hi, int s) {
    const int xv = (r32 >> 1) & 7, b = 8 * (s & 1);
    u32x4 pw;
    if (s < 2) { pw.x = pk2(p0[b], p0[b + 1]); pw.y = pk2(p0[b + 2], p0[b + 3]); pw.z = pk2(p0[b + 4], p0[b + 5]); pw.w = pk2(p0[b + 6], p0[b + 7]); }
    else       { pw.x = pk2(p1[b], p1[b + 1]); pw.y = pk2(p1[b + 2], p1[b + 3]); pw.z = pk2(p1[b + 4], p1[b + 5]); pw.w = pk2(p1[b + 6], p1[b + 7]); }
    const bf16x8 pf = __builtin_bit_cast(bf16x8, pw);
#pragma unroll
    for (int db = 0; db < 2; ++db) {
        LAS const unsigned char* vrow = Sb + SL_V + (32 * db + r32) * 128 + 8 * hi;
        const u32x2 lo = *(const LAS u32x2*)(vrow + (((2 * s) ^ xv) << 4)), hh = *(const LAS u32x2*)(vrow + (((2 * s + 1) ^ xv) << 4));
        const u32x4 vv = {lo.x, lo.y, hh.x, hh.y}; const bf16x8 vf = __builtin_bit_cast(bf16x8, vv);
        if (db == 0) o0 = MFMA32(vf, pf, o0); else o1 = MFMA32(vf, pf, o1); }
}
__device__ __forceinline__ void pv_tile(f32x16& o0, f32x16& o1, const f32x16& p0, const f32x16& p1, LAS const unsigned char* Sb, int r32, int hi) {
    const int xv = (r32 >> 1) & 7;
#pragma unroll
    for (int s = 0; s < 4; ++s) {
        const int b = 8 * (s & 1);
        u32x4 pw;
        if (s < 2) { pw.x = pk2(p0[b], p0[b + 1]); pw.y = pk2(p0[b + 2], p0[b + 3]); pw.z = pk2(p0[b + 4], p0[b + 5]); pw.w = pk2(p0[b + 6], p0[b + 7]); }
        else       { pw.x = pk2(p1[b], p1[b + 1]); pw.y = pk2(p1[b + 2], p1[b + 3]); pw.z = pk2(p1[b + 4], p1[b + 5]); pw.w = pk2(p1[b + 6], p1[b + 7]); }
        const bf16x8 pf = __builtin_bit_cast(bf16x8, pw);
#pragma unroll
        for (int db = 0; db < 2; ++db) {
            LAS const unsigned char* vrow = Sb + SL_V + (32 * db + r32) * 128 + 8 * hi;
            const u32x2 lo = *(const LAS u32x2*)(vrow + (((2 * s) ^ xv) << 4)), hh = *(const LAS u32x2*)(vrow + (((2 * s + 1) ^ xv) << 4));
            const u32x4 vv = {lo.x, lo.y, hh.x, hh.y}; const bf16x8 vf = __builtin_bit_cast(bf16x8, vv);
            if (db == 0) o0 = MFMA32(vf, pf, o0); else o1 = MFMA32(vf, pf, o1); }
    }
}
template <bool MASKED> __device__ __forceinline__ void softmax_step(FState& st, f32x16& p0, f32x16& p1, bool lane_on = true) {
    float mx = fmaxf(p0[0], p1[0]);
#pragma unroll
    for (int r = 1; r < 16; ++r) mx = fmaxf(mx, fmaxf(p0[r], p1[r]));
    mx = fmaxf(mx, __shfl_xor(mx, 32));
    if (!MASKED) mx = lane_on ? mx : -1e30f;
    if (__any(mx > st.m)) {
        const float mnew = fmaxf(st.m, mx), alpha = __builtin_amdgcn_exp2f(st.m - mnew); st.m = mnew;
        st.l *= alpha;
#pragma unroll
        for (int r = 0; r < 16; ++r) { st.o0[r] *= alpha; st.o1[r] *= alpha; }
    }
    float rs = 0.f;
    if (MASKED) {
        const float m = st.m;
#pragma unroll
        for (int r = 0; r < 16; ++r) { p0[r] = p0[r] > -1e29f ? __builtin_amdgcn_exp2f(p0[r] - m) : 0.f; p1[r] = p1[r] > -1e29f ? __builtin_amdgcn_exp2f(p1[r] - m) : 0.f; rs += p0[r] + p1[r]; }
    } else {
        const float m = lane_on ? st.m : 1e30f;
#pragma unroll
        for (int r = 0; r < 16; ++r) { p0[r] = __builtin_amdgcn_exp2f(p0[r] - m); p1[r] = __builtin_amdgcn_exp2f(p1[r] - m); rs += p0[r] + p1[r]; }
    }
    st.l += rs;
}
__device__ __forceinline__ float max_xor32(float v) { const auto rr = __builtin_amdgcn_permlane32_swap(__float_as_uint(v), __float_as_uint(v), false, false); return fmaxf(__uint_as_float(rr[0]), __uint_as_float(rr[1])); }
#define SMX_I(P0, P1, AL, MEFF, ON) do { float mx_ = fmaxf(P0[0], P1[0]); \
    _Pragma("unroll") for (int r = 1; r < 16; ++r) mx_ = fmaxf(mx_, fmaxf(P0[r], P1[r])); \
    mx_ = max_xor32(mx_); if (LANEON_) mx_ = (ON) ? mx_ : -1e30f; \
    const float mn_ = fmaxf(st.m, mx_); AL = __builtin_amdgcn_exp2f(st.m - mn_); st.m = mn_; MEFF = LANEON_ ? ((ON) ? mn_ : 1e30f) : mn_; } while (0)
#define SMX_II(P, MEFF, RS) do { _Pragma("unroll") for (int r = 0; r < 16; ++r) { P[r] = __builtin_amdgcn_exp2f(P[r] - MEFF); RS += P[r]; } } while (0)
#define SMX_III(AL, RS) do { st.l = st.l * AL + RS; _Pragma("unroll") for (int r = 0; r < 16; ++r) { st.o0[r] *= AL; st.o1[r] *= AL; } } while (0)
#define SBAR0 __builtin_amdgcn_sched_barrier(0)
#define PAIR_NB(DK, LANEON, ONA, ONB) do { constexpr bool LANEON_ = LANEON; \
    f32x16 a0, a1, b0, b1; float alA, mA, rsA = 0.f, alB, mB, rsB = 0.f; \
    qk_tile<DK>(a0, a1, qf, SbA, r32, hi); SBAR0; \
    qk_step(b0, b1, qf, SbB, r32, hi, 0); qk_step(b0, b1, qf, SbB, r32, hi, 1); SMX_I(a0, a1, alA, mA, (ONA)); SBAR0; \
    qk_step(b0, b1, qf, SbB, r32, hi, 2); qk_step(b0, b1, qf, SbB, r32, hi, 3); SMX_II(a0, mA, rsA); SBAR0; \
    if (DK == 96) { qk_step(b0, b1, qf, SbB, r32, hi, 4); qk_step(b0, b1, qf, SbB, r32, hi, 5); } SMX_II(a1, mA, rsA); SMX_III(alA, rsA); SBAR0; \
    pv_step(st.o0, st.o1, a0, a1, SbA, r32, hi, 0); pv_step(st.o0, st.o1, a0, a1, SbA, r32, hi, 1); SMX_I(b0, b1, alB, mB, (ONB)); SMX_II(b0, mB, rsB); SBAR0; \
    pv_step(st.o0, st.o1, a0, a1, SbA, r32, hi, 2); pv_step(st.o0, st.o1, a0, a1, SbA, r32, hi, 3); SMX_II(b1, mB, rsB); SBAR0; \
    SMX_III(alB, rsB); pv_tile(st.o0, st.o1, b0, b1, SbB, r32, hi); } while (0)
template <int DK> struct DmaLoader {
    const char *k1, *k2, *v; unsigned ks1, ks2, vs;
    unsigned o1, o2, ov;
    unsigned ldsbase, w;
    __device__ __forceinline__ void init(const bf16* k1_, int kp1, const bf16* k2_, int kp2, const bf16* v_, int vp, int lane, int wave, LAS unsigned char* lds) {
        k1 = (const char*)k1_; k2 = (const char*)k2_; v = (const char*)v_; ks1 = 64u * kp1 * 2u; ks2 = 64u * kp2 * 2u; vs = 128u; w = (unsigned)wave;
        ldsbase = (unsigned)(uintptr_t)lds + AT_RING;
        { const int key = 8 * wave + (lane >> 3), cc = (lane & 7) ^ ((key >> 1) & 7); o1 = ((unsigned)key * kp1 + 8u * cc) * 2u; }
        { const int key = 16 * (wave & 3) + (lane >> 2), cc = (lane & 3) ^ ((key >> 2) & 3); o2 = ((unsigned)key * kp2 + 8u * cc) * 2u; }
        { const int d = 8 * wave + (lane >> 3), kc = (lane & 7) ^ ((d >> 1) & 7); ov = ((unsigned)d * vp + 8u * kc) * 2u; }
    }
    __device__ __forceinline__ void issue(int j, int slot) const {
        const unsigned sb = ldsbase + (unsigned)slot * SLOT_BYTES;
        __builtin_amdgcn_global_load_lds((const unsigned*)(k1 + (size_t)j * ks1 + o1), (LAS unsigned*)(uintptr_t)(sb + SL_K + w * 1024u), 16, 0, 0);
        __builtin_amdgcn_global_load_lds((const unsigned*)(v + (size_t)j * vs + ov), (LAS unsigned*)(uintptr_t)(sb + SL_V + w * 1024u), 16, 0, 0);
        if (DK == 96) __builtin_amdgcn_global_load_lds((const unsigned*)(k2 + (size_t)j * ks2 + o2), (LAS unsigned*)(uintptr_t)(sb + SL_KR + (w & 3u) * 1024u), 16, 0, 0);
    }
};
#define ATT_WAITV(n) asm volatile("s_waitcnt vmcnt(" #n ")" ::: "memory")
#define TILE_BEGIN(L, J0, J1, WAITSTMT) { \
    const int _j0 = (J0), _j1 = (J1); \
    __syncthreads(); \
    if (_j0 < _j1) { \
    _Pragma("unroll") for (int _p = 0; _p < 3; ++_p) (L).issue((_j0 + _p) < _j1 ? (_j0 + _p) : (_j1 - 1), _p); \
    for (int j = _j0; j < _j1; ++j) { \
        WAITSTMT; __builtin_amdgcn_s_barrier(); asm volatile("" ::: "memory"); \
        (L).issue((j + 3) < _j1 ? (j + 3) : (_j1 - 1), (j - _j0 + 3) & 3); \
        LAS const unsigned char* Sb = c.lds + AT_RING + ((j - _j0) & 3) * SLOT_BYTES;
#define TILE_END(L) \
    } } \
    ATT_WAITV(0); __builtin_amdgcn_s_barrier(); asm volatile("" ::: "memory"); }

#define TILE2_BEGIN(L, J0, J1) { \
    const int _j0 = (J0), _j1 = (J1), _npair = (_j1 - _j0 + 1) >> 1; \
    __syncthreads(); \
    if (_npair > 0) { \
    (L).issue(_j0, 0); (L).issue((_j0 + 1) < _j1 ? (_j0 + 1) : (_j1 - 1), 1); \
    for (int _i = 0; _i < _npair; ++_i) { \
        const int j = _j0 + 2 * _i; const bool hasB = (j + 1) < _j1; \
        ATT_WAITV(0); __builtin_amdgcn_s_barrier(); asm volatile("" ::: "memory"); \
        { const int _jn = j + 2, _s = ((_i + 1) & 1) * 2; (L).issue(_jn < _j1 ? _jn : (_j1 - 1), _s); (L).issue((_jn + 1) < _j1 ? (_jn + 1) : (_j1 - 1), _s + 1); } \
        LAS const unsigned char* SbA = c.lds + AT_RING + ((_i & 1) * 2) * SLOT_BYTES; LAS const unsigned char* SbB = SbA + SLOT_BYTES;
#define TILE2_END(L) \
    } } \
    ATT_WAITV(0); __builtin_amdgcn_s_barrier(); asm volatile("" ::: "memory"); }

__device__ __forceinline__ void mla_unit(const Ctx& c0, int b, int h, int qb) {
    const Ctx c = fresh(c0);
    const int lane = c.lane, w = c.wave, r32 = lane & 31, hi = lane >> 5;
    const int qpos = 256 * qb + 32 * w + r32; const int row = b * SEQ + qpos;
    const bf16* Qn = (const bf16*)(c.ws + WS_QN); const bf16* Qr = (const bf16*)(c.ws + WS_QR);
    LAS unsigned char* qimg = c.lds + NSLOT * SLOT_BYTES + w * 6144 + lane * 16;
    __syncthreads();
#pragma unroll
    for (int ks = 0; ks < 4; ++ks) *(LAS bf16x8*)(qimg + ks * 1024) = *(const bf16x8*)(Qn + (size_t)row * 256 + h * 64 + 16 * ks + 8 * hi);
#pragma unroll
    for (int ks = 0; ks < 2; ++ks) *(LAS bf16x8*)(qimg + (4 + ks) * 1024) = *(const bf16x8*)(Qr + (size_t)row * 128 + h * 32 + 16 * ks + 8 * hi);
    const QLds qf{qimg};
    DmaLoader<96> L; L.init((const bf16*)(c.ws + WS_KN) + (size_t)b * SEQ * 256 + h * 64, 256, (const bf16*)(c.ws + WS_KR) + (size_t)b * SEQ * 32, 32, (const bf16*)(c.ws + WS_VTM) + (size_t)(b * 4 + h) * 64 * SEQ, SEQ, lane, w, c.lds);
    FState st; fstate_init(st);
    const int wmax = 256 * qb + 32 * w + 31;
#define MLA_SM(P0, P1, JJ) do { if (64 * (JJ) + 63 > 256 * qb + 32 * w) { \
            _Pragma("unroll") for (int r = 0; r < 16; ++r) { const int k0 = 64 * (JJ) + crow(r, hi); if (k0 > qpos) P0[r] = -1e30f; if (k0 + 32 > qpos) P1[r] = -1e30f; } \
            softmax_step<true>(st, P0, P1); } else softmax_step<false>(st, P0, P1); } while (0)
    TILE2_BEGIN(L, 0, 4 * qb)
        PAIR_NB(96, false, true, true);
    TILE2_END(L)
    TILE2_BEGIN(L, 4 * qb, 4 * qb + 4)
        const bool needA = 64 * j <= wmax, needB = hasB && (64 * (j + 1) <= wmax);
        if (needB) {
            f32x16 a0, a1, b0, b1; qk_tile<96>(a0, a1, qf, SbA, r32, hi); __builtin_amdgcn_sched_barrier(0); qk_tile<96>(b0, b1, qf, SbB, r32, hi);
            MLA_SM(a0, a1, j); __builtin_amdgcn_sched_barrier(0); pv_tile(st.o0, st.o1, a0, a1, SbA, r32, hi); __builtin_amdgcn_sched_barrier(0);
            MLA_SM(b0, b1, j + 1); __builtin_amdgcn_sched_barrier(0); pv_tile(st.o0, st.o1, b0, b1, SbB, r32, hi);
        } else if (needA) {
            f32x16 a0, a1; qk_tile<96>(a0, a1, qf, SbA, r32, hi);
            MLA_SM(a0, a1, j); pv_tile(st.o0, st.o1, a0, a1, SbA, r32, hi);
        }
    TILE2_END(L)
#undef MLA_SM
    const float lt = st.l + __shfl_xor(st.l, 32); const float inv = 1.0f / lt;
    int qp2 = qpos; asm volatile("" : "+v"(qp2));
    bf16* Y = (bf16*)(c.ws + WS_Y) + (size_t)(b * SEQ + qp2) * DM + h * 64;
#pragma unroll
    for (int g = 0; g < 4; ++g) {
        u32x2 o; o.x = pk2(st.o0[4 * g] * inv, st.o0[4 * g + 1] * inv); o.y = pk2(st.o0[4 * g + 2] * inv, st.o0[4 * g + 3] * inv); *(u32x2*)(Y + 8 * g + 4 * hi) = o;
        u32x2 o2; o2.x = pk2(st.o1[4 * g] * inv, st.o1[4 * g + 1] * inv); o2.y = pk2(st.o1[4 * g + 2] * inv, st.o1[4 * g + 3] * inv); *(u32x2*)(Y + 32 + 8 * g + 4 * hi) = o2; }
}

__device__ __forceinline__ void nsa_unit(const Ctx& c0, int b, int qt) {
    const Ctx c = fresh(c0);
    const int lane = c.lane, w = c.wave, r32 = lane & 31, hi = lane >> 5;
    const int tl = 8 * w + (r32 & 7), head = r32 >> 3, tok = 64 * qt + tl; const int row = b * SEQ + tok;
    const bf16* P = (const bf16*)(c.ws + WS_P);
    bf16x8 qf[4];
#pragma unroll
    for (int ks = 0; ks < 4; ++ks) qf[ks] = *(const bf16x8*)(P + (size_t)row * PP + C_NQ + head * 64 + 16 * ks + 8 * hi);
#define NSA_GATE(br) ({ int t_ = tok; asm volatile("" : "+v"(t_)); sigmoid_f(bf2f(P[(size_t)(b * SEQ + t_) * PP + C_NG + head * 3 + (br)])); })
    LAS float* psel = (LAS float*)(c.lds + AT_PSEL); LAS unsigned long long* selm = (LAS unsigned long long*)(c.lds + AT_SELM);
    __syncthreads();
    for (int i = c.tid; i < 64 * 65; i += NWAVES * 64) psel[i] = 0.f;
    LAS unsigned* tacc = (LAS unsigned*)(c.lds + AT_TACC) + w * 1024 + lane;
    DmaLoader<64> L; L.init((const bf16*)(c.ws + WS_KC) + (size_t)b * 256 * 64, 64, nullptr, 0, (const bf16*)(c.ws + WS_VCT) + (size_t)b * 64 * 256, 256, lane, w, c.lds);
    const int ntc = (4 * qt + 2) / 64 + 1;
    float cm = -1e30f, cl = 0.f;
    TILE_BEGIN(L, 0, ntc, ATT_WAITV(4))
        f32x16 p0, p1; qk_tile<64>(p0, p1, qf, Sb, r32, hi);
        float mx = -1e30f;
#pragma unroll
        for (int r = 0; r < 16; ++r) { const int c0 = 64 * j + crow(r, hi); if (16 * c0 + 31 > tok) p0[r] = -1e30f; if (16 * (c0 + 32) + 31 > tok) p1[r] = -1e30f; mx = fmaxf(mx, fmaxf(p0[r], p1[r])); }
        mx = fmaxf(mx, __shfl_xor(mx, 32));
        const float mnew = fmaxf(cm, mx); float rs = 0.f;
#pragma unroll
        for (int r = 0; r < 16; ++r) { rs += (p0[r] > -1e29f ? __builtin_amdgcn_exp2f(p0[r] - mnew) : 0.f) + (p1[r] > -1e29f ? __builtin_amdgcn_exp2f(p1[r] - mnew) : 0.f); }
        cl = cl * __builtin_amdgcn_exp2f(cm - mnew) + rs; cm = mnew;
    TILE_END(L)
    cl += __shfl_xor(cl, 32);
    const float cinv = cl > 0.f ? 1.0f / cl : 0.f;
    {
        f32x16 o0, o1;
#pragma unroll
        for (int r = 0; r < 16; ++r) { o0[r] = 0.f; o1[r] = 0.f; }
        TILE_BEGIN(L, 0, ntc, ATT_WAITV(4))
            f32x16 p0, p1; qk_tile<64>(p0, p1, qf, Sb, r32, hi);
#pragma unroll
            for (int r = 0; r < 16; ++r) { const int c0 = 64 * j + crow(r, hi);
                p0[r] = (16 * c0 + 31 <= tok) ? __builtin_amdgcn_exp2f(p0[r] - cm) * cinv : 0.f; p1[r] = (16 * (c0 + 32) + 31 <= tok) ? __builtin_amdgcn_exp2f(p1[r] - cm) * cinv : 0.f; }
#pragma unroll
            for (int half = 0; half < 2; ++half)
#pragma unroll
                for (int g = 0; g < 4; ++g) {
                    float av, bv;
                    if (half == 0) { av = p0[4 * g] + p0[4 * g + 1] + p0[4 * g + 2] + 0.5f * p0[4 * g + 3]; bv = 0.5f * p0[4 * g + 3]; }
                    else           { av = p1[4 * g] + p1[4 * g + 1] + p1[4 * g + 2] + 0.5f * p1[4 * g + 3]; bv = 0.5f * p1[4 * g + 3]; }
                    av += __shfl_xor(av, 8); av += __shfl_xor(av, 16); bv += __shfl_xor(bv, 8); bv += __shfl_xor(bv, 16);
                    if (head == 0) { const int n = 16 * j + 8 * half + 2 * g + hi; (void)__hip_atomic_fetch_add(psel + tl * 65 + n, av, __ATOMIC_RELAXED, __HIP_MEMORY_SCOPE_WORKGROUP); (void)__hip_atomic_fetch_add(psel + tl * 65 + n + 1, bv, __ATOMIC_RELAXED, __HIP_MEMORY_SCOPE_WORKGROUP); }
                }
            pv_tile(o0, o1, p0, p1, Sb, r32, hi);
        TILE_END(L)
        { const float g0 = NSA_GATE(0);
#pragma unroll
        for (int r = 0; r < 16; ++r) tacc[r * 64] = pk2(g0 * o0[r], g0 * o1[r]); }
    }
    __syncthreads();
    for (int tt = 0; tt < 8; ++tt) {
        const int tk = 8 * w + tt; float sc = psel[tk * 65 + lane];
        if (lane > qt) sc = -1.0f; else if (lane == 0 || lane == qt || lane == qt - 1) sc = 1e4f;
        int rank = 0;
        for (int n = 0; n < 64; ++n) { const float so = __builtin_bit_cast(float, __builtin_amdgcn_readlane(__builtin_bit_cast(int, sc), n)); rank += (so > sc || (so == sc && n < lane)) ? 1 : 0; }
        const unsigned long long mk = __ballot(rank < 16);
        if (lane == 0) selm[tk] = mk;
    }
    __syncthreads();
    const unsigned long long smask = selm[tl];
    {
        L.init(P + (size_t)b * SEQ * PP + C_NKS, PP, nullptr, 0, (const bf16*)(c.ws + WS_VTS) + (size_t)b * 64 * SEQ, SEQ, lane, w, c.lds);
        FState st; fstate_init(st);
#define SEL_SM(P0, P1, JJ) do { if ((JJ) == qt) { \
            _Pragma("unroll") for (int r = 0; r < 16; ++r) { const int k0 = 64 * (JJ) + crow(r, hi); if (k0 > tok) P0[r] = -1e30f; if (k0 + 32 > tok) P1[r] = -1e30f; } \
            softmax_step<true>(st, P0, P1);   \
        } else softmax_step<false>(st, P0, P1, (bool)((smask >> (JJ)) & 1ull)); } while (0)
        const int qe = qt & ~1;
        TILE2_BEGIN(L, 0, qe)
            PAIR_NB(64, true, (bool)((smask >> j) & 1ull), (bool)((smask >> (j + 1)) & 1ull));
        TILE2_END(L)
        TILE2_BEGIN(L, qe, qt + 1)
            if (hasB) {
                f32x16 a0, a1, b0, b1; qk_tile<64>(a0, a1, qf, SbA, r32, hi); __builtin_amdgcn_sched_barrier(0); qk_tile<64>(b0, b1, qf, SbB, r32, hi);
                SEL_SM(a0, a1, j); __builtin_amdgcn_sched_barrier(0); pv_tile(st.o0, st.o1, a0, a1, SbA, r32, hi); __builtin_amdgcn_sched_barrier(0);
                SEL_SM(b0, b1, j + 1); __builtin_amdgcn_sched_barrier(0); pv_tile(st.o0, st.o1, b0, b1, SbB, r32, hi);
            } else {
                f32x16 a0, a1; qk_tile<64>(a0, a1, qf, SbA, r32, hi);
                SEL_SM(a0, a1, j); pv_tile(st.o0, st.o1, a0, a1, SbA, r32, hi);
            }
        TILE2_END(L)
#undef SEL_SM
        const float lt = st.l + __shfl_xor(st.l, 32); const float f = lt > 0.f ? NSA_GATE(1) / lt : 0.f;
#pragma unroll
        for (int r = 0; r < 16; ++r) { const unsigned t = tacc[r * 64]; tacc[r * 64] = pk2(bflo(t) + f * st.o0[r], bfhi(t) + f * st.o1[r]); }
    }
    f32x16 t0, t1;
    {
        L.init(P + (size_t)b * SEQ * PP + C_NKW, PP, nullptr, 0, (const bf16*)(c.ws + WS_VTW) + (size_t)b * 64 * SEQ, SEQ, lane, w, c.lds);
        FState st; fstate_init(st);
        TILE_BEGIN(L, (qt >= 8 ? qt - 8 : 0), qt + 1, ATT_WAITV(4))
            f32x16 p0, p1; qk_tile<64>(p0, p1, qf, Sb, r32, hi);
            if (j == qt || j + 8 == qt) {
#pragma unroll
                for (int r = 0; r < 16; ++r) { const int k0 = 64 * j + crow(r, hi); if (k0 > tok || k0 + 512 <= tok) p0[r] = -1e30f; if (k0 + 32 > tok || k0 + 32 + 512 <= tok) p1[r] = -1e30f; }
                softmax_step<true>(st, p0, p1);
            } else softmax_step<false>(st, p0, p1);
            pv_tile(st.o0, st.o1, p0, p1, Sb, r32, hi);
        TILE_END(L)
        const float lt = st.l + __shfl_xor(st.l, 32); const float f = lt > 0.f ? NSA_GATE(2) / lt : 0.f;
#pragma unroll
        for (int r = 0; r < 16; ++r) { const unsigned t = tacc[r * 64]; t0[r] = bflo(t) + f * st.o0[r]; t1[r] = bfhi(t) + f * st.o1[r]; }
    }
    float ss = 0.f;
#pragma unroll
    for (int r = 0; r < 16; ++r) ss += t0[r] * t0[r] + t1[r] * t1[r];
    ss += __shfl_xor(ss, 32); ss += __shfl_xor(ss, 8); ss += __shfl_xor(ss, 16);
    const float rstd = 1.0f / sqrtf(ss * (1.0f / 256.0f) + EPS);
    int tk2 = tok; asm volatile("" : "+v"(tk2));
    bf16* Y = (bf16*)(c.ws + WS_Y) + (size_t)(b * SEQ + tk2) * DM + 768 + head * 64;
#pragma unroll
    for (int g = 0; g < 4; ++g) {
        u32x2 o; o.x = pk2(t0[4 * g] * rstd, t0[4 * g + 1] * rstd); o.y = pk2(t0[4 * g + 2] * rstd, t0[4 * g + 3] * rstd); *(u32x2*)(Y + 8 * g + 4 * hi) = o;
        u32x2 o2; o2.x = pk2(t1[4 * g] * rstd, t1[4 * g + 1] * rstd); o2.y = pk2(t1[4 * g + 2] * rstd, t1[4 * g + 3] * rstd); *(u32x2*)(Y + 32 + 8 * g + 4 * hi) = o2; }
}

#ifndef PHMASK
#define PHMASK 0xFFFF
#endif
#define PHON(k) ((PHMASK >> (k)) & 1)
#ifndef SUBMASK
#define SUBMASK 0xFF
#endif
#define SUBON(k) ((SUBMASK >> (k)) & 1)
#ifndef REPMASK
#define REPMASK 0
#endif
#define NREP(k) (((REPMASK >> (k)) & 1) ? 2 : 1)
constexpr int PH_PER_LAYER = 17, PH_FINAL = DEPTH * PH_PER_LAYER, NPH = PH_FINAL + 1;
__global__ void __launch_bounds__(NWAVES * 64, 2) fwd_kernel(Args a) {
    extern __shared__ __attribute__((aligned(16))) unsigned char lds_raw[];
    Ctx c; c.lds = (LAS unsigned char*)lds_raw; c.ws = (GAS unsigned char*)a.ws; c.tid = threadIdx.x; c.lane = c.tid & 63; c.wave = __builtin_amdgcn_readfirstlane(c.tid >> 6); c.G = gridDim.x; c.bid = blockIdx.x;
    volatile LAS unsigned* MISC = (volatile LAS unsigned*)(c.lds + MISC_OFF);
    if (c.tid < 64) MISC[c.tid] = 0u;
    __syncthreads();
    const int lo = a.ph_lo, hi = a.ph_hi;
    const bool multi = (hi - lo) > 1;
    XcdBarrier bar; bar.bar = (unsigned*)(c.ws + WS_CTL) + CW_BAR; bar.x = 0; bar.st = nullptr;
    if (multi) bar = xcd_barrier_post((unsigned*)(c.ws + WS_CTL) + CW_BAR, MISC + 8);
#define IN(k) (lo <= (k) && (k) < hi)
#define SEAM(k) do { if ((k) + 1 < hi) { xcd_barrier(bar, (unsigned*)(c.ws + WS_CTL) + CW_BAR); if (NREP(15) > 1) xcd_barrier(bar, (unsigned*)(c.ws + WS_CTL) + CW_BAR); } } while (0)
    for (int l = 0; l < DEPTH; ++l) {
        GAS unsigned char* ws = c.ws; asm volatile("" : "+s"(ws));
        const int pb = l * PH_PER_LAYER;
        const bool moe = (l & 1) != 0;
        if (PHON(0) && IN(pb + 0)) {
            for (int rep_ = 0; rep_ < NREP(0); ++rep_) convert_weights(a, c, l);
            const bf16* O2 = (const bf16*)(ws + WS_P);
            { const bool after_moe = l > 0 && ((l - 1) & 1);
              norm_pass<0>(a, c, l == 0 ? argp(I_X) : nullptr, after_moe ? O2 : nullptr, after_moe ? O2 + (size_t)T * DM : nullptr, l == 0 || after_moe, l); }
            if (NREP(10) > 1) { xcd_barrier(bar, (unsigned*)(c.ws + WS_CTL) + CW_BAR); norm_pass<0>(a, c, l == 0 ? argp(I_X) : nullptr, nullptr, nullptr, false, l); }
            SEAM(pb + 0);
        }
        if (PHON(1) && IN(pb + 1)) for (int rep_ = 0; rep_ < NREP(1); ++rep_) {
            SchedPlain S; S.R.init(T / 256, PP / 256, c.G, c.bid); S.lda2_ = DM * 2; S.B = (const char*)(ws + WS_WIN); S.btile = (size_t)256 * DM * 2;
            EpiInProj E{(bf16*)(ws + WS_P), (float*)(ws + WS_SSQ), (float*)(ws + WS_SSKV)};
            pg8::gemm_phase<EpiInProj, SchedPlain>(c.lds, (const char*)(ws + WS_XN), DM, DM, S, E);
            if (rep_ + 1 < NREP(1)) xcd_barrier(bar, (unsigned*)(c.ws + WS_CTL) + CW_BAR); else SEAM(pb + 1);
        }
        if (PHON(2) && IN(pb + 2)) for (int rep_ = 0; rep_ < NREP(2); ++rep_) {
            if (SUBON(0)) for (int r2_ = 0; r2_ < NREP(11); ++r2_) { SchedPlain S; S.R.init(T / 256, 4, c.G, c.bid); S.lda2_ = PP * 2; S.B = (const char*)(ws + WS_WQKV); S.btile = (size_t)256 * 384 * 2;
              EpiQkv E{(const float*)(ws + WS_SSQ), (const float*)(ws + WS_SSKV), (const f32x2_t*)(ws + WS_CS), (bf16*)(ws + WS_QN), (bf16*)(ws + WS_QR), (bf16*)(ws + WS_KN), (bf16*)(ws + WS_VTM)};
              pg8::gemm_phase<EpiQkv, SchedPlain>(c.lds, (const char*)(ws + WS_P), 384, 384, S, E); }
            if (SUBON(1)) for (int r2_ = 0; r2_ < NREP(12); ++r2_) for (int u = c.bid; u < NB * 32; u += c.G) gmlp_unit(a, c, l, u);
            if (SUBON(2)) for (int r2_ = 0; r2_ < NREP(13); ++r2_) for (int u = c.bid; u < 128; u += c.G) compress_unit(c, u);
            __syncthreads();
            if (SUBON(3)) for (int r2_ = 0; r2_ < NREP(14); ++r2_) prep_thin(a, c, l);
            if (rep_ + 1 < NREP(2)) xcd_barrier(bar, (unsigned*)(c.ws + WS_CTL) + CW_BAR); else SEAM(pb + 2);
        }
        if (PHON(3) && IN(pb + 3)) for (int rep_ = 0; rep_ < NREP(3); ++rep_) {
            const int vcu = (c.G % 8 == 0) ? (c.bid % 8) * (c.G / 8) + c.bid / 8 : c.bid;
            if (SUBON(0)) for (int u = vcu; u < 256; u += c.G) for (int rep = 0; rep < 2; ++rep) { const int bh = u >> 3, s = u & 7; mla_unit(c, bh >> 2, bh & 3, rep ? 15 - s : s); }
            if (SUBON(1)) for (int u = vcu; u < 256; u += c.G) for (int rep = 0; rep < 2; ++rep) { const int b = u >> 5, s = u & 31; nsa_unit(c, b, rep ? 63 - s : s); }
            if (rep_ + 1 < NREP(3)) xcd_barrier(bar, (unsigned*)(c.ws + WS_CTL) + CW_BAR); else SEAM(pb + 3);
        }
        if (PHON(4) && IN(pb + 4)) { mla_groupnorm(c); SEAM(pb + 4); }
        if (PHON(5) && IN(pb + 5)) for (int rep_ = 0; rep_ < NREP(5); ++rep_) {
            SchedPlain S; S.R.init(T / 256, 4, c.G, c.bid); S.lda2_ = DM * 2; S.B = (const char*)(ws + WS_WO); S.btile = (size_t)256 * DM * 2;
            EpiResidual E{(bf16*)(ws + WS_H)};
            pg8::gemm_phase<EpiResidual, SchedPlain>(c.lds, (const char*)(ws + WS_Y), DM, DM, S, E);
            if (rep_ + 1 < NREP(5)) xcd_barrier(bar, (unsigned*)(c.ws + WS_CTL) + CW_BAR); else SEAM(pb + 5);
        }
        if (PHON(6) && IN(pb + 6)) {
            norm_pass<1>(a, c, nullptr, nullptr, nullptr, false, l);
            SEAM(pb + 6);
        }
        if (PHON(7) && IN(pb + 7)) {
            const MoeMap M = make_moemap(c, l);
            const int P8 = M.pre8, rem = P8 & 63, NF = P8 >> 6, hasR = rem > 0 ? 1 : 0, nch = NF + hasR;
            for (int sidx = 0; sidx <= nch; ++sidx) {
                if (sidx >= 1) {
                    const int ci = sidx - 1; const bool isR = hasR && ci == 0; const int k = ci - hasR;
                    const int t0 = isR ? 0 : rem + 64 * k, nM = isR ? rem : 64;
                    SchedDown S; S.R.init(nM, 4, c.G, c.bid); S.M = M; S.t0 = t0; S.B = (const char*)(ws + WS_WD);
                    EpiDown E{(bf16*)(ws + WS_P), M, (bf16*)(ws + WS_H)};
                    pg8::gemm_phase<EpiDown, SchedDown>(c.lds, (const char*)(ws + (isR ? WS_ACTR : ((k & 1) ? WS_QN : WS_ACT))), FF, FF, S, E);
                }
                if (sidx < nch) {
                    const int ci = sidx; const bool isR = hasR && ci == 0; const int k = ci - hasR;
                    const int t0 = isR ? 0 : rem + 64 * k, nM = isR ? rem : 64;
                    SchedGateUp S; S.R.init(nM, 2 * FF / 256, c.G, c.bid); S.M = M; S.t0 = t0; S.B = (const char*)(ws + WS_WGU);
                    S.nd = (hasR && sidx == 1 && c.G == 256) ? rem * 4 : 0;
                    EpiSwiglu E{(unsigned char*)(ws + (isR ? WS_ACTR : ((k & 1) ? WS_QN : WS_ACT))), t0};
                    pg8::gemm_phase<EpiSwiglu, SchedGateUp>(c.lds, (const char*)(ws + WS_D1), DM, DM, S, E);
                }
                xcd_barrier(bar, (unsigned*)(c.ws + WS_CTL) + CW_BAR);
            }
        }
    }
    if (PHON(9) && IN(PH_FINAL)) {
        GAS unsigned char* ws = c.ws;
        const bf16* O2 = (const bf16*)(ws + WS_P);
        norm_pass<2>(a, c, nullptr, O2, O2 + (size_t)T * DM, false, DEPTH - 1);
    }
#undef IN
#undef SEAM
}

#ifndef MK_MULTI_LAUNCH
#define MK_MULTI_LAUNCH 0
#endif
extern "C" void kernel_launch(void* const* d_in, const int* in_sizes, int n_in, void* d_out, int out_size, void* d_ws, size_t ws_size, hipStream_t stream) {
    static int grid = 0;
    if (grid == 0) {
        if (n_in != 29 || out_size != T * DM || ws_size < WS_END) { fprintf(stderr, "kernel_launch: unexpected shapes (n_in %d, out %d, ws %zu < %zu)\n", n_in, out_size, ws_size, (size_t)WS_END); grid = -1; return; }
        int dev = 0, cus = 0, per_cu = 0;
        if (hipGetDevice(&dev) != hipSuccess || hipDeviceGetAttribute(&cus, hipDeviceAttributeMultiprocessorCount, dev) != hipSuccess) { grid = -1; return; }
        if (hipFuncSetAttribute((const void*)fwd_kernel, hipFuncAttributeMaxDynamicSharedMemorySize, LDS_BYTES) != hipSuccess) { fprintf(stderr, "kernel_launch: hipFuncSetAttribute failed\n"); grid = -1; return; }
        if (hipOccupancyMaxActiveBlocksPerMultiprocessor(&per_cu, (const void*)fwd_kernel, NWAVES * 64, LDS_BYTES) != hipSuccess || per_cu < 1) { fprintf(stderr, "kernel_launch: occupancy query says %d\n", per_cu); }
        (void)hipGetLastError();
        grid = cus;
    }
    if (grid < 0) return;
    (void)hipMemsetAsync((char*)d_ws + WS_CTL, 0, CTL_ZERO_BYTES, stream);
    Args a{};
    for (int i = 0; i < 29; ++i) a.in[i] = (const float*)d_in[i];
    a.out = (float*)d_out; a.ws = (unsigned char*)d_ws;
#if MK_MULTI_LAUNCH
    for (int p = 0; p < NPH; ++p) {
        const int l = p / PH_PER_LAYER, q = p % PH_PER_LAYER;
        if (p < PH_FINAL && q >= 7) { const int ch = (q - 7) >> 1; if (ch >= ((l & 1) ? 5 : 2)) continue; }
        a.ph_lo = p; a.ph_hi = p + 1;
        hipLaunchKernelGGL(fwd_kernel, dim3(grid), dim3(NWAVES * 64), LDS_BYTES, stream, a);
    }
#else
    a.ph_lo = 0; a.ph_hi = NPH;
    hipLaunchKernelGGL(fwd_kernel, dim3(grid), dim3(NWAVES * 64), LDS_BYTES, stream, a);
#endif
}
```
